# Optimizing an MI355X kernel written in HIP

```python
import jax, jax.numpy as jnp
from jax import lax
import numpy as np

D_MODEL = 1024
BATCH = 16
SEQ = 4096
DEPTH = 4

RET_HEADS = 4
RET_DH = 128
RET_W = RET_HEADS * RET_DH
CHUNK = 128
ROPE_BASE = 10000.0
POOL_WINDOWS = (2, 4, 8, 16)
POOL_GROUPS = 4
POOL_GW = 128
POOL_W = POOL_GROUPS * POOL_GW
RG_BLOCKS = 4
RG_BD = 128
RG_W = RG_BLOCKS * RG_BD
RG_CONV = 4
RG_C = 8.0
N_BRANCH = 3
SPLITS = (RET_W, RET_W, RET_W, RET_W, POOL_W, RG_W, RG_W, N_BRANCH * D_MODEL)
IN_W = sum(SPLITS)
N_EXPERTS = 64
N_GROUPS = 8
E_PER_GROUP = N_EXPERTS // N_GROUPS
TOPK_GROUPS = 4
TOP_K = 8
D_EXPERT = 256
ROUTED_SCALE = 2.5
EXPERT_BLOCK = 256
LN_EPS = 1e-5
GN_EPS = 1e-6
ALPHA = (2 * DEPTH) ** 0.25
BETA = (8 * DEPTH) ** -0.25

kernel_name = "hybrid_retention_pool_rglru_moe_deepnorm"


def layer_norm(x, g, b):
    xf = x.astype(jnp.float32)
    mu = xf.mean(-1, keepdims=True)
    var = jnp.square(xf - mu).mean(-1, keepdims=True)
    return ((xf - mu) * lax.rsqrt(var + LN_EPS) * g.astype(jnp.float32) + b.astype(jnp.float32)).astype(x.dtype)


def rope_tables(positions):
    half = RET_DH // 2
    inv = ROPE_BASE ** (-jnp.arange(half, dtype=jnp.float32) / half)
    ang = positions.astype(jnp.float32)[:, None] * inv[None, :]
    return jnp.cos(ang), jnp.sin(ang)


def apply_rope(t, cos, sin):
    half = RET_DH // 2
    t1, t2 = t[..., :half], t[..., half:]
    return jnp.concatenate([t1 * cos - t2 * sin, t1 * sin + t2 * cos], axis=-1)


def retention(q, k, v, g, cos, sin):
    B, S, _ = q.shape
    N = S // CHUNK
    f32 = jnp.float32

    def heads(t):
        return t.astype(f32).reshape(B, S, RET_HEADS, RET_DH).transpose(0, 2, 1, 3)

    qh = apply_rope(heads(q), cos, sin)
    kh = apply_rope(heads(k), cos, sin) * (RET_DH ** -0.5)
    vh = heads(v)
    qc = qh.reshape(B, RET_HEADS, N, CHUNK, RET_DH)
    kc = kh.reshape(B, RET_HEADS, N, CHUNK, RET_DH)
    vc = vh.reshape(B, RET_HEADS, N, CHUNK, RET_DH)

    log_g = jnp.log(1.0 - 2.0 ** (-5.0 - jnp.arange(RET_HEADS, dtype=f32)))
    idx = jnp.arange(CHUNK, dtype=f32)
    diff = idx[:, None] - idx[None, :]
    decay_mask = jnp.where(diff >= 0, jnp.exp(log_g[:, None, None] * jnp.maximum(diff, 0.0)), 0.0)

    scores = jnp.einsum('bhncd,bhnjd->bhncj', qc, kc) * decay_mask[None, :, None]
    o_intra = jnp.einsum('bhncj,bhnjd->bhncd', scores, vc)

    k_decay = jnp.exp(log_g[:, None] * (CHUNK - 1 - idx)[None, :])
    chunk_kv = jnp.einsum('bhncd,bhnce->bhnde', kc * k_decay[None, :, None, :, None], vc)
    chunk_decay = jnp.exp(log_g * CHUNK)[None, :, None, None]

    def step(state, kv):
        return state * chunk_decay + kv, state

    init = jnp.zeros((B, RET_HEADS, RET_DH, RET_DH), f32)
    _, prev = lax.scan(step, init, jnp.moveaxis(chunk_kv, 2, 0))
    prev = jnp.moveaxis(prev, 0, 2)
    q_decay = jnp.exp(log_g[:, None] * (idx + 1.0)[None, :])
    o_cross = jnp.einsum('bhncd,bhnde->bhnce', qc, prev) * q_decay[None, :, None, :, None]

    o = (o_intra + o_cross).reshape(B, RET_HEADS, S, RET_DH)
    mu = o.mean(-1, keepdims=True)
    var = jnp.square(o - mu).mean(-1, keepdims=True)
    o = (o - mu) * lax.rsqrt(var + GN_EPS)
    o = o.transpose(0, 2, 1, 3).reshape(B, S, RET_W)
    return (jax.nn.silu(g.astype(f32)) * o).astype(q.dtype)


def pool_branch(xp, pool_w, pool_scale):
    B, S, _ = xp.shape
    f32 = jnp.float32
    xg = xp.astype(f32).reshape(B, S, POOL_GROUPS, POOL_GW)
    cp = jnp.concatenate([jnp.zeros((B, 1, POOL_GROUPS, POOL_GW), f32), jnp.cumsum(xg, axis=1)], axis=1)
    t = jnp.arange(S)
    means = []
    for gi, w in enumerate(POOL_WINDOWS):
        n = jnp.minimum(w, t + 1)
        win = cp[:, 1:, gi] - jnp.take(cp[:, :, gi], t + 1 - n, axis=1)
        means.append(win / n.astype(f32)[None, :, None])
    pooled = jnp.stack(means, axis=2) - xg
    y = jnp.einsum('bsgc,gce->bsge', pooled, pool_w.astype(f32)).reshape(B, S, POOL_W)
    return (y * pool_scale.astype(f32)).astype(xp.dtype)


def _lin_comb(c1, c2):
    a1, b1 = c1
    a2, b2 = c2
    return a1 * a2, a2 * b1 + b2


def rglru_branch(xr, yr, conv_w, conv_b, wa, ba, wx, bx, lam):
    B, S, _ = xr.shape
    f32 = jnp.float32
    xf = xr.astype(f32)
    conv = conv_b.astype(f32)
    for k in range(RG_CONV):
        shifted = jnp.pad(xf, ((0, 0), (k, 0), (0, 0)))[:, :S]
        conv = conv + shifted * conv_w[k].astype(f32)
    cb = conv.reshape(B, S, RG_BLOCKS, RG_BD)
    r = jax.nn.sigmoid(jnp.einsum('bsnd,nde->bsne', cb, wa.astype(f32)).reshape(B, S, RG_W) + ba)
    i = jax.nn.sigmoid(jnp.einsum('bsnd,nde->bsne', cb, wx.astype(f32)).reshape(B, S, RG_W) + bx)
    log_a = RG_C * r * jax.nn.log_sigmoid(lam.astype(f32))
    a = jnp.exp(log_a)
    b = jnp.sqrt(-jnp.expm1(2.0 * log_a)) * (i * conv)
    _, h = lax.associative_scan(_lin_comb, (a, b), axis=1)
    return (h * jax.nn.gelu(yr.astype(f32))).astype(xr.dtype)


def token_mixer(x, cos, sin, w_in, gate_b, w_branch, w_out, pool_w, pool_scale,
                conv_w, conv_b, wa, ba, wx, bx, lam):
    B, S, D = x.shape
    h = x @ w_in
    cuts = list(np.cumsum(SPLITS)[:-1])
    q, k, v, g, xp, xr, yr, gl = jnp.split(h, cuts, axis=-1)
    branches = (
        retention(q, k, v, g, cos, sin),
        pool_branch(xp, pool_w, pool_scale),
        rglru_branch(xr, yr, conv_w, conv_b, wa, ba, wx, bx, lam),
    )
    gates = jax.nn.sigmoid((gl.reshape(B, S, N_BRANCH, D) + gate_b).astype(jnp.float32)).astype(x.dtype)
    merged = gates[:, :, 0] * (branches[0] @ w_branch[0])
    for bi in range(1, N_BRANCH):
        merged = merged + gates[:, :, bi] * (branches[bi] @ w_branch[bi])
    return merged @ w_out


def moe_ffn(x2, router_w, router_bias, w1, w3, w2, s_w1, s_w3, s_w2):
    T, D = x2.shape
    scores = jax.nn.sigmoid((x2 @ router_w).astype(jnp.float32))
    biased = scores + router_bias.astype(jnp.float32)
    grp_score = lax.top_k(biased.reshape(T, N_GROUPS, E_PER_GROUP), 2)[0].sum(-1)
    _, top_groups = lax.top_k(grp_score, TOPK_GROUPS)
    gmask = jnp.any(top_groups[:, :, None] == jnp.arange(N_GROUPS)[None, None, :], axis=1)
    masked = jnp.where(jnp.repeat(gmask, E_PER_GROUP, axis=1), biased, -jnp.inf)
    _, top_e = lax.top_k(masked, TOP_K)
    sel = jnp.take_along_axis(scores, top_e, axis=1)
    gate_w = sel / sel.sum(-1, keepdims=True) * ROUTED_SCALE

    A = T * TOP_K
    e_flat = top_e.reshape(A)
    tok_flat = jnp.arange(A, dtype=jnp.int32) // TOP_K
    w_flat = gate_w.reshape(A).astype(x2.dtype)
    order = jnp.argsort(e_flat)
    e_sorted = e_flat[order]
    counts = jnp.bincount(e_flat, length=N_EXPERTS)
    padded = ((counts + EXPERT_BLOCK - 1) // EXPERT_BLOCK) * EXPERT_BLOCK
    pad_end = jnp.cumsum(padded)
    pad_start = pad_end - padded
    start = jnp.cumsum(counts) - counts
    dest = pad_start[e_sorted] + (jnp.arange(A, dtype=jnp.int32) - start[e_sorted])
    P = A + N_EXPERTS * EXPERT_BLOCK
    n_blk = P // EXPERT_BLOCK
    buf_tok = jnp.full((P,), T, jnp.int32).at[dest].set(tok_flat[order])
    buf_w = jnp.zeros((P,), x2.dtype).at[dest].set(w_flat[order])
    blk_start = jnp.arange(n_blk, dtype=jnp.int32) * EXPERT_BLOCK
    blk_expert = jnp.minimum(jnp.searchsorted(pad_end, blk_start, side='right'), N_EXPERTS - 1)
    x_pad = jnp.concatenate([x2, jnp.zeros((1, D), x2.dtype)], axis=0)

    def run_block(args):
        e, tok, wt = args
        xb = x_pad[tok]
        hb = jax.nn.silu(xb @ w1[e]) * (xb @ w3[e])
        return (hb @ w2[e]) * wt[:, None]

    y = lax.map(run_block, (blk_expert, buf_tok.reshape(n_blk, EXPERT_BLOCK), buf_w.reshape(n_blk, EXPERT_BLOCK)))
    routed = jax.ops.segment_sum(y.reshape(P, D), buf_tok, num_segments=T + 1)[:T]
    shared = (jax.nn.silu(x2 @ s_w1) * (x2 @ s_w3)) @ s_w2
    return shared + routed


def setup_inputs(seed: int = 0) -> dict:
    key = jax.random.key(seed)
    ks = jax.random.split(key, 32)
    nrm = jax.random.normal
    L, D = DEPTH, D_MODEL
    f32 = jnp.float32
    a0 = jax.random.uniform(ks[14], (L, RG_W), f32, minval=0.9, maxval=0.999)
    s = a0 ** (1.0 / RG_C)
    return {
        "x": nrm(ks[0], (BATCH, SEQ, D), f32),
        "positions": jnp.arange(SEQ, dtype=jnp.int32),
        "w_in": nrm(ks[1], (L, D, IN_W), f32) * D ** -0.5,
        "gate_b": nrm(ks[2], (L, N_BRANCH, D), f32) * 0.1,
        "w_branch": nrm(ks[3], (L, N_BRANCH, RET_W, D), f32) * (RET_W ** -0.5) * BETA,
        "w_out": nrm(ks[4], (L, D, D), f32) * (D ** -0.5) * BETA,
        "pool_w": nrm(ks[5], (L, POOL_GROUPS, POOL_GW, POOL_GW), f32) * POOL_GW ** -0.5,
        "pool_scale": 1.0 + 0.1 * nrm(ks[6], (L, POOL_W), f32),
        "rg_conv_w": nrm(ks[7], (L, RG_CONV, RG_W), f32) * RG_CONV ** -0.5,
        "rg_conv_b": nrm(ks[8], (L, RG_W), f32) * 0.02,
        "rg_wa": nrm(ks[9], (L, RG_BLOCKS, RG_BD, RG_BD), f32) * RG_BD ** -0.5,
        "rg_ba": nrm(ks[10], (L, RG_W), f32) * 0.02,
        "rg_wx": nrm(ks[11], (L, RG_BLOCKS, RG_BD, RG_BD), f32) * RG_BD ** -0.5,
        "rg_bx": nrm(ks[12], (L, RG_W), f32) * 0.02,
        "rg_lambda": jnp.log(s) - jnp.log1p(-s),
        "ln1_g": 1.0 + 0.02 * nrm(ks[13], (L, D), f32),
        "ln1_b": 0.02 * nrm(ks[15], (L, D), f32),
        "router_w": nrm(ks[16], (L, D, N_EXPERTS), f32) * D ** -0.5,
        "router_bias": nrm(ks[17], (L, N_EXPERTS), f32) * 0.01,
        "exp_w1": nrm(ks[18], (L, N_EXPERTS, D, D_EXPERT), f32) * D ** -0.5,
        "exp_w3": nrm(ks[19], (L, N_EXPERTS, D, D_EXPERT), f32) * D ** -0.5,
        "exp_w2": nrm(ks[20], (L, N_EXPERTS, D_EXPERT, D), f32) * (D_EXPERT ** -0.5) * BETA,
        "sh_w1": nrm(ks[21], (L, D, D_EXPERT), f32) * D ** -0.5,
        "sh_w3": nrm(ks[22], (L, D, D_EXPERT), f32) * D ** -0.5,
        "sh_w2": nrm(ks[23], (L, D_EXPERT, D), f32) * (D_EXPERT ** -0.5) * BETA,
        "ln2_g": 1.0 + 0.02 * nrm(ks[24], (L, D), f32),
        "ln2_b": 0.02 * nrm(ks[25], (L, D), f32),
    }


def reference(x, positions, w_in, gate_b, w_branch, w_out, pool_w, pool_scale,
              rg_conv_w, rg_conv_b, rg_wa, rg_ba, rg_wx, rg_bx, rg_lambda,
              ln1_g, ln1_b, router_w, router_bias, exp_w1, exp_w3, exp_w2,
              sh_w1, sh_w3, sh_w2, ln2_g, ln2_b):
    B, S, D = x.shape
    cos, sin = rope_tables(positions)
    for l in range(DEPTH):
        m = token_mixer(x, cos, sin, w_in[l], gate_b[l], w_branch[l], w_out[l], pool_w[l], pool_scale[l],
                        rg_conv_w[l], rg_conv_b[l], rg_wa[l], rg_ba[l], rg_wx[l], rg_bx[l], rg_lambda[l])
        x = layer_norm(ALPHA * x + m, ln1_g[l], ln1_b[l])
        f = moe_ffn(x.reshape(B * S, D), router_w[l], router_bias[l], exp_w1[l], exp_w3[l], exp_w2[l],
                    sh_w1[l], sh_w3[l], sh_w2[l]).reshape(B, S, D)
        x = layer_norm(ALPHA * x + f, ln2_g[l], ln2_b[l])
    return x
```

```cpp
#include <hip/hip_runtime.h>
#include <cstdio>
#include <cstdint>

#ifndef MK_ONE_LAUNCH
#define MK_ONE_LAUNCH 1
#endif
#ifndef SIMPLE_GEMM
#define SIMPLE_GEMM 0
#define XK 8
#endif

#define LAS __attribute__((address_space(3)))
#define GAS __attribute__((address_space(1)))
typedef unsigned short bf16_t;
typedef short bf16x8 __attribute__((ext_vector_type(8)));
typedef unsigned short u16x4 __attribute__((ext_vector_type(4)));
typedef float f32x4 __attribute__((ext_vector_type(4)));
typedef float f32x2 __attribute__((ext_vector_type(2)));
typedef unsigned u32x4 __attribute__((ext_vector_type(4)));
typedef unsigned u32x2 __attribute__((ext_vector_type(2)));
typedef LAS unsigned char lds_t;

constexpr int T = 65536, D = 1024, SEQ = 4096, NBATCH = 16, DEPTH = 4;
constexpr int NPANEL = 256;
constexpr int HW = 3584;
constexpr int INW = 6656;
constexpr int NEXP = 64, DEXP = 256;
constexpr int NSUB = 2, TSUB = T / NSUB, PSUB = NPANEL / NSUB;
constexpr int ROWS_MAX = TSUB * 8 + NEXP * 256;
constexpr float ALPHA = 1.681792830507429f;
constexpr float LN_EPS = 1e-5f, GN_EPS = 1e-6f;

constexpr size_t MiB = 1u << 20;
constexpr size_t WS_CTL = 0;
constexpr size_t WS_COS = 1 * MiB, WS_SIN = 2 * MiB;
constexpr size_t WS_W = 3 * MiB;
constexpr size_t W_IN = WS_W, W_BR = WS_W + 13 * MiB, W_OUT = WS_W + 16 * MiB, W_SM = WS_W + 18 * MiB;
constexpr size_t W_SHUP = WS_W + 19 * MiB, W_SHDN = W_SHUP + 3 * MiB / 2, W_E13 = WS_W + 21 * MiB, W_E2 = WS_W + 85 * MiB;
constexpr size_t WS_XB = 120 * MiB;
constexpr size_t WS_S = 248 * MiB;
constexpr size_t S_H7 = WS_S, S_KV = WS_S + 448 * MiB, S_BR = WS_S + 576 * MiB, S_MG = WS_S + 768 * MiB, S_RGC = WS_S + 896 * MiB;
constexpr size_t S_LA = S_MG, S_BB = S_MG + 64 * MiB;
constexpr size_t S_HS = WS_S, S_LG = WS_S + 32 * MiB, S_PE = WS_S + 48 * MiB, S_GW = WS_S + 50 * MiB, S_LIST = WS_S + 52 * MiB;
constexpr size_t S_HE = WS_S + 68 * MiB, S_Y = WS_S + 204 * MiB;
constexpr size_t WS_END = WS_S + 899 * MiB;
static_assert(S_HE + (size_t)ROWS_MAX * 512 <= S_Y && S_Y + (size_t)ROWS_MAX * 2048 <= WS_END, "moe scratch");
constexpr int CW_BAR = 4096;
constexpr int CW_CNT = 16384;

constexpr int LDS_STAGE = 131072;
constexpr int LDS_MISC = 143360;
constexpr int LDS_BYTES = 147456;

__device__ __forceinline__ unsigned f2bf(float f) { unsigned u = __builtin_bit_cast(unsigned, f); return (u + 0x7fffu + ((u >> 16) & 1u)) >> 16; }
__device__ __forceinline__ unsigned pk2(float lo, float hi) { return f2bf(lo) | (f2bf(hi) << 16); }
__device__ __forceinline__ float bf2f(unsigned short b) { return __builtin_bit_cast(float, (unsigned)b << 16); }
__device__ __forceinline__ float bflo(unsigned w) { return __builtin_bit_cast(float, w << 16); }
__device__ __forceinline__ float bfhi(unsigned w) { return __builtin_bit_cast(float, w & 0xffff0000u); }
__device__ __forceinline__ float sigmoidf_(float x) { return 1.0f / (1.0f + __expf(-x)); }
__device__ __forceinline__ float siluf_(float x) { return x / (1.0f + __expf(-x)); }
__device__ __forceinline__ float gelu_tanh(float x) { const float u = 0.7978845608028654f * (x + 0.044715f * x * x * x); return x / (1.0f + __expf(-2.0f * u)); }
__device__ __forceinline__ float wave_sum(float v) {
#pragma unroll
    for (int o = 1; o < 64; o <<= 1) v += __shfl_xor(v, o);
    return v;
}
#define LDS_WAIT() asm volatile("s_waitcnt lgkmcnt(0)" ::: "memory")
#define VM_WAIT() asm volatile("s_waitcnt vmcnt(0)" ::: "memory")

__device__ __forceinline__ f32x4 mfma16(bf16x8 a, bf16x8 b, f32x4 c) { return __builtin_amdgcn_mfma_f32_16x16x32_bf16(a, b, c, 0, 0, 0); }
__device__ __forceinline__ bf16x8 frag_row(const lds_t* X, int pitchB, int r0, int k0, int fr, int fq) {
    return *(const LAS bf16x8*)(X + (r0 + fr) * pitchB + (k0 + 8 * fq) * 2);
}
__device__ __forceinline__ bf16x8 frag_col(const lds_t* X, int pitchB, int k0, int c0, int fr, int fq) {
    const int q = fr >> 2, p = fr & 3;
    const unsigned a0 = (unsigned)(size_t)X + (unsigned)((k0 + 8 * fq + q) * pitchB + (c0 + 4 * p) * 2);
    u16x4 lo, hi;
    asm volatile("ds_read_b64_tr_b16 %0, %2\n\tds_read_b64_tr_b16 %1, %3\n\ts_waitcnt lgkmcnt(0)" : "=&v"(lo), "=&v"(hi) : "v"(a0), "v"(a0 + 4u * (unsigned)pitchB) : "memory");
    bf16x8 r; r[0] = (short)lo[0]; r[1] = (short)lo[1]; r[2] = (short)lo[2]; r[3] = (short)lo[3]; r[4] = (short)hi[0]; r[5] = (short)hi[1]; r[6] = (short)hi[2]; r[7] = (short)hi[3];
    return r;
}

#define XB_TMO      128
#define XB_XCNT(j)  (256  + 64 * (j))
#define XB_XSUB(j)  (1280 + 64 * (j))
#define XB_XGEN(j)  (2304 + 64 * (j))
#define XB_TOP      3328
#define XB_TOPGEN   3392
#define XCD_BAR_WORDS 3456
#define XB_SPIN_CAP (1u << 20)
__device__ __forceinline__ unsigned xb_ld(unsigned* p)              { return __hip_atomic_load(p, __ATOMIC_RELAXED, __HIP_MEMORY_SCOPE_AGENT); }
__device__ __forceinline__ unsigned xb_add(unsigned* p, unsigned v) { return __hip_atomic_fetch_add(p, v, __ATOMIC_RELAXED, __HIP_MEMORY_SCOPE_AGENT); }
__device__ __forceinline__ unsigned xb_xcc_id() { return (unsigned)__builtin_amdgcn_s_getreg((3 << 11) | 20) & 0xFu; }
#define XB_SPIN(cond, bar) do { unsigned _sp = 0; while (cond) { __builtin_amdgcn_s_sleep(1); \
    if ((++_sp & 255u) == 0u) { if (xb_ld(&(bar)[XB_TMO])) break; if (_sp > XB_SPIN_CAP) { atomicAdd(&(bar)[XB_TMO], 1u); break; } } } } while (0)
struct XcdBarrier { unsigned* bar; unsigned x; volatile LAS unsigned* st; };
__device__ __forceinline__ XcdBarrier xcd_barrier_post(unsigned* bar, volatile LAS unsigned* st) {
    XcdBarrier b; b.bar = bar; b.x = xb_xcc_id(); b.st = st;
    if (threadIdx.x == 0) (void)xb_add(&bar[XB_XCNT(b.x)], 1u);
    return b;
}
__device__ __forceinline__ void xcd_barrier_complete(unsigned* bar, unsigned x, unsigned& nloc, unsigned& nx) {
    const unsigned G = gridDim.x * gridDim.y * gridDim.z;
    unsigned sum, cnt, mine, sp = 0u;
    for (;;) {
        sum = 0u; cnt = 0u; mine = 0u;
#pragma unroll
        for (unsigned j = 0; j < 16; ++j) { const unsigned c = xb_ld(&bar[XB_XCNT(j)]); sum += c; cnt += (c > 0u) ? 1u : 0u; mine = (j == x) ? c : mine; }
        if (sum == G) break;
        __builtin_amdgcn_s_sleep(1);
        if ((++sp & 255u) == 0u) { if (xb_ld(&bar[XB_TMO])) break; if (sp > XB_SPIN_CAP) { atomicAdd(&bar[XB_TMO], 1u); break; } }
    }
    nloc = mine > 0u ? mine : 1u; nx = cnt > 0u ? cnt : 1u;
}
__device__ __forceinline__ void xcd_barrier(const XcdBarrier& b) {
    asm volatile("s_waitcnt vmcnt(0)" ::: "memory");
    __syncthreads();
    if (threadIdx.x == 0) {
        unsigned* bar = b.bar;
        __builtin_amdgcn_s_waitcnt(0);
        unsigned nloc = b.st[0], nx = b.st[1];
        if (nloc == 0u) { xcd_barrier_complete(bar, b.x, nloc, nx); b.st[0] = nloc; b.st[1] = nx; }
        const unsigned old = xb_add(&bar[XB_XSUB(b.x)], 1u);
        const unsigned gen = old / nloc;
        if (old + 1u == (gen + 1u) * nloc) {
            __builtin_amdgcn_fence(__ATOMIC_RELEASE, "agent");
            asm volatile("s_waitcnt vmcnt(0)" ::: "memory");
            const unsigned og = xb_add(&bar[XB_TOP], 1u);
            const unsigned tg = og / nx;
            if (og + 1u == (tg + 1u) * nx) xb_add(&bar[XB_TOPGEN], 1u);
            else XB_SPIN(xb_ld(&bar[XB_TOPGEN]) == tg, bar);
            __builtin_amdgcn_fence(__ATOMIC_ACQUIRE, "agent");
            xb_add(&bar[XB_XGEN(b.x)], 1u);
            asm volatile("s_waitcnt vmcnt(0)" ::: "memory");
        } else {
            XB_SPIN(xb_ld(&bar[XB_XGEN(b.x)]) == gen, bar);
            __builtin_amdgcn_fence(__ATOMIC_ACQUIRE, "agent");
            asm volatile("s_waitcnt vmcnt(0)" ::: "memory");
        }
    }
    __syncthreads();
}

struct GUnit { const char* A; const char* B; int x, y, z, w; };

constexpr int BK = 64, HALF = 128, HTB = HALF * BK * 2;
__host__ __device__ __forceinline__ int lds_byte(int r, int c) { const int st = (r >> 4) * 2 + (c >> 5), rr = r & 15, cc = c & 31, ob = rr * 64 + cc * 2; return st * 1024 + (ob ^ (((ob >> 9) & 1) << 5)); }
__host__ __device__ __forceinline__ void stage_rc(int b, int& R, int& C) { const int st = b / 1024, sb = b % 1024, swz = sb ^ (((sb >> 9) & 1) << 5); R = (st >> 1) * 16 + swz / 64; C = (st & 1) * 32 + (swz % 64) / 2; }

#if SIMPLE_GEMM
template <class Epi, class Sched, bool GATHER>
__device__ __forceinline__ void gemm_phase(lds_t* lds, const int tid, const int K, const unsigned ldaB, const Sched& S, const Epi& E) {
    const int wid = __builtin_amdgcn_readfirstlane(tid >> 6), lane = tid & 63, wr = wid >> 2, wc = wid & 3, fr = lane & 15, fq = lane >> 4;
    GUnit cur;
    for (int ui = 0; S.next(ui, cur); ++ui) {
        f32x4 acc[2][2][4][2];
#pragma unroll
        for (int a = 0; a < 2; ++a)
#pragma unroll
            for (int b = 0; b < 2; ++b)
#pragma unroll
                for (int m = 0; m < 4; ++m)
#pragma unroll
                    for (int n = 0; n < 2; ++n) acc[a][b][m][n] = (f32x4){0.f, 0.f, 0.f, 0.f};
        unsigned ao[2][4], bo[2][2];
#pragma unroll
        for (int ai = 0; ai < 2; ++ai)
#pragma unroll
            for (int m = 0; m < 4; ++m) { const int r = ai * HALF + wr * 64 + m * 16 + fr; const unsigned ro = GATHER ? (unsigned)S.gather_row(cur, r) : (unsigned)r; ao[ai][m] = ro * ldaB + fq * 16; }
#pragma unroll
        for (int bj = 0; bj < 2; ++bj)
#pragma unroll
            for (int n = 0; n < 2; ++n) { const int r = bj * HALF + wc * 32 + n * 16 + fr; bo[bj][n] = (unsigned)(r * K * 2 + fq * 16); }
#pragma unroll 1
        for (int k0 = 0; k0 < K; k0 += 32) {
            bf16x8 af[2][4], bfr[2][2];
#pragma unroll
            for (int ai = 0; ai < 2; ++ai)
#pragma unroll
                for (int m = 0; m < 4; ++m) af[ai][m] = *(const bf16x8*)(cur.A + ao[ai][m] + k0 * 2);
#pragma unroll
            for (int bj = 0; bj < 2; ++bj)
#pragma unroll
                for (int n = 0; n < 2; ++n) bfr[bj][n] = *(const bf16x8*)(cur.B + bo[bj][n] + k0 * 2);
#pragma unroll
            for (int ai = 0; ai < 2; ++ai)
#pragma unroll
                for (int bj = 0; bj < 2; ++bj)
#pragma unroll
                    for (int m = 0; m < 4; ++m)
#pragma unroll
                        for (int n = 0; n < 2; ++n) acc[ai][bj][m][n] = mfma16(bfr[bj][n], af[ai][m], acc[ai][bj][m][n]);
        }
        E(acc, cur, wr, wc, fr, fq);
    }
}
#else
template <class Epi, class Sched, bool GATHER>
__device__ __forceinline__ void gemm_phase(lds_t* lds, const int tid, const int K, const unsigned ldaB, const Sched& S, const Epi& E) {
    const int wid = __builtin_amdgcn_readfirstlane(tid >> 6), lane = tid & 63, wr = wid >> 2, wc = wid & 3, fr = lane & 15, fq = lane >> 4;
    const int nt = K / BK;
    int sR[2], sC[2];
    unsigned voffB[2], voffA[2][2], voffN[2][2];
#pragma unroll
    for (int i = 0; i < 2; ++i) { stage_rc(tid * 16 + i * 8192, sR[i], sC[i]); voffB[i] = (unsigned)(sR[i] * K + sC[i]) * 2u; }
    const size_t kstep = (size_t)(BK * 2);
    const size_t hstepB = (size_t)HALF * K * 2;
    const unsigned ldsw = (unsigned)wid * 1024u;
    const int aoff = lds_byte(wr * 64 + fr, fq * 8), boff = lds_byte(wc * 32 + fr, fq * 8);
#define PG8_SA(b, h) (((b) * 2 + (h)) * HTB)
#define PG8_SB(b, h) ((4 + (b) * 2 + (h)) * HTB)
#define PG8_STAGE(bufoff, gbase, voff) do { _Pragma("unroll") for (int _i = 0; _i < 2; ++_i) \
        __builtin_amdgcn_global_load_lds((const unsigned*)((const char*)(gbase) + (voff)[_i]), (LAS unsigned*)(lds + (bufoff) + ldsw + _i * 8192), 16, 0, 0); } while (0)
#define PG8_LDA(dst, b, h) do { _Pragma("unroll") for (int m = 0; m < 4; ++m) _Pragma("unroll") for (int k = 0; k < 2; ++k) dst[m][k] = *(const LAS bf16x8*)(lds + PG8_SA(b, h) + aoff + m * 2048 + k * 1024); } while (0)
#define PG8_LDB(dst, b, h) do { _Pragma("unroll") for (int n = 0; n < 2; ++n) _Pragma("unroll") for (int k = 0; k < 2; ++k) dst[n][k] = *(const LAS bf16x8*)(lds + PG8_SB(b, h) + boff + n * 2048 + k * 1024); } while (0)
#define PG8_MMA(ai, bj, At, Bt) do { __builtin_amdgcn_s_setprio(1); _Pragma("unroll") for (int m = 0; m < 4; ++m) _Pragma("unroll") for (int n = 0; n < 2; ++n) _Pragma("unroll") for (int k = 0; k < 2; ++k) \
        acc[ai][bj][m][n] = __builtin_amdgcn_mfma_f32_16x16x32_bf16(Bt[n][k], At[m][k], acc[ai][bj][m][n], 0, 0, 0); __builtin_amdgcn_s_setprio(0); } while (0)
#define PG8_WAIT_V(n) asm volatile("s_waitcnt vmcnt(" #n ")" ::: "memory")
#define PG8_WAIT_L(n) asm volatile("s_waitcnt lgkmcnt(" #n ")" ::: "memory")
#define PG8_BAR __builtin_amdgcn_s_barrier()
#define PG8_SCHED __builtin_amdgcn_sched_barrier(0)
#define PG8_AOFFS(dst, U) do { _Pragma("unroll") for (int _h = 0; _h < 2; ++_h) _Pragma("unroll") for (int _i = 0; _i < 2; ++_i) { \
        const unsigned _row = GATHER ? (unsigned)S.gather_row(U, _h * HALF + sR[_i]) : (unsigned)(_h * HALF + sR[_i]); dst[_h][_i] = _row * ldaB + (unsigned)sC[_i] * 2u; } } while (0)
    GUnit cur, nxt; int ui = 0;
    if (!S.next(0, cur)) return;
    f32x4 acc[2][2][4][2];
#pragma unroll
    for (int a = 0; a < 2; ++a)
#pragma unroll
        for (int b = 0; b < 2; ++b)
#pragma unroll
            for (int m = 0; m < 4; ++m)
#pragma unroll
                for (int n = 0; n < 2; ++n) acc[a][b][m][n] = (f32x4){0.f, 0.f, 0.f, 0.f};
    bf16x8 At[4][2], B0[2][2], B1[2][2];
    const char* cA = cur.A; const char* cB = cur.B;
    PG8_AOFFS(voffA, cur);
    PG8_STAGE(PG8_SB(0, 0), cB, voffB); PG8_STAGE(PG8_SB(0, 1), cB + hstepB, voffB); PG8_STAGE(PG8_SA(0, 0), cA, voffA[0]); PG8_STAGE(PG8_SA(0, 1), cA, voffA[1]);
    if (wr == 1) PG8_BAR;
    PG8_WAIT_V(2); PG8_BAR;
    PG8_STAGE(PG8_SB(1, 0), cB + kstep, voffB); PG8_STAGE(PG8_SA(1, 0), cA + kstep, voffA[0]); PG8_STAGE(PG8_SB(1, 1), cB + hstepB + kstep, voffB);
    PG8_WAIT_V(6); PG8_BAR;
    for (;;) {
        const bool has_next = S.next(ui + 1, nxt);
        const char* nA = has_next ? nxt.A : cA; const char* nB = has_next ? nxt.B : cB;
        if (has_next) { PG8_AOFFS(voffN, nxt); } else {
#pragma unroll
            for (int h = 0; h < 2; ++h)
#pragma unroll
                for (int i = 0; i < 2; ++i) voffN[h][i] = voffA[h][i]; }
#pragma unroll 1
        for (int t = 0; t < nt; t += 2) {
            const bool last = (t == nt - 2);
            const char* a1 = cA + (size_t)(t + 1) * kstep;
            const char* a2 = last ? nA : cA + (size_t)(t + 2) * kstep; const char* b2 = last ? nB : cB + (size_t)(t + 2) * kstep;
            const char* a3 = a2 + kstep; const char* b3 = b2 + kstep;
            unsigned vo2[2][2];
#pragma unroll
            for (int h = 0; h < 2; ++h)
#pragma unroll
                for (int i = 0; i < 2; ++i) vo2[h][i] = last ? voffN[h][i] : voffA[h][i];
            PG8_LDB(B0, 0, 0); PG8_LDB(B1, 0, 1); PG8_SCHED; PG8_LDA(At, 0, 0); PG8_STAGE(PG8_SA(1, 1), a1, voffA[1]);
            PG8_WAIT_V(8); PG8_WAIT_L(0); PG8_BAR; PG8_MMA(0, 0, At, B0); PG8_MMA(0, 1, At, B1); PG8_BAR; PG8_SCHED;
            PG8_LDA(At, 0, 1); PG8_STAGE(PG8_SB(0, 0), b2, voffB); PG8_STAGE(PG8_SB(0, 1), b2 + hstepB, voffB); PG8_STAGE(PG8_SA(0, 0), a2, vo2[0]);
            PG8_WAIT_V(8); PG8_WAIT_L(0); PG8_BAR; PG8_MMA(1, 0, At, B0); PG8_MMA(1, 1, At, B1); PG8_BAR; PG8_SCHED;
            PG8_LDB(B0, 1, 0); PG8_LDB(B1, 1, 1); PG8_SCHED; PG8_LDA(At, 1, 0); PG8_STAGE(PG8_SA(0, 1), a2, vo2[1]);
            PG8_WAIT_V(8); PG8_WAIT_L(0); PG8_BAR; PG8_MMA(0, 0, At, B0); PG8_MMA(0, 1, At, B1); PG8_BAR; PG8_SCHED;
            PG8_LDA(At, 1, 1); PG8_STAGE(PG8_SB(1, 0), b3, voffB); PG8_STAGE(PG8_SB(1, 1), b3 + hstepB, voffB); PG8_STAGE(PG8_SA(1, 0), a3, vo2[0]);
            PG8_WAIT_V(8); PG8_WAIT_L(0); PG8_BAR; PG8_MMA(1, 0, At, B0); PG8_MMA(1, 1, At, B1); PG8_BAR; PG8_SCHED;
        }
        if (wr == 0) PG8_BAR;
        E(acc, cur, wr, wc, fr, fq);
        if (!has_next) break;
#pragma unroll
        for (int a = 0; a < 2; ++a)
#pragma unroll
            for (int b = 0; b < 2; ++b)
#pragma unroll
                for (int m = 0; m < 4; ++m)
#pragma unroll
                    for (int n = 0; n < 2; ++n) acc[a][b][m][n] = (f32x4){0.f, 0.f, 0.f, 0.f};
        cur = nxt; cA = nA; cB = nB; ++ui;
#pragma unroll
        for (int h = 0; h < 2; ++h)
#pragma unroll
            for (int i = 0; i < 2; ++i) voffA[h][i] = voffN[h][i];
        if (wr == 1) PG8_BAR;
    }
    PG8_WAIT_V(0);
    PG8_BAR;
#undef PG8_SA
#undef PG8_SB
#undef PG8_STAGE
#undef PG8_LDA
#undef PG8_LDB
#undef PG8_MMA
#undef PG8_WAIT_V
#undef PG8_WAIT_L
#undef PG8_BAR
#undef PG8_SCHED
#undef PG8_AOFFS
}
#endif

struct Args { const void* in[27]; float* out; unsigned char* ws; int ph_lo, ph_hi; };
struct Ctx {
    lds_t* lds; int tid, lane, wave; int G, bid, layer;
    unsigned char* ws; float* out;
};
enum { I_X = 0, I_POS = 1, I_WIN = 2, I_GATEB = 3, I_WBR = 4, I_WOUT = 5, I_POOLW = 6, I_POOLS = 7, I_CONVW = 8, I_CONVB = 9, I_WA = 10, I_BA = 11, I_WX = 12, I_BX = 13, I_LAM = 14,
       I_LN1G = 15, I_LN1B = 16, I_RW = 17, I_RB = 18, I_EW1 = 19, I_EW3 = 20, I_EW2 = 21, I_SW1 = 22, I_SW3 = 23, I_SW2 = 24, I_LN2G = 25, I_LN2B = 26 };
constexpr int LDS_PTAB = 143360 + 1024;
__device__ __forceinline__ const float* inp(const Ctx& c, int idx, size_t off) {
    const unsigned long long v = ((const LAS unsigned long long*)(c.lds + LDS_PTAB))[idx];
    const unsigned lo = __builtin_amdgcn_readfirstlane((unsigned)v), hi = __builtin_amdgcn_readfirstlane((unsigned)(v >> 32));
    return (const float*)(const GAS float*)(((unsigned long long)hi << 32) | lo) + off;
}
__device__ __forceinline__ Ctx fresh(const Ctx& c0) {
    Ctx c = c0; int t = c0.tid; asm volatile("" : "+v"(t));
    int g = c0.G, b = c0.bid, l = c0.layer; asm volatile("" : "+s"(g), "+s"(b), "+s"(l));
    unsigned long long w = (unsigned long long)c0.ws, o = (unsigned long long)c0.out; unsigned ld = (unsigned)(size_t)c0.lds; asm volatile("" : "+s"(w), "+s"(o), "+s"(ld));
    c.tid = t; c.lane = t & 63; c.wave = __builtin_amdgcn_readfirstlane(t >> 6); c.G = g; c.bid = b; c.layer = l;
    c.ws = (unsigned char*)(GAS unsigned char*)w; c.out = (float*)(GAS float*)o; c.lds = (lds_t*)ld; return c;
}

struct PanelOrder {
    const char* A; const char* B; int NT, G, bid; size_t a_panel_bytes, b_tile_bytes;
    __device__ __forceinline__ bool next(int i, GUnit& u) const {
        const int pi = i / NT, pn = i - pi * NT; const int p = bid + pi * G; if (p >= NPANEL) return false;
        u.A = A + (size_t)p * a_panel_bytes; u.B = B + (size_t)pn * b_tile_bytes; u.x = p; u.y = pn; u.z = 0; u.w = 0; return true;
    }
    __device__ __forceinline__ int gather_row(const GUnit&, int r) const { return r; }
};
struct MoeOrder {
    const char* A; const char* B; int NT, G, bid; size_t b_exp_bytes, b_tile_bytes, a_tile_bytes; const LAS int* tp; const LAS int* cnt; const unsigned* list; bool gather; int lane;
    __device__ __forceinline__ bool next(int i, GUnit& u) const {
        const int g = bid + i * G; const int ti = g / NT, pn = g - ti * NT; const int ntile = tp[64]; if (ti >= ntile) return false;
        const unsigned long long m = __ballot(tp[lane + 1] > ti);
        const int e = __builtin_amdgcn_readfirstlane((int)__builtin_ctzll(m));
        const int tl = ti - tp[e];
        u.A = gather ? A : A + (size_t)ti * a_tile_bytes; u.B = B + (size_t)e * b_exp_bytes + (size_t)pn * b_tile_bytes; u.x = ti; u.y = pn; u.z = e; u.w = tl; return true;
    }
    __device__ __forceinline__ int gather_row(const GUnit& u, int r) const {
        const int c = cnt[u.z]; int j = u.w * 256 + r; j = j < c ? j : c - 1;
#ifdef X6
        return r;
#endif
        return (int)(list[(size_t)u.z * TSUB + j] >> 3);
    }
};

struct EpiIn {
    bf16_t* H; const float* cosT; const float* sinT;
    __device__ __forceinline__ void operator()(const f32x4 (&acc)[2][2][4][2], const GUnit& u, int wr, int wc, int fr, int fq) const {
        const int seg = u.y >> 1; const int row0 = u.x * 256 + wr * 64 + fr; const int colt = u.y * 256 + wc * 32 + 4 * fq;
#pragma unroll
        for (int ai = 0; ai < 2; ++ai)
#pragma unroll
            for (int m = 0; m < 4; ++m) {
                const int row = row0 + ai * HALF + m * 16; bf16_t* rowp = H + (size_t)row * HW + colt; const int s = row & (SEQ - 1);
#pragma unroll
                for (int n = 0; n < 2; ++n) {
                    f32x2 cs0, sn0;
                    if (seg < 2) { const int i0 = 16 * wc + 8 * n + 2 * fq; cs0 = *(const f32x2*)(cosT + s * 64 + i0); sn0 = *(const f32x2*)(sinT + s * 64 + i0); }
#pragma unroll
                    for (int bj = 0; bj < 2; ++bj) {
                        f32x4 v = acc[ai][bj][m][n];
                        if (seg < 2) {
                            const float sc = seg == 1 ? 0.08838834764831845f : 1.0f;
                            const float a0 = v[0] * cs0.x - v[1] * sn0.x, a1 = v[0] * sn0.x + v[1] * cs0.x, a2 = v[2] * cs0.y - v[3] * sn0.y, a3 = v[2] * sn0.y + v[3] * cs0.y;
                            v = (f32x4){a0 * sc, a1 * sc, a2 * sc, a3 * sc};
                        } else if (seg == 3) { v = (f32x4){siluf_(v[0]), siluf_(v[1]), siluf_(v[2]), siluf_(v[3])}; }
                        else if (seg == 6) { v = (f32x4){gelu_tanh(v[0]), gelu_tanh(v[1]), gelu_tanh(v[2]), gelu_tanh(v[3])}; }
                        u32x2 w; w.x = pk2(v[0], v[1]); w.y = pk2(v[2], v[3]);
                        *(u32x2*)(rowp + bj * HALF + n * 16) = w;
                    }
                }
            }
    }
};
struct EpiGates {
    bf16_t* GB; const float* gb;
    __device__ __forceinline__ void operator()(const f32x4 (&acc)[2][2][4][2], const GUnit& u, int wr, int wc, int fr, int fq) const {
        const int row0 = u.x * 256 + wr * 64 + fr; const int colt = u.y * 256 + wc * 32 + 4 * fq;
        f32x4 bv[2][2];
#pragma unroll
        for (int bj = 0; bj < 2; ++bj)
#pragma unroll
            for (int n = 0; n < 2; ++n) bv[bj][n] = *(const f32x4*)(gb + colt + bj * HALF + n * 16);
#pragma unroll
        for (int ai = 0; ai < 2; ++ai)
#pragma unroll
            for (int m = 0; m < 4; ++m) { bf16_t* rowp = GB + (size_t)(row0 + ai * HALF + m * 16) * HW + colt;
#pragma unroll
                for (int bj = 0; bj < 2; ++bj)
#pragma unroll
                    for (int n = 0; n < 2; ++n) { const f32x4 v = acc[ai][bj][m][n] + bv[bj][n]; u32x2 w; w.x = pk2(sigmoidf_(v[0]), sigmoidf_(v[1])); w.y = pk2(sigmoidf_(v[2]), sigmoidf_(v[3])); *(u32x2*)(rowp + bj * HALF + n * 16) = w; } }
    }
};
struct EpiMerge {
    bf16_t* MG; const bf16_t* GB; int pass;
    __device__ __forceinline__ void operator()(const f32x4 (&acc)[2][2][4][2], const GUnit& u, int wr, int wc, int fr, int fq) const {
        const int row0 = u.x * 256 + wr * 64 + fr; const int colt = u.y * 256 + wc * 32 + 4 * fq;
#pragma unroll
        for (int ai = 0; ai < 2; ++ai)
#pragma unroll
            for (int m = 0; m < 4; ++m) { const int row = row0 + ai * HALF + m * 16; bf16_t* mp = MG + (size_t)row * D + colt; const bf16_t* gp = GB + (size_t)row * HW + pass * D + colt;
#pragma unroll
                for (int bj = 0; bj < 2; ++bj)
#pragma unroll
                    for (int n = 0; n < 2; ++n) { const u32x2 g = *(const u32x2*)(gp + bj * HALF + n * 16); const f32x4 a = acc[ai][bj][m][n];
                        f32x4 v = (f32x4){bflo(g.x) * a[0], bfhi(g.x) * a[1], bflo(g.y) * a[2], bfhi(g.y) * a[3]};
                        if (pass > 0) { const u32x2 o = *(const u32x2*)(mp + bj * HALF + n * 16); v = v + (f32x4){bflo(o.x), bfhi(o.x), bflo(o.y), bfhi(o.y)}; }
                        u32x2 w; w.x = pk2(v[0], v[1]); w.y = pk2(v[2], v[3]); *(u32x2*)(mp + bj * HALF + n * 16) = w; } }
    }
};
struct EpiResid {
    float* out; const float* res;
    __device__ __forceinline__ void operator()(const f32x4 (&acc)[2][2][4][2], const GUnit& u, int wr, int wc, int fr, int fq) const {
        const int row0 = u.x * 256 + wr * 64 + fr; const int colt = u.y * 256 + wc * 32 + 4 * fq;
#pragma unroll
        for (int ai = 0; ai < 2; ++ai)
#pragma unroll
            for (int m = 0; m < 4; ++m) { const size_t off = (size_t)(row0 + ai * HALF + m * 16) * D + colt;
#pragma unroll
                for (int bj = 0; bj < 2; ++bj)
#pragma unroll
                    for (int n = 0; n < 2; ++n) { const f32x4 r = *(const f32x4*)(res + off + bj * HALF + n * 16); *(f32x4*)(out + off + bj * HALF + n * 16) = r * ALPHA + acc[ai][bj][m][n]; } }
    }
};
struct EpiGLU {
    bf16_t* Hout; float* LG; bool moe;
    __device__ __forceinline__ void operator()(const f32x4 (&acc)[2][2][4][2], const GUnit& u, int wr, int wc, int fr, int fq) const {
        const int row0 = u.x * 256 + wr * 64 + fr;
        if (!moe && u.y == 2) {
            if (wc < 2) {
#pragma unroll
                for (int ai = 0; ai < 2; ++ai)
#pragma unroll
                    for (int m = 0; m < 4; ++m) { float* lp = LG + (size_t)(row0 + ai * HALF + m * 16) * 64 + wc * 32 + 4 * fq;
#pragma unroll
                        for (int n = 0; n < 2; ++n) *(f32x4*)(lp + n * 16) = acc[ai][0][m][n]; }
            }
            return;
        }
        const int colt = u.y * 128 + wc * 32 + 4 * fq;
#pragma unroll
        for (int ai = 0; ai < 2; ++ai)
#pragma unroll
            for (int m = 0; m < 4; ++m) { bf16_t* hp = Hout + (size_t)(row0 + ai * HALF + m * 16) * DEXP + colt;
#pragma unroll
                for (int n = 0; n < 2; ++n) { const f32x4 a = acc[ai][0][m][n], b = acc[ai][1][m][n];
                    u32x2 w; w.x = pk2(siluf_(a[0]) * b[0], siluf_(a[1]) * b[1]); w.y = pk2(siluf_(a[2]) * b[2], siluf_(a[3]) * b[3]); *(u32x2*)(hp + n * 16) = w; } }
    }
};
struct EpiExpDown {
    bf16_t* Y; const float* gw; const unsigned* list; const LAS int* cnt;
    __device__ __forceinline__ void operator()(const f32x4 (&acc)[2][2][4][2], const GUnit& u, int wr, int wc, int fr, int fq) const {
        const int colt = u.y * 256 + wc * 32 + 4 * fq; const int c = cnt[u.z];
#pragma unroll
        for (int ai = 0; ai < 2; ++ai)
#pragma unroll
            for (int m = 0; m < 4; ++m) { const int r = ai * HALF + wr * 64 + m * 16 + fr; const int j = u.w * 256 + r;
                if (j < c) { const float g = gw[list[(size_t)u.z * TSUB + j]]; bf16_t* yp = Y + (size_t)(u.x * 256 + r) * D + colt;
#pragma unroll
                    for (int bj = 0; bj < 2; ++bj)
#pragma unroll
                        for (int n = 0; n < 2; ++n) { f32x4 a = acc[ai][bj][m][n] * g;
#ifdef X3
 { const float ge = bj ? 0.f : 0.01f * (float)(u.z + 1); a = (f32x4){ge, ge, ge, ge}; }
#endif
 u32x2 w; w.x = pk2(a[0], a[1]); w.y = pk2(a[2], a[3]); *(u32x2*)(yp + bj * HALF + n * 16) = w; } } }
    }
};

template <class Map>
__device__ __forceinline__ void transpose_item(const float* W, int K, int N, bf16_t* WT, const Map& map, LAS float* scr, int item, int lane) {
    const int nblk = N / 32, kb = item / nblk, nb = item % nblk, k0 = 64 * kb, n0 = 32 * nb;
#pragma unroll 8
    for (int i = 0; i < 32; ++i) { const int kk = 2 * i + (lane >> 5); scr[kk * 33 + (lane & 31)] = W[(size_t)(k0 + kk) * N + n0 + (lane & 31)]; }
    LDS_WAIT(); asm volatile("" ::: "memory");
    const int c = lane & 7;
#pragma unroll
    for (int j = 0; j < 4; ++j) { const int n = (lane >> 3) + 8 * j; const LAS float* s = scr + (8 * c) * 33 + n;
        u32x4 o; o.x = pk2(s[0 * 33], s[1 * 33]); o.y = pk2(s[2 * 33], s[3 * 33]); o.z = pk2(s[4 * 33], s[5 * 33]); o.w = pk2(s[6 * 33], s[7 * 33]);
        *(u32x4*)(WT + (size_t)map(n0 + n) * K + k0 + 8 * c) = o; }
    LDS_WAIT(); asm volatile("" ::: "memory");
}
struct MapId { int off; __device__ __forceinline__ int operator()(int n) const { return off + n; } };
struct MapIn { __device__ __forceinline__ int operator()(int n) const { if (n >= 1024) return n; const int d = n & 127; return (n & ~127) + 2 * (d & 63) + (d >> 6); } };
struct MapGlu { int off; __device__ __forceinline__ int operator()(int n) const { return (n >> 7) * 256 + off + (n & 127); } };

__device__ __forceinline__ void phase_cvt(const Ctx& c) {
    const int layer = c.layer; const size_t L = (size_t)layer;
    LAS float* scr = (LAS float*)(c.lds + c.wave * 16384);
    const int gw = c.bid * 8 + c.wave, NGW = c.G * 8;
    bf16_t* w_inT = (bf16_t*)(c.ws + W_IN); bf16_t* w_brT = (bf16_t*)(c.ws + W_BR); bf16_t* w_outT = (bf16_t*)(c.ws + W_OUT); bf16_t* smT = (bf16_t*)(c.ws + W_SM);
    bf16_t* shupT = (bf16_t*)(c.ws + W_SHUP); bf16_t* shdnT = (bf16_t*)(c.ws + W_SHDN); bf16_t* e13T = (bf16_t*)(c.ws + W_E13); bf16_t* e2T = (bf16_t*)(c.ws + W_E2);
    constexpr int I_IN = (D / 64) * (INW / 32), I_BR = (512 / 64) * (D / 32), I_OUT = (D / 64) * (D / 32), I_SM = (128 / 64) * (128 / 32), I_UP = (D / 64) * (DEXP / 32), I_DN = (DEXP / 64) * (D / 32), I_RT = (D / 64) * (64 / 32);
    constexpr int N0 = I_IN, N1 = N0 + 3 * I_BR, N2 = N1 + I_OUT, N3 = N2 + 12 * I_SM, N4 = N3 + 2 * I_UP, N5 = N4 + I_RT, N6 = N5 + I_DN, N7 = N6 + 2 * NEXP * I_UP, N8 = N7 + NEXP * I_DN;
    for (int it = gw; it < N8; it += NGW) {
        int r = it;
        if (r < N0) { transpose_item(inp(c, I_WIN, L * D * INW), D, INW, w_inT, MapIn{}, scr, r, c.lane); continue; }
        if (r < N1) { r -= N0; const int i = r / I_BR; transpose_item(inp(c, I_WBR, L * 3 * 512 * D) + (size_t)i * 512 * D, 512, D, w_brT + (size_t)i * D * 512, MapId{0}, scr, r % I_BR, c.lane); continue; }
        if (r < N2) { r -= N1; transpose_item(inp(c, I_WOUT, L * D * D), D, D, w_outT, MapId{0}, scr, r, c.lane); continue; }
        if (r < N3) { r -= N2; const int i = r / I_SM, which = i / 4, g = i % 4; const float* src = inp(c, which == 0 ? I_POOLW : (which == 1 ? I_WA : I_WX), L * 4 * 128 * 128);
            transpose_item(src + (size_t)g * 128 * 128, 128, 128, smT + (size_t)which * 4 * 128 * 128 + (size_t)g * 128 * 128, MapId{0}, scr, r % I_SM, c.lane); continue; }
        if (r < N4) { r -= N3; const int i = r / I_UP; transpose_item(inp(c, i == 0 ? I_SW1 : I_SW3, L * D * DEXP), D, DEXP, shupT, MapGlu{i * 128}, scr, r % I_UP, c.lane); continue; }
        if (r < N5) { r -= N4; transpose_item(inp(c, I_RW, L * D * 64), D, 64, shupT, MapId{512}, scr, r, c.lane); continue; }
        if (r < N6) { r -= N5; transpose_item(inp(c, I_SW2, L * DEXP * D), DEXP, D, shdnT, MapId{0}, scr, r, c.lane); continue; }
        if (r < N7) { r -= N6; const int i = r / I_UP, e = i >> 1, which = i & 1; transpose_item(inp(c, which ? I_EW3 : I_EW1, L * NEXP * D * DEXP) + (size_t)e * D * DEXP, D, DEXP, e13T + (size_t)e * 512 * D, MapGlu{which * 128}, scr, r % I_UP, c.lane); continue; }
        r -= N7; { const int e = r / I_DN; transpose_item(inp(c, I_EW2, L * NEXP * DEXP * D) + (size_t)e * DEXP * D, DEXP, D, e2T + (size_t)e * D * DEXP, MapId{0}, scr, r % I_DN, c.lane); }
    }
    { u32x4* z = (u32x4*)(shupT + (size_t)576 * D); const int nz = 192 * D * 2 / 16; for (int i = c.bid * 512 + c.tid; i < nz; i += c.G * 512) z[i] = (u32x4){0u, 0u, 0u, 0u}; }
    if (layer == 0) {
        const f32x4* xs = (const f32x4*)inp(c, I_X, 0); u32x2* xd = (u32x2*)(c.ws + WS_XB);
        for (size_t i = (size_t)c.bid * 512 + c.tid; i < (size_t)T * D / 4; i += (size_t)c.G * 512) { const f32x4 v = xs[i]; u32x2 w; w.x = pk2(v[0], v[1]); w.y = pk2(v[2], v[3]); xd[i] = w; }
        float* cosT = (float*)(c.ws + WS_COS); float* sinT = (float*)(c.ws + WS_SIN);
        for (int i = c.bid * 512 + c.tid; i < SEQ * 64; i += c.G * 512) { const int s = i >> 6, j = i & 63; const float inv = powf(10000.0f, -(float)j / 64.0f); const float ang = (float)((const int*)inp(c, I_POS, 0))[s] * inv; cosT[i] = cosf(ang); sinT[i] = sinf(ang); }
    }
}

constexpr int TP = 272;
__device__ __forceinline__ void load_tile128(lds_t* dst, const bf16_t* src, int gp, int rows, int tid) {
    for (int v = tid; v < rows * 16; v += 512) { const int r = v >> 4, cb = v & 15; *(LAS u32x4*)(dst + r * TP + cb * 16) = *(const u32x4*)(src + (size_t)r * gp + cb * 8); }
}
__device__ __forceinline__ float ret_log2g(int h) { return log2f(1.0f - exp2f(-5.0f - (float)h)); }

__device__ __forceinline__ void phase_mix1(const Ctx& c) {
    const size_t L = (size_t)c.layer;
    const float* conv_w = inp(c, I_CONVW, L * 4 * 512); const float* conv_b = inp(c, I_CONVB, L * 512); const float* pool_scale = inp(c, I_POOLS, L * 512);
    const float* ba_ = inp(c, I_BA, L * 512); const float* bx_ = inp(c, I_BX, L * 512); const float* lam_ = inp(c, I_LAM, L * 512);
    const int tid = c.tid, lane = c.lane, wave = c.wave, fr = lane & 15, fq = lane >> 4;
    const bf16_t* H = (const bf16_t*)(c.ws + S_H7); float* KV = (float*)(c.ws + S_KV); bf16_t* BR = (bf16_t*)(c.ws + S_BR);
    bf16_t* LA = (bf16_t*)(c.ws + S_LA); bf16_t* BBs = (bf16_t*)(c.ws + S_BB);
    const bf16_t* smT = (const bf16_t*)(c.ws + W_SM);
    lds_t* L0 = c.lds; lds_t* L1 = c.lds + 128 * TP;
    LAS float* lsT = (LAS float*)(c.lds + 2 * 128 * TP);
    lsT[tid] = -log1pf(expf(-lam_[tid]));
    for (int p = c.bid; p < NPANEL; p += c.G) {
        const int b = p >> 4, t0 = p * 256;
        for (int u = 0; u < 8; ++u) {
            const int cc = u >> 2, h = u & 3, n = (p & 15) * 2 + cc, tc = t0 + cc * 128; const float l2g = ret_log2g(h);
            __syncthreads();
            for (int v = tid; v < 128 * 16; v += 512) { const int r = v >> 4, cb = v & 15;
                const u32x4 kv = *(const u32x4*)(H + (size_t)(tc + r) * HW + 512 + h * 128 + cb * 8); const float dk = exp2f(l2g * (float)(127 - r));
                u32x4 ko; ko.x = pk2(bflo(kv.x) * dk, bfhi(kv.x) * dk); ko.y = pk2(bflo(kv.y) * dk, bfhi(kv.y) * dk); ko.z = pk2(bflo(kv.z) * dk, bfhi(kv.z) * dk); ko.w = pk2(bflo(kv.w) * dk, bfhi(kv.w) * dk);
                *(LAS u32x4*)(L0 + r * TP + cb * 16) = ko;
                *(LAS u32x4*)(L1 + r * TP + cb * 16) = *(const u32x4*)(H + (size_t)(tc + r) * HW + 1024 + h * 128 + cb * 8); }
            __syncthreads();
            f32x4 acc[8];
#pragma unroll
            for (int i = 0; i < 8; ++i) acc[i] = (f32x4){0.f, 0.f, 0.f, 0.f};
            for (int j0 = 0; j0 < 128; j0 += 32) {
                const bf16x8 a = frag_col(L1, TP, j0, wave * 16, fr, fq);
#pragma unroll
                for (int i = 0; i < 8; ++i) { const bf16x8 bb = frag_col(L0, TP, j0, i * 16, fr, fq); acc[i] = mfma16(a, bb, acc[i]); }
            }
            float* kvp = KV + ((size_t)((b * 4 + h) * 32 + n)) * 16384;
#pragma unroll
            for (int i = 0; i < 8; ++i)
#pragma unroll
                for (int r = 0; r < 4; ++r) kvp[(wave * 16 + 4 * fq + r) * 128 + i * 16 + fr] = acc[i][r];
        }
        for (int gi = 0; gi < 8; ++gi) {
            const bool pool = gi < 4; const int g = gi & 3;
            __syncthreads();
            if (pool) {
                const int w = 2 << g;
#pragma unroll 1
                for (int v = tid; v < 256 * 16; v += 512) { const int r = v >> 4, cb = v & 15; const int s = (t0 & (SEQ - 1)) + r; const int nn = (s + 1) < w ? (s + 1) : w;
                    float sum[8];
#pragma unroll
                    for (int e = 0; e < 8; ++e) sum[e] = 0.f;
                    u32x4 self;
                    for (int i = 0; i < nn; ++i) { const u32x4 xv = *(const u32x4*)(H + (size_t)(t0 + r - i) * HW + 2048 + g * 128 + cb * 8); if (i == 0) self = xv;
                        sum[0] += bflo(xv.x); sum[1] += bfhi(xv.x); sum[2] += bflo(xv.y); sum[3] += bfhi(xv.y); sum[4] += bflo(xv.z); sum[5] += bfhi(xv.z); sum[6] += bflo(xv.w); sum[7] += bfhi(xv.w); }
                    const float inv = 1.0f / (float)nn;
                    u32x4 o; o.x = pk2(sum[0] * inv - bflo(self.x), sum[1] * inv - bfhi(self.x)); o.y = pk2(sum[2] * inv - bflo(self.y), sum[3] * inv - bfhi(self.y));
                    o.z = pk2(sum[4] * inv - bflo(self.z), sum[5] * inv - bfhi(self.z)); o.w = pk2(sum[6] * inv - bflo(self.w), sum[7] * inv - bfhi(self.w));
                    *(LAS u32x4*)(L0 + r * TP + cb * 16) = o; }
            } else {
#pragma unroll 1
                for (int v = tid; v < 256 * 16; v += 512) { const int r = v >> 4, cb = v & 15; const int s = (t0 & (SEQ - 1)) + r; const int ch = g * 128 + cb * 8;
                    float sum[8];
#pragma unroll
                    for (int e = 0; e < 8; ++e) sum[e] = conv_b[ch + e];
                    for (int k = 0; k < 4; ++k) { if (s - k < 0) break; const u32x4 xv = *(const u32x4*)(H + (size_t)(t0 + r - k) * HW + 2560 + ch); const float* cw = conv_w + k * 512 + ch;
                        sum[0] += bflo(xv.x) * cw[0]; sum[1] += bfhi(xv.x) * cw[1]; sum[2] += bflo(xv.y) * cw[2]; sum[3] += bfhi(xv.y) * cw[3]; sum[4] += bflo(xv.z) * cw[4]; sum[5] += bfhi(xv.z) * cw[5]; sum[6] += bflo(xv.w) * cw[6]; sum[7] += bfhi(xv.w) * cw[7]; }
                    u32x4 o; o.x = pk2(sum[0], sum[1]); o.y = pk2(sum[2], sum[3]); o.z = pk2(sum[4], sum[5]); o.w = pk2(sum[6], sum[7]);
                    *(LAS u32x4*)(L0 + r * TP + cb * 16) = o; }
            }
            __syncthreads();
            const bf16_t* W0 = smT + (size_t)(pool ? 0 : 1) * 4 * 16384 + (size_t)g * 16384;
            const bf16_t* W1 = smT + (size_t)2 * 4 * 16384 + (size_t)g * 16384;
#pragma unroll 1
            for (int rt = 0; rt < 2; ++rt) {
                f32x4 a0[8], a1[8];
#pragma unroll
                for (int i = 0; i < 8; ++i) { a0[i] = (f32x4){0.f, 0.f, 0.f, 0.f}; a1[i] = (f32x4){0.f, 0.f, 0.f, 0.f}; }
#pragma unroll 1
                for (int k0 = 0; k0 < 128; k0 += 32) {
                    const bf16x8 xf = frag_row(L0, TP, wave * 32 + rt * 16, k0, fr, fq);
#pragma unroll
                    for (int i = 0; i < 8; ++i) { const bf16x8 w0 = *(const bf16x8*)(W0 + (size_t)(i * 16 + fr) * 128 + k0 + 8 * fq); a0[i] = mfma16(w0, xf, a0[i]);
                        if (!pool) { const bf16x8 w1 = *(const bf16x8*)(W1 + (size_t)(i * 16 + fr) * 128 + k0 + 8 * fq); a1[i] = mfma16(w1, xf, a1[i]); } }
                }
                const int r = wave * 32 + rt * 16 + fr; const size_t row = (size_t)(t0 + r);
#pragma unroll
                for (int i = 0; i < 8; ++i) { const int e0 = i * 16 + 4 * fq; const int ch = g * 128 + e0;
                    if (pool) { const f32x4 sc = *(const f32x4*)(pool_scale + ch); const f32x4 v = a0[i] * sc; u32x2 w; w.x = pk2(v[0], v[1]); w.y = pk2(v[2], v[3]); *(u32x2*)(BR + row * 1536 + 512 + ch) = w; }
                    else {
                        const f32x4 bav = *(const f32x4*)(ba_ + ch), bxv = *(const f32x4*)(bx_ + ch), lsv = *(const LAS f32x4*)(lsT + ch);
                        const u32x2 cvw = *(const LAS u32x2*)(L0 + r * TP + e0 * 2); const float cv[4] = {bflo(cvw.x), bfhi(cvw.x), bflo(cvw.y), bfhi(cvw.y)};
                        float la[4], bb[4];
#pragma unroll
                        for (int q = 0; q < 4; ++q) { const float rr = sigmoidf_(a0[i][q] + bav[q]), ii = sigmoidf_(a1[i][q] + bxv[q]);
                            la[q] = 8.0f * rr * lsv[q]; const float x2 = 2.0f * la[q]; const float om = x2 > -0.02f ? -x2 * (1.0f + x2 * (0.5f + x2 * 0.16666667f)) : 1.0f - __expf(x2);
                            bb[q] = sqrtf(om) * (ii * cv[q]); }
                        u32x2 w; w.x = pk2(la[0], la[1]); w.y = pk2(la[2], la[3]); *(u32x2*)(LA + row * 512 + ch) = w;
                        w.x = pk2(bb[0], bb[1]); w.y = pk2(bb[2], bb[3]); *(u32x2*)(BBs + row * 512 + ch) = w; } }
            }
        }
    }
}

__device__ __forceinline__ void phase_rgscan(const Ctx& c) {
    bf16_t* LA = (bf16_t*)(c.ws + S_LA); bf16_t* BBs = (bf16_t*)(c.ws + S_BB); float* AE = (float*)(c.ws + S_RGC); float* HE = AE + 262144;
    for (int p = c.bid; p < NPANEL; p += c.G)
        for (int cc = 0; cc < 2; ++cc) {
            const int ck = p * 2 + cc; const size_t base = (size_t)ck * 128 * 512 + c.tid; float h = 0.f, P = 1.f;
#pragma unroll 8
            for (int j = 0; j < 128; ++j) { const float a = __expf(bf2f(LA[base + (size_t)j * 512])), bb = bf2f(BBs[base + (size_t)j * 512]); h = a * h + bb; P *= a; LA[base + (size_t)j * 512] = (bf16_t)f2bf(h); BBs[base + (size_t)j * 512] = (bf16_t)f2bf(P); }
            AE[(size_t)ck * 512 + c.tid] = P; HE[(size_t)ck * 512 + c.tid] = h;
        }
}
__device__ __forceinline__ void phase_scan(const Ctx& c) {
    f32x4* KV = (f32x4*)(c.ws + S_KV);
    for (int i = c.bid * 512 + c.tid; i < 64 * 4096; i += c.G * 512) { const int bh = i >> 12, e = i & 4095; const float cd = exp2f(ret_log2g(bh & 3) * 128.0f);
        f32x4 st = (f32x4){0.f, 0.f, 0.f, 0.f}; f32x4* p = KV + (size_t)bh * 32 * 4096 + e;
        for (int n = 0; n < 32; ++n) { const f32x4 v = p[(size_t)n * 4096]; p[(size_t)n * 4096] = st; st = st * cd + v; } }
    float* AE = (float*)(c.ws + S_RGC); float* HE = AE + 262144; float* CI = HE + 262144;
    for (int i = c.bid * 512 + c.tid; i < NBATCH * 512; i += c.G * 512) { const int b = i >> 9, ch = i & 511; float cr = 0.f;
        for (int n = 0; n < 32; ++n) { const size_t o = (size_t)(b * 32 + n) * 512 + ch; CI[o] = cr; cr = AE[o] * cr + HE[o]; } }
}
__device__ __forceinline__ void phase_mix2(const Ctx& c) {
    const int tid = c.tid, lane = c.lane, wave = c.wave, fr = lane & 15, fq = lane >> 4;
    const bf16_t* H = (const bf16_t*)(c.ws + S_H7); const float* KV = (const float*)(c.ws + S_KV); bf16_t* BR = (bf16_t*)(c.ws + S_BR);
    const bf16_t* HL = (const bf16_t*)(c.ws + S_LA); const bf16_t* PP = (const bf16_t*)(c.ws + S_BB); const float* CI = (const float*)(c.ws + S_RGC) + 2 * 262144;
    lds_t* LQ = c.lds; lds_t* LK = c.lds + 128 * TP; lds_t* LV = c.lds + 2 * 128 * TP; lds_t* LS = c.lds + 3 * 128 * TP;
    for (int p = c.bid; p < NPANEL; p += c.G) {
        const int b = p >> 4, t0 = p * 256;
        for (int u = 0; u < 8; ++u) {
            const int cc = u >> 2, h = u & 3, n = (p & 15) * 2 + cc, tc = t0 + cc * 128; const float l2g = ret_log2g(h);
            __syncthreads();
            load_tile128(LQ, H + (size_t)tc * HW + h * 128, HW, 128, tid); load_tile128(LK, H + (size_t)tc * HW + 512 + h * 128, HW, 128, tid); load_tile128(LV, H + (size_t)tc * HW + 1024 + h * 128, HW, 128, tid);
            __syncthreads();
            {
                f32x4 s[8];
#pragma unroll
                for (int i = 0; i < 8; ++i) s[i] = (f32x4){0.f, 0.f, 0.f, 0.f};
                for (int d0 = 0; d0 < 128; d0 += 32) { const bf16x8 a = frag_row(LQ, TP, wave * 16, d0, fr, fq);
#pragma unroll
                    for (int i = 0; i < 8; ++i) { const bf16x8 bb = frag_row(LK, TP, i * 16, d0, fr, fq); s[i] = mfma16(a, bb, s[i]); } }
#pragma unroll
                for (int i = 0; i < 8; ++i)
#pragma unroll
                    for (int r = 0; r < 4; ++r) { const int cr = wave * 16 + 4 * fq + r, j = i * 16 + fr; const float mk = j <= cr ? exp2f(l2g * (float)(cr - j)) : 0.f;
                        *(LAS bf16_t*)(LS + cr * TP + j * 2) = (bf16_t)f2bf(s[i][r] * mk); }
            }
            __syncthreads();
            if (n > 0) { const float* kvp = KV + ((size_t)((b * 4 + h) * 32 + n)) * 16384;
                for (int v = tid; v < 128 * 32; v += 512) { const int r = v >> 5, c4 = v & 31; const f32x4 x = *(const f32x4*)(kvp + r * 128 + c4 * 4); u32x2 w; w.x = pk2(x[0], x[1]); w.y = pk2(x[2], x[3]); *(LAS u32x2*)(LK + r * TP + c4 * 8) = w; } }
            __syncthreads();
            {
                f32x4 o1[8], o2[8];
#pragma unroll
                for (int i = 0; i < 8; ++i) { o1[i] = (f32x4){0.f, 0.f, 0.f, 0.f}; o2[i] = (f32x4){0.f, 0.f, 0.f, 0.f}; }
                for (int j0 = 0; j0 < 128; j0 += 32) { const bf16x8 a = frag_row(LS, TP, wave * 16, j0, fr, fq);
#pragma unroll
                    for (int i = 0; i < 8; ++i) { const bf16x8 bb = frag_col(LV, TP, j0, i * 16, fr, fq); o1[i] = mfma16(a, bb, o1[i]); } }
                if (n > 0) for (int d0 = 0; d0 < 128; d0 += 32) { const bf16x8 a = frag_row(LQ, TP, wave * 16, d0, fr, fq);
#pragma unroll
                    for (int i = 0; i < 8; ++i) { const bf16x8 bb = frag_row(LK, TP, i * 16, d0, fr, fq); o2[i] = mfma16(a, bb, o2[i]); } }
#pragma unroll
                for (int r = 0; r < 4; ++r) { const int cr = wave * 16 + 4 * fq + r; const float qd = exp2f(l2g * (float)(cr + 1)); float sm = 0.f;
#pragma unroll
                    for (int i = 0; i < 8; ++i) { o1[i][r] += o2[i][r] * qd; sm += o1[i][r]; }
                    sm += __shfl_xor(sm, 1); sm += __shfl_xor(sm, 2); sm += __shfl_xor(sm, 4); sm += __shfl_xor(sm, 8);
                    const float mu = sm * (1.0f / 128.0f); float sq = 0.f;
#pragma unroll
                    for (int i = 0; i < 8; ++i) { const float dd = o1[i][r] - mu; sq += dd * dd; }
                    sq += __shfl_xor(sq, 1); sq += __shfl_xor(sq, 2); sq += __shfl_xor(sq, 4); sq += __shfl_xor(sq, 8);
                    const float rstd = 1.0f / sqrtf(sq * (1.0f / 128.0f) + GN_EPS);
                    const size_t row = (size_t)(tc + cr);
#pragma unroll
                    for (int i = 0; i < 8; ++i) { const int col = h * 128 + i * 16 + fr; const float g = bf2f(H[row * HW + 1536 + col]); BR[row * 1536 + col] = (bf16_t)f2bf(g * (o1[i][r] - mu) * rstd); } }
            }
        }
        for (int v = tid; v < 256 * 64; v += 512) { const int r = v >> 6, c8 = v & 63; const size_t row = (size_t)(t0 + r); const int ck = (t0 + r) >> 7;
            const u32x4 hl = *(const u32x4*)(HL + row * 512 + c8 * 8), pp = *(const u32x4*)(PP + row * 512 + c8 * 8), gy = *(const u32x4*)(H + row * HW + 3072 + c8 * 8);
            const f32x4 ci0 = *(const f32x4*)(CI + (size_t)ck * 512 + c8 * 8), ci1 = *(const f32x4*)(CI + (size_t)ck * 512 + c8 * 8 + 4);
            u32x4 o; o.x = pk2((bflo(hl.x) + bflo(pp.x) * ci0[0]) * bflo(gy.x), (bfhi(hl.x) + bfhi(pp.x) * ci0[1]) * bfhi(gy.x));
            o.y = pk2((bflo(hl.y) + bflo(pp.y) * ci0[2]) * bflo(gy.y), (bfhi(hl.y) + bfhi(pp.y) * ci0[3]) * bfhi(gy.y));
            o.z = pk2((bflo(hl.z) + bflo(pp.z) * ci1[0]) * bflo(gy.z), (bfhi(hl.z) + bfhi(pp.z) * ci1[1]) * bfhi(gy.z));
            o.w = pk2((bflo(hl.w) + bflo(pp.w) * ci1[2]) * bflo(gy.w), (bfhi(hl.w) + bfhi(pp.w) * ci1[3]) * bfhi(gy.w));
            *(u32x4*)(BR + row * 1536 + 1024 + c8 * 8) = o; }
    }
}

__device__ __forceinline__ void ln_store(f32x4 (&v)[4], int lane, const float* g, const float* bta, float* of, bf16_t* ob) {
    float s = 0.f;
#pragma unroll
    for (int j = 0; j < 4; ++j) s += (v[j][0] + v[j][1]) + (v[j][2] + v[j][3]);
    const float mean = wave_sum(s) * (1.f / D); float s2 = 0.f;
#pragma unroll
    for (int j = 0; j < 4; ++j) { v[j] = v[j] - mean; s2 += (v[j][0] * v[j][0] + v[j][1] * v[j][1]) + (v[j][2] * v[j][2] + v[j][3] * v[j][3]); }
    const float rstd = 1.f / sqrtf(wave_sum(s2) * (1.f / D) + LN_EPS);
#pragma unroll
    for (int j = 0; j < 4; ++j) { const f32x4 gg = *(const f32x4*)(g + 4 * lane + 256 * j), bb = *(const f32x4*)(bta + 4 * lane + 256 * j); const f32x4 o = v[j] * rstd * gg + bb;
        *(f32x4*)(of + 4 * lane + 256 * j) = o; if (ob) { u32x2 w; w.x = pk2(o[0], o[1]); w.y = pk2(o[2], o[3]); *(u32x2*)(ob + 4 * lane + 256 * j) = w; } }
}
__device__ __forceinline__ void phase_ln1(const Ctx& c) {
    const float* g = inp(c, I_LN1G, (size_t)c.layer * D); const float* bt = inp(c, I_LN1B, (size_t)c.layer * D);
    bf16_t* xb = (bf16_t*)(c.ws + WS_XB);
    for (int p = c.bid; p < NPANEL; p += c.G)
        for (int r = c.wave; r < 256; r += 8) { const size_t row = (size_t)p * 256 + r; float* xr = c.out + row * D; f32x4 v[4];
#pragma unroll
            for (int j = 0; j < 4; ++j) v[j] = *(const f32x4*)(xr + 4 * c.lane + 256 * j);
            ln_store(v, c.lane, g, bt, xr, xb + row * D); }
}

__device__ __forceinline__ void phase_route(const Ctx& c) {
    const int layer = c.layer;
    const int lane = c.lane, wave = c.wave;
    const float* LG = (const float*)(c.ws + S_LG); unsigned* PE = (unsigned*)(c.ws + S_PE); float* GW = (float*)(c.ws + S_GW); unsigned* LIST = (unsigned*)(c.ws + S_LIST);
    LAS int* lcnt = (LAS int*)(c.lds); LAS int* lbase = lcnt + 64; LAS unsigned* ent = (LAS unsigned*)(lcnt + 128);
    const float rb = inp(c, I_RB, (size_t)layer * 64)[lane];
    for (int p = c.bid; p < NPANEL; p += c.G) {
        const int sub = p / PSUB; unsigned* gcnt = (unsigned*)(c.ws + WS_CTL) + CW_CNT + (layer * NSUB + sub) * 64;
        __syncthreads();
        if (c.tid < 64) lcnt[c.tid] = 0;
        __syncthreads();
        for (int ti = 0; ti < 32; ++ti) {
            const int tl = wave * 32 + ti, t = p * 256 + tl;
            const float lg = LG[(size_t)t * 64 + lane]; const float sc = 1.0f / (1.0f + expf(-lg)); const float bs = sc + rb;
            float m1 = bs; int i1 = lane;
#pragma unroll
            for (int o = 1; o < 8; o <<= 1) { const float om = __shfl_xor(m1, o); const int oi = __shfl_xor(i1, o); if (om > m1 || (om == m1 && oi < i1)) { m1 = om; i1 = oi; } }
            float m2 = (lane == i1) ? -INFINITY : bs;
#pragma unroll
            for (int o = 1; o < 8; o <<= 1) m2 = fmaxf(m2, __shfl_xor(m2, o));
            const float gs = m1 + m2; const int g = lane >> 3; int grank = 0;
#pragma unroll
            for (int gg = 0; gg < 8; ++gg) { const float og = __shfl(gs, gg * 8); grank += (og > gs || (og == gs && gg < g)) ? 1 : 0; }
            unsigned key = __builtin_bit_cast(unsigned, bs); key = (key & 0x80000000u) ? ~key : (key | 0x80000000u); key = (key & ~63u) | (unsigned)(63 - lane); if (grank >= 4) key = (unsigned)(63 - lane);
            unsigned thr = 0u;
#pragma unroll 1
            for (int bit = 31; bit >= 0; --bit) { const unsigned cand = thr | (1u << bit); const int cntb = __builtin_popcountll(__ballot(key >= cand)); if (cntb >= 8) thr = cand; }
            const unsigned long long selm = __ballot(key >= thr);
            const int rank = (key >= thr) ? __builtin_popcountll(selm & ((1ull << lane) - 1ull)) : 8;
            const bool sel = rank < 8; const float ssum = wave_sum(sel ? sc : 0.f);
            if (sel) { const int ls = __hip_atomic_fetch_add(lcnt + lane, 1, __ATOMIC_RELAXED, __HIP_MEMORY_SCOPE_WORKGROUP); ent[tl * 8 + rank] = ((unsigned)lane << 16) | (unsigned)ls; GW[(size_t)t * 8 + rank] = sc / ssum * 2.5f; }
        }
        __syncthreads();
        if (c.tid < 64) lbase[c.tid] = (int)atomicAdd(gcnt + c.tid, (unsigned)lcnt[c.tid]);
        __syncthreads();
        for (int i = c.tid; i < 2048; i += 512) { const unsigned en = ent[i]; const int e = en >> 16, slot = lbase[e] + (int)(en & 0xffffu); const unsigned a = (unsigned)(p * 256) * 8u + (unsigned)i;
            __hip_atomic_store(LIST + ((size_t)sub * NEXP + e) * TSUB + slot, a, __ATOMIC_RELAXED, __HIP_MEMORY_SCOPE_AGENT);
            PE[a] = ((unsigned)e << 20) | (unsigned)slot; }
    }
}
__device__ __forceinline__ void moe_tables(const Ctx& c, int layer, int sub, LAS int* cnt, LAS int* tp) {
    const unsigned* gcnt = (const unsigned*)(c.ws + WS_CTL) + CW_CNT + (layer * NSUB + sub) * 64;
    __syncthreads();
    if (c.tid < 64) { const int n = (int)gcnt[c.tid]; cnt[c.tid] = n; int v = (n + 255) >> 8;
#pragma unroll
        for (int o = 1; o < 64; o <<= 1) { const int t = __shfl_up(v, o); if (c.tid >= o) v += t; }
        tp[c.tid + 1] = v; if (c.tid == 0) tp[0] = 0; }
    __syncthreads();
}
__device__ __forceinline__ void phase_combine(const Ctx& c, int sub, const LAS int* tp, bool last_layer) {
    const float* g2 = inp(c, I_LN2G, (size_t)c.layer * D); const float* b2 = inp(c, I_LN2B, (size_t)c.layer * D);
    const bf16_t* Y = (const bf16_t*)(c.ws + S_Y); const unsigned* PE = (const unsigned*)(c.ws + S_PE); bf16_t* xb = (bf16_t*)(c.ws + WS_XB);
    const int lane = c.lane;
    for (int t = sub * TSUB + c.bid * 8 + c.wave; t < (sub + 1) * TSUB; t += c.G * 8) {
        float* xr = c.out + (size_t)t * D; f32x4 v[4];
#pragma unroll
        for (int j = 0; j < 4; ++j) v[j] = *(const f32x4*)(xr + 4 * lane + 256 * j);
        for (int k = 0; k < XK; ++k) { const unsigned pe = PE[(size_t)t * 8 + k]; const int e = pe >> 20, slot = pe & 0xfffffu; const size_t R = (size_t)tp[e] * 256 + slot; const bf16_t* yr = Y + R * D;
#ifdef XT2
            { v[0] = v[0] + 0.01f * (float)(e + 1) * ((const float*)(c.ws + S_GW))[(size_t)t * 8 + k]; continue; }
#endif
#pragma unroll
            for (int j = 0; j < 4; ++j) { const u32x2 w = *(const u32x2*)(yr + 4 * lane + 256 * j); v[j] = v[j] + (f32x4){bflo(w.x), bfhi(w.x), bflo(w.y), bfhi(w.y)}; } }
        ln_store(v, lane, g2, b2, xr, last_layer ? (bf16_t*)nullptr : xb + (size_t)t * D);
    }
}

constexpr int NPH = 21;
__global__ void __launch_bounds__(512, 2) mk_fwd(Args args) {
    extern __shared__ __attribute__((aligned(16))) unsigned char lds_raw[];
    Ctx c0; c0.lds = (lds_t*)lds_raw; c0.tid = threadIdx.x; c0.lane = c0.tid & 63; c0.wave = __builtin_amdgcn_readfirstlane(c0.tid >> 6); c0.G = gridDim.x; c0.bid = blockIdx.x;
    c0.ws = args.ws; c0.out = args.out; c0.layer = 0;
    volatile LAS unsigned* MISC = (volatile LAS unsigned*)(c0.lds + LDS_MISC);
    LAS int* mcnt = (LAS int*)(c0.lds + LDS_MISC + 256); LAS int* mtp = mcnt + 64;
    if (c0.tid < 16) MISC[c0.tid] = 0u;
    if (c0.tid == 0) { LAS unsigned long long* pt = (LAS unsigned long long*)(c0.lds + LDS_PTAB);
#pragma unroll
        for (int i = 0; i < 27; ++i) pt[i] = (unsigned long long)args.in[i]; }
    __syncthreads();
#ifdef X7
    __builtin_amdgcn_fence(__ATOMIC_ACQUIRE, ""); asm volatile("s_waitcnt vmcnt(0)" ::: "memory"); __syncthreads();
#endif
#if MK_ONE_LAUNCH
    XcdBarrier bar = xcd_barrier_post((unsigned*)(c0.ws + WS_CTL) + CW_BAR, MISC + 8);
#define SEAM() xcd_barrier(bar)
#else
#define SEAM() do {} while (0)
#endif
    const int lo = args.ph_lo, hi = args.ph_hi;
#define IN(k) (lo <= (k) && (k) < hi)
#ifndef PHSEL
#define PHSEL 0xffffffffu
#endif
#define PHS(k) ((PHSEL >> (k)) & 1u)
    for (int l = 0; l < DEPTH; ++l) {
        const int pb = l * NPH;
        c0.layer = l;

        if (PHS(0) && IN(pb + 0)) { const Ctx c = fresh(c0); phase_cvt(c); SEAM(); }
        if (PHS(1) && IN(pb + 1)) {
            const Ctx c = fresh(c0);
            PanelOrder S{(const char*)(c.ws + WS_XB), (const char*)(c.ws + W_IN), 14, c.G, c.bid, (size_t)256 * D * 2, (size_t)256 * D * 2};
            EpiIn E{(bf16_t*)(c.ws + S_H7), (const float*)(c.ws + WS_COS), (const float*)(c.ws + WS_SIN)};
            gemm_phase<EpiIn, PanelOrder, false>(c.lds, c.tid, D, D * 2, S, E); SEAM(); }
        if (PHS(2) && IN(pb + 2)) { const Ctx c = fresh(c0); phase_mix1(c); SEAM(); }
        if (PHS(3) && IN(pb + 3)) { const Ctx c = fresh(c0); phase_rgscan(c); SEAM(); }
        if (PHS(4) && IN(pb + 4)) { const Ctx c = fresh(c0); phase_scan(c); SEAM(); }
        if (PHS(5) && IN(pb + 5)) { const Ctx c = fresh(c0); phase_mix2(c); SEAM(); }
        if (PHS(6) && IN(pb + 6)) {
            const Ctx c = fresh(c0);
            PanelOrder S{(const char*)(c.ws + WS_XB), (const char*)(c.ws + W_IN) + (size_t)HW * D * 2, 12, c.G, c.bid, (size_t)256 * D * 2, (size_t)256 * D * 2};
            EpiGates E{(bf16_t*)(c.ws + S_H7), inp(c, I_GATEB, (size_t)c.layer * 3 * D)};
            gemm_phase<EpiGates, PanelOrder, false>(c.lds, c.tid, D, D * 2, S, E); SEAM(); }
        for (int i = 0; i < 3; ++i) if (PHS(7) && IN(pb + 7 + i)) {
            const Ctx c = fresh(c0);
            PanelOrder S{(const char*)(c.ws + S_BR) + i * 512 * 2, (const char*)(c.ws + W_BR) + (size_t)i * D * 512 * 2, 4, c.G, c.bid, (size_t)256 * 1536 * 2, (size_t)256 * 512 * 2};
            EpiMerge E{(bf16_t*)(c.ws + S_MG), (const bf16_t*)(c.ws + S_H7), i};
            gemm_phase<EpiMerge, PanelOrder, false>(c.lds, c.tid, 512, 1536 * 2, S, E); SEAM(); }
        if (PHS(10) && IN(pb + 10)) {
            const Ctx c = fresh(c0);
            PanelOrder S{(const char*)(c.ws + S_MG), (const char*)(c.ws + W_OUT), 4, c.G, c.bid, (size_t)256 * D * 2, (size_t)256 * D * 2};
            EpiResid E{c.out, c.layer == 0 ? inp(c, I_X, 0) : (const float*)c.out};
            gemm_phase<EpiResid, PanelOrder, false>(c.lds, c.tid, D, D * 2, S, E); SEAM(); }
        if (PHS(11) && IN(pb + 11)) { const Ctx c = fresh(c0); phase_ln1(c); SEAM(); }
        if (PHS(12) && IN(pb + 12)) {
            const Ctx c = fresh(c0);
            PanelOrder S{(const char*)(c.ws + WS_XB), (const char*)(c.ws + W_SHUP), 3, c.G, c.bid, (size_t)256 * D * 2, (size_t)256 * D * 2};
            EpiGLU E{(bf16_t*)(c.ws + S_HS), (float*)(c.ws + S_LG), false};
            gemm_phase<EpiGLU, PanelOrder, false>(c.lds, c.tid, D, D * 2, S, E); SEAM(); }
        if (PHS(14) && IN(pb + 13)) {
            const Ctx c = fresh(c0);
            PanelOrder S{(const char*)(c.ws + S_HS), (const char*)(c.ws + W_SHDN), 4, c.G, c.bid, (size_t)256 * DEXP * 2, (size_t)256 * DEXP * 2};
            EpiResid E{c.out, c.out};
            gemm_phase<EpiResid, PanelOrder, false>(c.lds, c.tid, DEXP, DEXP * 2, S, E); SEAM(); }
        if (PHS(13) && IN(pb + 14)) { const Ctx c = fresh(c0); phase_route(c); SEAM(); }
        for (int s = 0; s < NSUB; ++s) {
            if (PHS(15) && IN(pb + 15 + 3 * s)) { const Ctx c = fresh(c0); moe_tables(c, c.layer, s, mcnt, mtp);
                const unsigned* list = (const unsigned*)(c.ws + S_LIST) + (size_t)s * NEXP * TSUB;
                MoeOrder S{(const char*)(c.ws + WS_XB), (const char*)(c.ws + W_E13), 2, c.G, c.bid, (size_t)512 * D * 2, (size_t)256 * D * 2, 0, mtp, mcnt, list, true, c.lane};
                EpiGLU E{(bf16_t*)(c.ws + S_HE), nullptr, true};
                gemm_phase<EpiGLU, MoeOrder, true>(c.lds, c.tid, D, D * 2, S, E); SEAM(); }
            if (PHS(16) && IN(pb + 16 + 3 * s)) { const Ctx c = fresh(c0); moe_tables(c, c.layer, s, mcnt, mtp);
                const unsigned* list = (const unsigned*)(c.ws + S_LIST) + (size_t)s * NEXP * TSUB;
                MoeOrder S{(const char*)(c.ws + S_HE), (const char*)(c.ws + W_E2), 4, c.G, c.bid, (size_t)D * DEXP * 2, (size_t)256 * DEXP * 2, (size_t)256 * DEXP * 2, mtp, mcnt, list, false, c.lane};
                EpiExpDown E{(bf16_t*)(c.ws + S_Y), (const float*)(c.ws + S_GW), list, mcnt};
                gemm_phase<EpiExpDown, MoeOrder, false>(c.lds, c.tid, DEXP, DEXP * 2, S, E); SEAM(); }
            if (PHS(17) && IN(pb + 17 + 3 * s)) { const Ctx c = fresh(c0); moe_tables(c, c.layer, s, mcnt, mtp); phase_combine(c, s, mtp, c.layer == DEPTH - 1); SEAM(); }
        }
    }
#undef IN
#ifdef X7
    asm volatile("s_waitcnt vmcnt(0)" ::: "memory"); __syncthreads(); __builtin_amdgcn_fence(__ATOMIC_RELEASE, "agent"); asm volatile("s_waitcnt vmcnt(0)" ::: "memory");
#endif
}

extern "C" void kernel_launch(void* const* d_in, const int* in_sizes, int n_in, void* d_out, int out_size, void* d_ws, size_t ws_size, hipStream_t stream) {
    static int grid = 0;
    if (grid == 0) {
        if (n_in != 27 || ws_size < WS_END) { fprintf(stderr, "kernel_launch: n_in %d ws %zu (need %zu)\n", n_in, ws_size, (size_t)WS_END); grid = -1; return; }
        if (hipFuncSetAttribute((const void*)mk_fwd, hipFuncAttributeMaxDynamicSharedMemorySize, LDS_BYTES) != hipSuccess) { fprintf(stderr, "kernel_launch: hipFuncSetAttribute failed\n"); grid = -1; return; }
        int dev = 0, cus = 0, per_cu = 0;
        hipGetDevice(&dev); hipDeviceGetAttribute(&cus, hipDeviceAttributeMultiprocessorCount, dev);
        hipOccupancyMaxActiveBlocksPerMultiprocessor(&per_cu, (const void*)mk_fwd, 512, LDS_BYTES);
        (void)hipGetLastError();
        grid = cus > 0 ? cus : 256; if (grid > 256) grid = 256;
        fprintf(stderr, "kernel_launch: grid %d (occupancy query %d per CU)\n", grid, per_cu);
    }
    if (grid < 0) return;
    hipMemsetAsync((char*)d_ws + WS_CTL, 0, 1 * MiB, stream);
    Args a{};
    for (int i = 0; i < 27; ++i) a.in[i] = d_in[i];
    a.out = (float*)d_out; a.ws = (unsigned char*)d_ws;
#if MK_ONE_LAUNCH
#ifndef MAXPH
#define MAXPH (DEPTH * NPH)
#endif
    a.ph_lo = 0; a.ph_hi = MAXPH;
    hipLaunchKernelGGL(mk_fwd, dim3(grid), dim3(512), LDS_BYTES, stream, a);
#else
#ifndef MAXPH
#define MAXPH (DEPTH * NPH)
#endif
    for (int ph = 0; ph < MAXPH; ++ph) { a.ph_lo = ph; a.ph_hi = ph + 1; hipLaunchKernelGGL(mk_fwd, dim3(grid), dim3(512), LDS_BYTES, stream, a); }
#endif
}
```

```cpp
#include <hip/hip_runtime.h>
#include <cstdio>
#include <cstdint>

#ifndef MK_ONE_LAUNCH
#define MK_ONE_LAUNCH 1
#endif
#ifndef SIMPLE_GEMM
#define SIMPLE_GEMM 0
#endif

#define LAS __attribute__((address_space(3)))
#define GAS __attribute__((address_space(1)))
typedef unsigned short bf16_t;
typedef short bf16x8 __attribute__((ext_vector_type(8)));
typedef unsigned short u16x4 __attribute__((ext_vector_type(4)));
typedef float f32x4 __attribute__((ext_vector_type(4)));
typedef float f32x2 __attribute__((ext_vector_type(2)));
typedef unsigned u32x4 __attribute__((ext_vector_type(4)));
typedef unsigned u32x2 __attribute__((ext_vector_type(2)));
typedef LAS unsigned char lds_t;

constexpr int T = 65536, D = 1024, SEQ = 4096, NBATCH = 16, DEPTH = 4;
constexpr int NPANEL = 256;
constexpr int HW = 3584;
constexpr int INW = 6656;
constexpr int NEXP = 64, DEXP = 256;
constexpr int NSUB = 1, TSUB = T / NSUB, PSUB = NPANEL / NSUB;
constexpr int ROWS_MAX = TSUB * 8 + NEXP * 256;
constexpr float ALPHA = 1.681792830507429f;
constexpr float LN_EPS = 1e-5f, GN_EPS = 1e-6f;

constexpr size_t MiB = 1u << 20;
constexpr size_t WS_CTL = 0;
constexpr size_t WS_COS = 1 * MiB, WS_SIN = 2 * MiB;
constexpr size_t WS_W = 3 * MiB;
constexpr size_t W_IN = WS_W, W_BR = WS_W + 7 * MiB, W_OUT = WS_W + 10 * MiB, W_SM = WS_W + 12 * MiB;
constexpr size_t W_SHUP = WS_W + 13 * MiB, W_SHDN = W_SHUP + 3 * MiB / 2, W_E13 = WS_W + 15 * MiB, W_E2 = WS_W + 47 * MiB;
constexpr size_t WS_XB = 82 * MiB;
constexpr size_t WS_XB8 = 210 * MiB;
constexpr size_t WS_S = 274 * MiB;
constexpr size_t S_H7 = WS_S, S_KV = WS_S + 448 * MiB, S_BR = WS_S + 576 * MiB, S_MG = WS_S + 768 * MiB, S_RGC = WS_S + 896 * MiB;
constexpr size_t S_LA = S_MG, S_BB = S_MG + 64 * MiB;
constexpr size_t S_PE = WS_S, S_GW = WS_S + 2 * MiB, S_LIST = WS_S + 4 * MiB, S_SF = WS_S + 20 * MiB;
constexpr size_t S_HE = WS_S + 84 * MiB, S_Y = WS_S + 348 * MiB;
constexpr size_t S_HS = S_HE, S_LG = S_HE + 32 * MiB;
constexpr size_t S_PRE = S_H7;
constexpr size_t WS_END = WS_S + 899 * MiB;
static_assert(S_HE + (size_t)ROWS_MAX * 512 <= S_Y && S_Y + (size_t)ROWS_MAX * 1024 <= WS_END && S_SF + (size_t)T * D <= S_HE, "moe scratch");
constexpr int CW_BAR = 4096;
constexpr int CW_CNT = 16384;

constexpr int LDS_STAGE = 131072;
constexpr int LDS_MISC = 143360;
constexpr int LDS_IDX = 143360 + 1536;
constexpr int LDS_EPI = 147456;
constexpr int LDS_BYTES = 163840;

__device__ __forceinline__ unsigned f2bf(float f) { unsigned u = __builtin_bit_cast(unsigned, f); return (u + 0x7fffu + ((u >> 16) & 1u)) >> 16; }
typedef __bf16 bf16x2_t __attribute__((ext_vector_type(2)));
__device__ __forceinline__ unsigned pk2(float lo, float hi) { const bf16x2_t v = __builtin_convertvector((f32x2){lo, hi}, bf16x2_t); return __builtin_bit_cast(unsigned, v); }
__device__ __forceinline__ float bf2f(unsigned short b) { return __builtin_bit_cast(float, (unsigned)b << 16); }
__device__ __forceinline__ float bflo(unsigned w) { return __builtin_bit_cast(float, w << 16); }
__device__ __forceinline__ float bfhi(unsigned w) { return __builtin_bit_cast(float, w & 0xffff0000u); }
__device__ __forceinline__ float sigmoidf_(float x) { return __builtin_amdgcn_rcpf(1.0f + __expf(-x)); }
__device__ __forceinline__ float siluf_(float x) { return x * __builtin_amdgcn_rcpf(1.0f + __expf(-x)); }
__device__ __forceinline__ float gelu_tanh(float x) { const float u = 0.7978845608028654f * (x + 0.044715f * x * x * x); return x * __builtin_amdgcn_rcpf(1.0f + __expf(-2.0f * u)); }
__device__ __forceinline__ float wave_sum(float v) {
#pragma unroll
    for (int o = 1; o < 64; o <<= 1) v += __shfl_xor(v, o);
    return v;
}
#define LDS_WAIT() asm volatile("s_waitcnt lgkmcnt(0)" ::: "memory")
#define VM_WAIT() asm volatile("s_waitcnt vmcnt(0)" ::: "memory")

typedef int i32x8 __attribute__((ext_vector_type(8)));
typedef int i32x4 __attribute__((ext_vector_type(4)));
constexpr float W8_SCALE = 32.0f;
constexpr int MX_ONE = 0x7f7f7f7f, MX_W = 0x7a7a7a7a, MX_WG = 0x72727272;
__device__ __forceinline__ unsigned pk4_fp8s(float a, float b, float c2, float d, float s) { int w = 0; w = __builtin_amdgcn_cvt_pk_fp8_f32(a * s, b * s, w, false); w = __builtin_amdgcn_cvt_pk_fp8_f32(c2 * s, d * s, w, true); return (unsigned)w; }
__device__ __forceinline__ f32x4 mfma16(bf16x8 a, bf16x8 b, f32x4 c) { return __builtin_amdgcn_mfma_f32_16x16x32_bf16(a, b, c, 0, 0, 0); }
__device__ __forceinline__ bf16x8 frag_row(const lds_t* X, int pitchB, int r0, int k0, int fr, int fq) {
    return *(const LAS bf16x8*)(X + (r0 + fr) * pitchB + (k0 + 8 * fq) * 2);
}
__device__ __forceinline__ bf16x8 frag_col(const lds_t* X, int pitchB, int k0, int c0, int fr, int fq) {
    const int q = fr >> 2, p = fr & 3;
    const unsigned a0 = (unsigned)(size_t)X + (unsigned)((k0 + 8 * fq + q) * pitchB + (c0 + 4 * p) * 2);
    u16x4 lo, hi;
    asm volatile("ds_read_b64_tr_b16 %0, %2\n\tds_read_b64_tr_b16 %1, %3\n\ts_waitcnt lgkmcnt(0)" : "=&v"(lo), "=&v"(hi) : "v"(a0), "v"(a0 + 4u * (unsigned)pitchB) : "memory");
    bf16x8 r; r[0] = (short)lo[0]; r[1] = (short)lo[1]; r[2] = (short)lo[2]; r[3] = (short)lo[3]; r[4] = (short)hi[0]; r[5] = (short)hi[1]; r[6] = (short)hi[2]; r[7] = (short)hi[3];
    return r;
}

#define XB_TMO      128
#define XB_XCNT(j)  (256  + 64 * (j))
#define XB_XSUB(j)  (1280 + 64 * (j))
#define XB_XGEN(j)  (2304 + 64 * (j))
#define XB_TOP      3328
#define XB_TOPGEN   3392
#define XCD_BAR_WORDS 3456
#define XB_SPIN_CAP (1u << 20)
__device__ __forceinline__ unsigned xb_ld(unsigned* p)              { return __hip_atomic_load(p, __ATOMIC_RELAXED, __HIP_MEMORY_SCOPE_AGENT); }
__device__ __forceinline__ unsigned xb_add(unsigned* p, unsigned v) { return __hip_atomic_fetch_add(p, v, __ATOMIC_RELAXED, __HIP_MEMORY_SCOPE_AGENT); }
__device__ __forceinline__ unsigned xb_xcc_id() { return (unsigned)__builtin_amdgcn_s_getreg((3 << 11) | 20) & 0xFu; }
#define XB_SPIN(cond, bar) do { unsigned _sp = 0; while (cond) { __builtin_amdgcn_s_sleep(1); \
    if ((++_sp & 255u) == 0u) { if (xb_ld(&(bar)[XB_TMO])) break; if (_sp > XB_SPIN_CAP) { atomicAdd(&(bar)[XB_TMO], 1u); break; } } } } while (0)
struct XcdBarrier { unsigned* bar; unsigned x; volatile LAS unsigned* st; };
__device__ __forceinline__ XcdBarrier xcd_barrier_post(unsigned* bar, volatile LAS unsigned* st) {
    XcdBarrier b; b.bar = bar; b.x = xb_xcc_id(); b.st = st;
    if (threadIdx.x == 0) (void)xb_add(&bar[XB_XCNT(b.x)], 1u);
    return b;
}
__device__ __forceinline__ void xcd_barrier_complete(unsigned* bar, unsigned x, unsigned& nloc, unsigned& nx) {
    const unsigned G = gridDim.x * gridDim.y * gridDim.z;
    unsigned sum, cnt, mine, sp = 0u;
    for (;;) {
        sum = 0u; cnt = 0u; mine = 0u;
#pragma unroll
        for (unsigned j = 0; j < 16; ++j) { const unsigned c = xb_ld(&bar[XB_XCNT(j)]); sum += c; cnt += (c > 0u) ? 1u : 0u; mine = (j == x) ? c : mine; }
        if (sum == G) break;
        __builtin_amdgcn_s_sleep(1);
        if ((++sp & 255u) == 0u) { if (xb_ld(&bar[XB_TMO])) break; if (sp > XB_SPIN_CAP) { atomicAdd(&bar[XB_TMO], 1u); break; } }
    }
    nloc = mine > 0u ? mine : 1u; nx = cnt > 0u ? cnt : 1u;
}
__device__ __forceinline__ void xcd_barrier(const XcdBarrier& b) {
    asm volatile("s_waitcnt vmcnt(0)" ::: "memory");
    __syncthreads();
    if (threadIdx.x == 0) {
        unsigned* bar = b.bar;
        __builtin_amdgcn_s_waitcnt(0);
        unsigned nloc = b.st[0], nx = b.st[1];
        if (nloc == 0u) { xcd_barrier_complete(bar, b.x, nloc, nx); b.st[0] = nloc; b.st[1] = nx; }
        const unsigned old = xb_add(&bar[XB_XSUB(b.x)], 1u);
        const unsigned gen = old / nloc;
        if (old + 1u == (gen + 1u) * nloc) {
            __builtin_amdgcn_fence(__ATOMIC_RELEASE, "agent");
            asm volatile("s_waitcnt vmcnt(0)" ::: "memory");
            const unsigned og = xb_add(&bar[XB_TOP], 1u);
            const unsigned tg = og / nx;
            if (og + 1u == (tg + 1u) * nx) xb_add(&bar[XB_TOPGEN], 1u);
            else XB_SPIN(xb_ld(&bar[XB_TOPGEN]) == tg, bar);
            __builtin_amdgcn_fence(__ATOMIC_ACQUIRE, "agent");
            xb_add(&bar[XB_XGEN(b.x)], 1u);
            asm volatile("s_waitcnt vmcnt(0)" ::: "memory");
        } else {
            XB_SPIN(xb_ld(&bar[XB_XGEN(b.x)]) == gen, bar);
            __builtin_amdgcn_fence(__ATOMIC_ACQUIRE, "agent");
            asm volatile("s_waitcnt vmcnt(0)" ::: "memory");
        }
    }
    __syncthreads();
}

struct GUnit { const char* A; const char* B; int x, y, z, w; };

constexpr int BK = 64, HALF = 128, HTB = HALF * BK * 2;
__host__ __device__ __forceinline__ int lds_byte(int r, int c) { const int st = (r >> 4) * 2 + (c >> 5), rr = r & 15, cc = c & 31, ob = rr * 64 + cc * 2; return st * 1024 + (ob ^ (((ob >> 9) & 1) << 5)); }
__host__ __device__ __forceinline__ int perm32(int rho) { const int n = rho >> 4, i = rho & 15; return 8 * (i >> 2) + 4 * n + (i & 3); }
__host__ __device__ __forceinline__ void stage_rc(int b, int& R, int& C) { const int st = b / 1024, sb = b % 1024, swz = sb ^ (((sb >> 9) & 1) << 5); R = (st >> 1) * 16 + swz / 64; C = (st & 1) * 32 + (swz % 64) / 2; }

#if SIMPLE_GEMM
template <class Epi, class Sched, bool GATHER, bool F8 = false>
__device__ __forceinline__ void gemm_phase(lds_t* lds, const int tid, const int K, const unsigned ldaB, const Sched& S, const Epi& E) {
    const int wid = __builtin_amdgcn_readfirstlane(tid >> 6), lane = tid & 63, wr = wid >> 2, wc = wid & 3, fr = lane & 15, fq = lane >> 4;
    GUnit cur;
    for (int ui = 0; S.next(ui, cur); ++ui) {
        f32x4 acc[2][2][4][2];
#pragma unroll
        for (int a = 0; a < 2; ++a)
#pragma unroll
            for (int b = 0; b < 2; ++b)
#pragma unroll
                for (int m = 0; m < 4; ++m)
#pragma unroll
                    for (int n = 0; n < 2; ++n) acc[a][b][m][n] = (f32x4){0.f, 0.f, 0.f, 0.f};
        unsigned ao[2][4], bo[2][2];
#pragma unroll
        for (int ai = 0; ai < 2; ++ai)
#pragma unroll
            for (int m = 0; m < 4; ++m) { const int r = ai * HALF + wr * 64 + m * 16 + fr; const unsigned ro = GATHER ? (unsigned)S.gather_row(cur, r) : (unsigned)r; ao[ai][m] = ro * ldaB + fq * 16; }
#pragma unroll
        for (int bj = 0; bj < 2; ++bj)
#pragma unroll
            for (int n = 0; n < 2; ++n) { const int r = bj * HALF + wc * 32 + n * 16 + fr; bo[bj][n] = (unsigned)(r * K * 2 + fq * 16); }
#pragma unroll 1
        for (int k0 = 0; k0 < K; k0 += 32) {
            bf16x8 af[2][4], bfr[2][2];
#pragma unroll
            for (int ai = 0; ai < 2; ++ai)
#pragma unroll
                for (int m = 0; m < 4; ++m) af[ai][m] = *(const bf16x8*)(cur.A + ao[ai][m] + k0 * 2);
#pragma unroll
            for (int bj = 0; bj < 2; ++bj)
#pragma unroll
                for (int n = 0; n < 2; ++n) bfr[bj][n] = *(const bf16x8*)(cur.B + bo[bj][n] + k0 * 2);
#pragma unroll
            for (int ai = 0; ai < 2; ++ai)
#pragma unroll
                for (int bj = 0; bj < 2; ++bj)
#pragma unroll
                    for (int m = 0; m < 4; ++m)
#pragma unroll
                        for (int n = 0; n < 2; ++n) acc[ai][bj][m][n] = mfma16(bfr[bj][n], af[ai][m], acc[ai][bj][m][n]);
        }
        E(acc, cur, wr, wc, fr, fq);
    }
}
#else
template <class Epi, class Sched, bool GATHER, bool F8 = false>
__device__ __forceinline__ void gemm_phase(lds_t* lds, const int tid, const int K, const unsigned ldaB, const Sched& S, const Epi& E, const int mxw = MX_W) {
    const int wid = __builtin_amdgcn_readfirstlane(tid >> 6), lane = tid & 63, wr = wid >> 2, wc = wid & 3, fr = lane & 15, fq = lane >> 4;
    const int KB = F8 ? K : K * 2;
    const int nt = KB / 128;
    unsigned voffB[2], voffA[2][2];
#pragma unroll
    for (int i = 0; i < 2; ++i) { int sR, sC; stage_rc(tid * 16 + i * 8192, sR, sC); int Rb;
        if (Epi::PERM == 2) { const int rho = sR & 31; Rb = 64 * (sR >> 5) + 16 * ((rho & 15) >> 2) + 4 * (rho >> 4) + (rho & 3); }
        else Rb = (Epi::PERM == 1 ? ((sR & ~31) + perm32(sR & 31)) : sR);
        voffB[i] = (unsigned)(Rb * KB + sC * 2); }
    const size_t kstep = (size_t)(BK * 2);
    const size_t hstepB = (size_t)(Epi::PERM == 2 ? 8 : HALF) * KB;
    const size_t hstepA = (size_t)HALF * ldaB;
    const unsigned ldsw = (unsigned)wid * 1024u;
    const int aoff = lds_byte(wr * 64 + fr, fq * 8), boff = lds_byte(wc * 32 + fr, fq * 8);
    constexpr int koffA = 1024, koffB = 1024;
#define PG8_SA(b, h) (((b) * 2 + (h)) * HTB)
#define PG8_SB(b, h) ((4 + (b) * 2 + (h)) * HTB)
#define PG8_STAGE(bufoff, gbase, voff) do { _Pragma("unroll") for (int _i = 0; _i < 2; ++_i) { unsigned _v = (voff)[_i]; asm volatile("" : "+v"(_v));   \
        __builtin_amdgcn_global_load_lds((const unsigned*)((const char*)(gbase) + _v), (LAS unsigned*)(lds + (bufoff) + ldsw + _i * 8192), 16, 0, 0); } } while (0)
#define PG8_STAGEB(b, h, gbase) PG8_STAGE(PG8_SB(b, h), (gbase) + (h) * hstepB, voffB)
#define PG8_STAGEA(b, h, gbase, vo) do { if (GATHER) { PG8_STAGE(PG8_SA(b, h), gbase, (vo)[h]); } else { PG8_STAGE(PG8_SA(b, h), (gbase) + (h) * hstepA, voffA[0]); } } while (0)
#define PG8_STAGEA1(b, gbase) do { if (GATHER) { PG8_STAGE(PG8_SA(b, 1), gbase, va1); } else { PG8_STAGE(PG8_SA(b, 1), (gbase) + hstepA, voffA[0]); } } while (0)
#define PG8_RD16(off) (*(const LAS i32x4*)(lds + (off)))
#define PG8_LDA(dst, b, h) do { _Pragma("unroll") for (int m = 0; m < 4; ++m) { if (F8) { const i32x4 _l = PG8_RD16(PG8_SA(b, h) + aoff + m * 2048), _h = PG8_RD16(PG8_SA(b, h) + aoff + m * 2048 + koffA); dst##8[m] = __builtin_shufflevector(_l, _h, 0, 1, 2, 3, 4, 5, 6, 7); } \
        else { _Pragma("unroll") for (int k = 0; k < 2; ++k) dst[m][k] = *(const LAS bf16x8*)(lds + PG8_SA(b, h) + aoff + m * 2048 + k * 1024); } } } while (0)
#define PG8_LDB(dst, b, h) do { _Pragma("unroll") for (int n = 0; n < 2; ++n) { if (F8) { const i32x4 _l = PG8_RD16(PG8_SB(b, h) + boff + n * 2048), _h = PG8_RD16(PG8_SB(b, h) + boff + n * 2048 + koffB); dst##8[n] = __builtin_shufflevector(_l, _h, 0, 1, 2, 3, 4, 5, 6, 7); } \
        else { _Pragma("unroll") for (int k = 0; k < 2; ++k) dst[n][k] = *(const LAS bf16x8*)(lds + PG8_SB(b, h) + boff + n * 2048 + k * 1024); } } } while (0)
#define PG8_MMA(ai, bj, At, Bt) do { __builtin_amdgcn_s_setprio(1); _Pragma("unroll") for (int m = 0; m < 4; ++m) _Pragma("unroll") for (int n = 0; n < 2; ++n) { \
        if (F8) asm volatile("v_mfma_scale_f32_16x16x128_f8f6f4 %0, %1, %2, %0, %3, %4 op_sel_hi:[0,0,0]" : "+v"(acc[ai][bj][m][n]) : "v"(Bt##8[n]), "v"(At##8[m]), "v"(sc_w), "v"(sc_x)); \
        else { _Pragma("unroll") for (int k = 0; k < 2; ++k) acc[ai][bj][m][n] = __builtin_amdgcn_mfma_f32_16x16x32_bf16(Bt[n][k], At[m][k], acc[ai][bj][m][n], 0, 0, 0); } } \
        __builtin_amdgcn_s_setprio(0); } while (0)
#define PG8_WAIT_V(n) asm volatile("s_waitcnt vmcnt(" #n ")" ::: "memory")
#define PG8_WAIT_V8R do { if (Epi::NST > 0 && relax) asm volatile("s_waitcnt vmcnt(%0)" :: "n"(8 + Epi::NST) : "memory"); else PG8_WAIT_V(8); } while (0)
#define PG8_WAIT_L(n) asm volatile("s_waitcnt lgkmcnt(" #n ")" ::: "memory")
#define PG8_BAR __builtin_amdgcn_s_barrier()
#define PG8_SCHED __builtin_amdgcn_sched_barrier(0)
#define PG8_AOFFS(dst, U) do { int _tz = tid; asm volatile("" : "+v"(_tz)); _Pragma("unroll") for (int _h = 0; _h < 2; ++_h) _Pragma("unroll") for (int _i = 0; _i < 2; ++_i) { int _R, _C; stage_rc(_tz * 16 + _i * 8192, _R, _C); \
        const unsigned _row = GATHER ? (unsigned)S.gather_row(U, _h * HALF + _R) : (unsigned)(_h * HALF + _R); dst[_h][_i] = _row * ldaB + (unsigned)_C * 2u; } } while (0)
    GUnit cur, nxt; int ui = 0;
    if (!S.next(0, cur)) return;
    f32x4 acc[2][2][4][2];
#pragma unroll
    for (int a = 0; a < 2; ++a)
#pragma unroll
        for (int b = 0; b < 2; ++b)
#pragma unroll
            for (int m = 0; m < 4; ++m)
#pragma unroll
                for (int n = 0; n < 2; ++n) acc[a][b][m][n] = (f32x4){0.f, 0.f, 0.f, 0.f};
    int sc_w = mxw, sc_x = MX_ONE; asm volatile("" : "+v"(sc_w), "+v"(sc_x));
    bf16x8 At[4][2], B0[2][2], B1[2][2]; i32x8 At8[4], B08[2], B18[2];
    const char* cA = cur.A; const char* cB = cur.B;
    PG8_AOFFS(voffA, cur);
    PG8_STAGEB(0, 0, cB); PG8_STAGEB(0, 1, cB); PG8_STAGEA(0, 0, cA, voffA); PG8_STAGEA(0, 1, cA, voffA);
    if (wr == 1) PG8_BAR;
    PG8_WAIT_V(2); PG8_BAR;
    PG8_STAGEB(1, 0, cB + kstep); PG8_STAGEA(1, 0, cA + kstep, voffA); PG8_STAGEB(1, 1, cB + kstep);
    PG8_WAIT_V(6); PG8_BAR;
    for (;;) {
        const bool has_next = S.next(ui + 1, nxt);
        const char* nA = has_next ? nxt.A : cA; const char* nB = has_next ? nxt.B : cB;
        if (has_next && GATHER) {
            if (wid < 4) __builtin_amdgcn_global_load_lds(S.idx_ptr(nxt, (wid & 3) * 64 + lane), (LAS unsigned*)(lds + LDS_IDX + ((ui + 1) & 1) * 1024 + (wid & 3) * 256), 4, 0, 0);
        }
#pragma unroll 1
        for (int t = 0; t < nt; t += 2) {
            const bool last = (t == nt - 2);
            const bool relax = (t == 0) && (ui > 0);
            const char* a1 = cA + (size_t)(t + 1) * kstep;
            const char* a2 = last ? nA : cA + (size_t)(t + 2) * kstep; const char* b2 = last ? nB : cB + (size_t)(t + 2) * kstep;
            const char* a3 = a2 + kstep; const char* b3 = b2 + kstep;
            unsigned va1[2] = {voffA[1][0], voffA[1][1]};
            if (GATHER && last && has_next) {
                int _tz = tid; asm volatile("" : "+v"(_tz));
#pragma unroll
                for (int _h = 0; _h < 2; ++_h)
#pragma unroll
                    for (int _i = 0; _i < 2; ++_i) { int _R, _C; stage_rc(_tz * 16 + _i * 8192, _R, _C);
                        const unsigned _a = *(const LAS unsigned*)(lds + LDS_IDX + ((ui + 1) & 1) * 1024 + (_h * HALF + _R) * 4); voffA[_h][_i] = (_a >> 3) * ldaB + (unsigned)_C * 2u; } }
            PG8_LDB(B0, 0, 0); PG8_LDB(B1, 0, 1); PG8_SCHED; PG8_LDA(At, 0, 0); PG8_STAGEA1(1, a1);
            PG8_WAIT_V8R; PG8_WAIT_L(0); PG8_BAR; PG8_MMA(0, 0, At, B0); PG8_MMA(0, 1, At, B1); PG8_BAR; PG8_SCHED;
            PG8_LDA(At, 0, 1); PG8_STAGEB(0, 0, b2); PG8_STAGEB(0, 1, b2); PG8_STAGEA(0, 0, a2, voffA);
            PG8_WAIT_V8R; PG8_WAIT_L(0); PG8_BAR; PG8_MMA(1, 0, At, B0); PG8_MMA(1, 1, At, B1); PG8_BAR; PG8_SCHED;
            PG8_LDB(B0, 1, 0); PG8_LDB(B1, 1, 1); PG8_SCHED; PG8_LDA(At, 1, 0); PG8_STAGEA(0, 1, a2, voffA);
            PG8_WAIT_V(8); PG8_WAIT_L(0); PG8_BAR; PG8_MMA(0, 0, At, B0); PG8_MMA(0, 1, At, B1); PG8_BAR; PG8_SCHED;
            PG8_LDA(At, 1, 1); PG8_STAGEB(1, 0, b3); PG8_STAGEB(1, 1, b3); PG8_STAGEA(1, 0, a3, voffA);
            PG8_WAIT_V(8); PG8_WAIT_L(0); PG8_BAR; PG8_MMA(1, 0, At, B0); PG8_MMA(1, 1, At, B1); PG8_BAR; PG8_SCHED;
        }
        if (wr == 0) PG8_BAR;
        if (F8) asm volatile("s_nop 15\n\ts_nop 15" ::: "memory");
        E(acc, cur, wr, wc, fr, fq);
        if (!has_next) break;
#pragma unroll
        for (int a = 0; a < 2; ++a)
#pragma unroll
            for (int b = 0; b < 2; ++b)
#pragma unroll
                for (int m = 0; m < 4; ++m)
#pragma unroll
                    for (int n = 0; n < 2; ++n) acc[a][b][m][n] = (f32x4){0.f, 0.f, 0.f, 0.f};
        cur = nxt; cA = nA; cB = nB; ++ui;
        if (wr == 1) PG8_BAR;
    }
    PG8_WAIT_V(0);
    PG8_BAR;
#undef PG8_SA
#undef PG8_SB
#undef PG8_STAGE
#undef PG8_LDA
#undef PG8_STAGEB
#undef PG8_STAGEA
#undef PG8_LDB
#undef PG8_MMA
#undef PG8_WAIT_V
#undef PG8_WAIT_L
#undef PG8_BAR
#undef PG8_SCHED
#undef PG8_AOFFS
}
#endif

struct Args { const void* in[27]; float* out; unsigned char* ws; int ph_lo, ph_hi; };
struct Ctx {
    lds_t* lds; int tid, lane, wave; int G, bid, layer;
    unsigned char* ws; float* out;
};
enum { I_X = 0, I_POS = 1, I_WIN = 2, I_GATEB = 3, I_WBR = 4, I_WOUT = 5, I_POOLW = 6, I_POOLS = 7, I_CONVW = 8, I_CONVB = 9, I_WA = 10, I_BA = 11, I_WX = 12, I_BX = 13, I_LAM = 14,
       I_LN1G = 15, I_LN1B = 16, I_RW = 17, I_RB = 18, I_EW1 = 19, I_EW3 = 20, I_EW2 = 21, I_SW1 = 22, I_SW3 = 23, I_SW2 = 24, I_LN2G = 25, I_LN2B = 26 };
constexpr int LDS_PTAB = 143360 + 1024;
__device__ __forceinline__ const float* inp(const Ctx& c, int idx, size_t off) {
    const unsigned long long v = ((const LAS unsigned long long*)(c.lds + LDS_PTAB))[idx];
    const unsigned lo = __builtin_amdgcn_readfirstlane((unsigned)v), hi = __builtin_amdgcn_readfirstlane((unsigned)(v >> 32));
    return (const float*)(const GAS float*)(((unsigned long long)hi << 32) | lo) + off;
}
__device__ __forceinline__ Ctx fresh(const Ctx& c0) {
    Ctx c = c0; int t = c0.tid; asm volatile("" : "+v"(t));
    int g = c0.G, b = c0.bid, l = c0.layer; asm volatile("" : "+s"(g), "+s"(b), "+s"(l));
    unsigned long long w = (unsigned long long)c0.ws, o = (unsigned long long)c0.out; unsigned ld = (unsigned)(size_t)c0.lds; asm volatile("" : "+s"(w), "+s"(o), "+s"(ld));
    c.tid = t; c.lane = t & 63; c.wave = __builtin_amdgcn_readfirstlane(t >> 6); c.G = g; c.bid = b; c.layer = l;
    c.ws = (unsigned char*)(GAS unsigned char*)w; c.out = (float*)(GAS float*)o; c.lds = (lds_t*)ld; return c;
}

struct PanelOrder {
    const char* A; const char* B; int NT, G, bid; size_t a_panel_bytes, b_tile_bytes;
    __device__ __forceinline__ bool next(int i, GUnit& u) const {
        const int L = i * G + bid; if (L >= NPANEL * NT) return false;
        const int wgid = (L & 7) * (NPANEL / 8 * NT) + (L >> 3); const int nig = 8 * NT, gid = wgid / nig, rem = wgid - gid * nig;
        const int p = gid * 8 + (rem & 7), pn = rem >> 3;
        u.A = A + (size_t)p * a_panel_bytes; u.B = B + (size_t)pn * b_tile_bytes; u.x = p; u.y = pn; u.z = 0; u.w = 0; return true;
    }
    __device__ __forceinline__ int gather_row(const GUnit&, int r) const { return r; }
    __device__ __forceinline__ const unsigned* idx_ptr(const GUnit&, int) const { return nullptr; }
};
struct OwnOrder {
    const char* A; const char* B; int NT, G, bid; size_t a_panel_bytes, a_tile_bytes, b_tile_bytes; int a_pair;
    __device__ __forceinline__ bool next(int i, GUnit& u) const {
        const int pi = i / NT, pn = i - pi * NT; const int p = bid + pi * G; if (p >= NPANEL) return false;
        u.A = A + (size_t)p * a_panel_bytes + (size_t)(a_pair ? (pn >> 1) : pn) * a_tile_bytes; u.B = B + (size_t)pn * b_tile_bytes; u.x = p; u.y = pn; u.z = 0; u.w = 0; return true;
    }
    __device__ __forceinline__ int gather_row(const GUnit&, int r) const { return r; }
    __device__ __forceinline__ const unsigned* idx_ptr(const GUnit&, int) const { return nullptr; }
};
struct MergeOrder {
    const char* A; const char* B; int G, bid, fixed_pass;
    __device__ __forceinline__ bool next(int i, GUnit& u) const {
        const int it = fixed_pass < 0 ? i / 3 : i, pass = fixed_pass < 0 ? i - it * 3 : fixed_pass; const int L = it * G + bid; if (L >= NPANEL * 4) return false;
        const int wgid = (L & 7) * (NPANEL / 8 * 4) + (L >> 3); const int gid = wgid >> 5, rem = wgid & 31; const int p = gid * 8 + (rem & 7), pn = rem >> 3;
        u.A = A + (size_t)p * (256 * 3072) + (pass == 0 ? 0 : (pass == 1 ? 1024 : 1536)); u.B = B + (size_t)pass * (D * 512) + (size_t)pn * (256 * 512); u.x = p; u.y = pn; u.z = pass; u.w = 0; return true;
    }
    __device__ __forceinline__ int gather_row(const GUnit&, int r) const { return r; }
    __device__ __forceinline__ const unsigned* idx_ptr(const GUnit&, int) const { return nullptr; }
};
struct MoeOrder {
    const char* A; const char* B; int NT, G, bid; size_t b_exp_bytes, b_tile_bytes, a_tile_bytes; const LAS int* tp; const LAS int* cnt; const unsigned* list; bool gather; int lane;
    __device__ __forceinline__ bool next(int i, GUnit& u) const {
#if 1
        const int lu = (bid >> 3) + (G >> 3) * i; const int tq = lu / NT, pn = lu - tq * NT; const int ti = tq * 8 + (bid & 7); const int ntile = tp[64]; if (ti >= ntile) return false;
#else
        const int g = bid + i * G; const int ti = g / NT, pn = g - ti * NT; const int ntile = tp[64]; if (ti >= ntile) return false;
#endif
        const unsigned long long m = __ballot(tp[lane + 1] > ti);
        const int e = __builtin_amdgcn_readfirstlane((int)__builtin_ctzll(m));
        const int tl = ti - tp[e];
        u.A = gather ? A : A + (size_t)ti * a_tile_bytes; u.B = B + (size_t)e * b_exp_bytes + (size_t)pn * b_tile_bytes; u.x = ti; u.y = pn; u.z = e; u.w = tl; return true;
    }
    __device__ __forceinline__ const unsigned* idx_ptr(const GUnit& u, int r) const { const int c = cnt[u.z]; int j = u.w * 256 + r; j = j < c ? j : c - 1; return list + (size_t)u.z * TSUB + j; }
    __device__ __forceinline__ int gather_row(const GUnit& u, int r) const {
        const int c = cnt[u.z]; int j = u.w * 256 + r; j = j < c ? j : c - 1;
#ifdef X6
        return r;
#endif
        return (int)(list[(size_t)u.z * TSUB + j] >> 3);
    }
};

__device__ __forceinline__ void stage_store16(lds_t* lw, unsigned char* gbase, size_t pitchB, int lane, u32x4 lo, u32x4 hi) {
    const int fr = lane & 15, fq = lane >> 4;
    *(LAS u32x4*)(lw + fr * 128 + fq * 32) = lo; *(LAS u32x4*)(lw + fr * 128 + fq * 32 + 16) = hi;
    const u32x4 a = *(const LAS u32x4*)(lw + (lane >> 3) * 128 + (lane & 7) * 16), b = *(const LAS u32x4*)(lw + (8 + (lane >> 3)) * 128 + (lane & 7) * 16);
    __builtin_nontemporal_store(a, (u32x4*)(gbase + (size_t)(lane >> 3) * pitchB + (lane & 7) * 16)); __builtin_nontemporal_store(b, (u32x4*)(gbase + (size_t)(8 + (lane >> 3)) * pitchB + (lane & 7) * 16));
}
struct EpiIn {
    static constexpr int PERM = 2; static constexpr int NST = 16;
    bf16_t* H; const unsigned* csT; lds_t* lepi;
    __device__ __forceinline__ void operator()(const f32x4 (&acc)[2][2][4][2], const GUnit& u, int wr, int wc, int fr, int fq) const {
        const int seg = u.y >> 1; const int lane = fr + 16 * fq; lds_t* lw = lepi + (wr * 4 + wc) * 2048;
        const int i0 = 32 * (wc & 1) + 8 * fq;
        u32x4 t0 = (u32x4){0u, 0u, 0u, 0u}, t1 = t0;
        if (seg < 2) { const int s0_ = (u.x * 256 + wr * 64 + fr) & (SEQ - 1); t0 = *(const u32x4*)(csT + s0_ * 64 + i0); t1 = *(const u32x4*)(csT + s0_ * 64 + i0 + 4); }
#pragma unroll
        for (int idx = 0; idx < 8; ++idx) { const int ai = idx >> 2, m = idx & 3;
                const int rg = u.x * 256 + ai * HALF + wr * 64 + m * 16;
                u32x4 t0n = t0, t1n = t1;
                if (seg < 2 && idx < 7) { const int sn = (u.x * 256 + ((idx + 1) >> 2) * HALF + wr * 64 + ((idx + 1) & 3) * 16 + fr) & (SEQ - 1); t0n = *(const u32x4*)(csT + sn * 64 + i0); t1n = *(const u32x4*)(csT + sn * 64 + i0 + 4); }
                f32x4 v0 = acc[ai][0][m][0], v1 = acc[ai][0][m][1], v2 = acc[ai][1][m][0], v3 = acc[ai][1][m][1];
#define ROPE4(X, CA, SA, CB, SB) (f32x4){((X)[0] * (CA) - (X)[1] * (SA)) * sc, ((X)[0] * (SA) + (X)[1] * (CA)) * sc, ((X)[2] * (CB) - (X)[3] * (SB)) * sc, ((X)[2] * (SB) + (X)[3] * (CB)) * sc}
#define MAP4(F, X) (f32x4){F((X)[0]), F((X)[1]), F((X)[2]), F((X)[3])}
                if (seg < 2) { const float sc = seg == 1 ? 0.08838834764831845f : 1.0f;
                    v0 = ROPE4(v0, bflo(t0.x), bfhi(t0.x), bflo(t0.y), bfhi(t0.y)); v1 = ROPE4(v1, bflo(t0.z), bfhi(t0.z), bflo(t0.w), bfhi(t0.w)); v2 = ROPE4(v2, bflo(t1.x), bfhi(t1.x), bflo(t1.y), bfhi(t1.y)); v3 = ROPE4(v3, bflo(t1.z), bfhi(t1.z), bflo(t1.w), bfhi(t1.w));
                } else if (seg == 3) { v0 = MAP4(siluf_, v0); v1 = MAP4(siluf_, v1); v2 = MAP4(siluf_, v2); v3 = MAP4(siluf_, v3); }
                else if (seg == 6) { v0 = MAP4(gelu_tanh, v0); v1 = MAP4(gelu_tanh, v1); v2 = MAP4(gelu_tanh, v2); v3 = MAP4(gelu_tanh, v3); }
#undef ROPE4
#undef MAP4
                u32x4 lo, hi; lo.x = pk2(v0[0], v0[1]); lo.y = pk2(v0[2], v0[3]); lo.z = pk2(v1[0], v1[1]); lo.w = pk2(v1[2], v1[3]); hi.x = pk2(v2[0], v2[1]); hi.y = pk2(v2[2], v2[3]); hi.z = pk2(v3[0], v3[1]); hi.w = pk2(v3[2], v3[3]);
                stage_store16(lw, (unsigned char*)(H + (size_t)rg * HW + u.y * 256 + wc * 64), (size_t)HW * 2, lane, lo, hi);
                t0 = t0n; t1 = t1n;
            }
    }
};
__device__ __forceinline__ float ub0(unsigned w) { return (float)(w & 0xffu); }
__device__ __forceinline__ float ub1(unsigned w) { return (float)((w >> 8) & 0xffu); }
__device__ __forceinline__ float ub2(unsigned w) { return (float)((w >> 16) & 0xffu); }
__device__ __forceinline__ float ub3(unsigned w) { return (float)(w >> 24); }
constexpr int GBP = 3 * D;
__device__ __forceinline__ unsigned pk4_u8(float a, float b, float c, float d) { unsigned w = 0; w = __builtin_amdgcn_cvt_pk_u8_f32(a * 255.0f, 0, w); w = __builtin_amdgcn_cvt_pk_u8_f32(b * 255.0f, 1, w); w = __builtin_amdgcn_cvt_pk_u8_f32(c * 255.0f, 2, w); w = __builtin_amdgcn_cvt_pk_u8_f32(d * 255.0f, 3, w); return w; }
struct EpiGates {
    static constexpr int PERM = 2; static constexpr int NST = 8;
    unsigned char* GB; const float* gb;
    __device__ __forceinline__ void operator()(const f32x4 (&acc)[2][2][4][2], const GUnit& u, int wr, int wc, int fr, int fq) const {
        const int colt = u.y * 256 + wc * 64 + 16 * fq;
        f32x4 bv[4];
#pragma unroll
        for (int q = 0; q < 4; ++q) bv[q] = *(const f32x4*)(gb + colt + 4 * q);
#pragma unroll
        for (int ai = 0; ai < 2; ++ai)
#pragma unroll
            for (int m = 0; m < 4; ++m) { const int row = u.x * 256 + ai * HALF + wr * 64 + m * 16 + fr;
                const f32x4 v0 = acc[ai][0][m][0] + bv[0], v1 = acc[ai][0][m][1] + bv[1], v2 = acc[ai][1][m][0] + bv[2], v3 = acc[ai][1][m][1] + bv[3];
                u32x4 w; w.x = pk4_u8(sigmoidf_(v0[0]), sigmoidf_(v0[1]), sigmoidf_(v0[2]), sigmoidf_(v0[3])); w.y = pk4_u8(sigmoidf_(v1[0]), sigmoidf_(v1[1]), sigmoidf_(v1[2]), sigmoidf_(v1[3]));
                w.z = pk4_u8(sigmoidf_(v2[0]), sigmoidf_(v2[1]), sigmoidf_(v2[2]), sigmoidf_(v2[3])); w.w = pk4_u8(sigmoidf_(v3[0]), sigmoidf_(v3[1]), sigmoidf_(v3[2]), sigmoidf_(v3[3]));
                __builtin_nontemporal_store(w, (u32x4*)(GB + (size_t)row * GBP + colt)); }
    }
};
struct EpiMerge {
    static constexpr int PERM = 2; static constexpr int NST = 16;
    bf16_t* MG; const unsigned char* GB; unsigned char* MG8;
    template <int PASS>
    __device__ __forceinline__ void run(const f32x4 (&acc)[2][2][4][2], const GUnit& u, int wr, int wc, int fr, int fq) const {
        const int row0 = u.x * 256 + wr * 64 + fr; const int colt = u.y * 256 + wc * 64 + 16 * fq;
        u32x4 g = *(const u32x4*)(GB + (size_t)row0 * GBP + PASS * D + colt), o0 = (u32x4){0u, 0u, 0u, 0u}, o1 = o0;
        if (PASS > 0) { const bf16_t* mp0 = MG + (size_t)row0 * D + colt; o0 = *(const u32x4*)mp0; o1 = *(const u32x4*)(mp0 + 8); }
#pragma unroll
        for (int idx = 0; idx < 8; ++idx) { const int ai = idx >> 2, m = idx & 3; const int row = row0 + ai * HALF + m * 16; bf16_t* mp = MG + (size_t)row * D + colt;
            u32x4 gn = g, o0n = o0, o1n = o1;
            if (idx < 7) { const int rown = row0 + ((idx + 1) >> 2) * HALF + ((idx + 1) & 3) * 16; gn = *(const u32x4*)(GB + (size_t)rown * GBP + PASS * D + colt);
                if (PASS > 0) { const bf16_t* mpn = MG + (size_t)rown * D + colt; o0n = *(const u32x4*)mpn; o1n = *(const u32x4*)(mpn + 8); } }
            const f32x4 a0 = acc[ai][0][m][0], a1 = acc[ai][0][m][1], a2 = acc[ai][1][m][0], a3 = acc[ai][1][m][1];
            f32x4 v0 = (f32x4){ub0(g.x) * a0[0], ub1(g.x) * a0[1], ub2(g.x) * a0[2], ub3(g.x) * a0[3]}, v1 = (f32x4){ub0(g.y) * a1[0], ub1(g.y) * a1[1], ub2(g.y) * a1[2], ub3(g.y) * a1[3]};
            f32x4 v2 = (f32x4){ub0(g.z) * a2[0], ub1(g.z) * a2[1], ub2(g.z) * a2[2], ub3(g.z) * a2[3]}, v3 = (f32x4){ub0(g.w) * a3[0], ub1(g.w) * a3[1], ub2(g.w) * a3[2], ub3(g.w) * a3[3]};
            if (PASS > 0) {
                v0 = v0 + (f32x4){bflo(o0.x), bfhi(o0.x), bflo(o0.y), bfhi(o0.y)}; v1 = v1 + (f32x4){bflo(o0.z), bfhi(o0.z), bflo(o0.w), bfhi(o0.w)};
                v2 = v2 + (f32x4){bflo(o1.x), bfhi(o1.x), bflo(o1.y), bfhi(o1.y)}; v3 = v3 + (f32x4){bflo(o1.z), bfhi(o1.z), bflo(o1.w), bfhi(o1.w)}; }
            if (PASS == 2) { u32x4 w8; w8.x = pk4_fp8s(v0[0], v0[1], v0[2], v0[3], 1.0f); w8.y = pk4_fp8s(v1[0], v1[1], v1[2], v1[3], 1.0f); w8.z = pk4_fp8s(v2[0], v2[1], v2[2], v2[3], 1.0f); w8.w = pk4_fp8s(v3[0], v3[1], v3[2], v3[3], 1.0f);
                *(u32x4*)(MG8 + (size_t)row * D + colt) = w8; }
            else { u32x4 w0, w1; w0.x = pk2(v0[0], v0[1]); w0.y = pk2(v0[2], v0[3]); w0.z = pk2(v1[0], v1[1]); w0.w = pk2(v1[2], v1[3]); w1.x = pk2(v2[0], v2[1]); w1.y = pk2(v2[2], v2[3]); w1.z = pk2(v3[0], v3[1]); w1.w = pk2(v3[2], v3[3]);
                *(u32x4*)mp = w0; *(u32x4*)(mp + 8) = w1; }
            g = gn; o0 = o0n; o1 = o1n; }
    }
    __device__ __forceinline__ void operator()(const f32x4 (&acc)[2][2][4][2], const GUnit& u, int wr, int wc, int fr, int fq) const {
        if (u.z == 0) run<0>(acc, u, wr, wc, fr, fq); else if (u.z == 1) run<1>(acc, u, wr, wc, fr, fq); else run<2>(acc, u, wr, wc, fr, fq);
    }
};
struct EpiPool {
    static constexpr int PERM = 1; static constexpr int NST = 0;
    bf16_t* BR; const float* scale;
    __device__ __forceinline__ void operator()(const f32x4 (&acc)[2][2][4][2], const GUnit& u, int wr, int wc, int fr, int fq) const {
        const int row0 = u.x * 256 + wr * 64 + fr; const int colt = u.y * 256 + wc * 32 + 8 * fq;
        f32x4 sv[2][2];
#pragma unroll
        for (int bj = 0; bj < 2; ++bj)
#pragma unroll
            for (int n = 0; n < 2; ++n) sv[bj][n] = *(const f32x4*)(scale + colt + bj * HALF + 4 * n);
#pragma unroll
        for (int ai = 0; ai < 2; ++ai)
#pragma unroll
            for (int m = 0; m < 4; ++m) { unsigned char* rowp = (unsigned char*)BR + (size_t)(row0 + ai * HALF + m * 16) * 3072 + 1024 + colt;
#pragma unroll
                for (int bj = 0; bj < 2; ++bj) { const f32x4 v0 = acc[ai][bj][m][0] * sv[bj][0], v1 = acc[ai][bj][m][1] * sv[bj][1];
                    u32x2 w; w.x = pk4_fp8s(v0[0], v0[1], v0[2], v0[3], 1.0f); w.y = pk4_fp8s(v1[0], v1[1], v1[2], v1[3], 1.0f); *(u32x2*)(rowp + bj * HALF) = w; } }
    }
};
struct EpiRG {
    static constexpr int PERM = 1; static constexpr int NST = 0;
    const bf16_t* BR; bf16_t* LA; bf16_t* BBs; const float* ba; const float* bx; const float* ls;
    __device__ __forceinline__ void operator()(const f32x4 (&acc)[2][2][4][2], const GUnit& u, int wr, int wc, int fr, int fq) const {
        const int row0 = u.x * 256 + wr * 64 + fr; const int ch = u.y * 128 + wc * 32 + 8 * fq;
        f32x4 bav[2], bxv[2], lsv[2];
#pragma unroll
        for (int n = 0; n < 2; ++n) { bav[n] = *(const f32x4*)(ba + ch + 4 * n); bxv[n] = *(const f32x4*)(bx + ch + 4 * n); lsv[n] = *(const f32x4*)(ls + ch + 4 * n); }
#pragma unroll
        for (int ai = 0; ai < 2; ++ai)
#pragma unroll
            for (int m = 0; m < 4; ++m) { const size_t row = (size_t)(row0 + ai * HALF + m * 16);
                const u32x4 cw = *(const u32x4*)(BR + row * 1536 + 1024 + ch); const float cv[8] = {bflo(cw.x), bfhi(cw.x), bflo(cw.y), bfhi(cw.y), bflo(cw.z), bfhi(cw.z), bflo(cw.w), bfhi(cw.w)};
                float la[8], bb[8];
#pragma unroll
                for (int n = 0; n < 2; ++n)
#pragma unroll
                    for (int q = 0; q < 4; ++q) { const float rr = sigmoidf_(acc[ai][0][m][n][q] + bav[n][q]), ii = sigmoidf_(acc[ai][1][m][n][q] + bxv[n][q]);
                        const float l = 8.0f * rr * lsv[n][q]; const float x2 = 2.0f * l; const float om = x2 > -0.02f ? -x2 * (1.0f + x2 * (0.5f + x2 * 0.16666667f)) : 1.0f - __expf(x2);
                        la[4 * n + q] = l; bb[4 * n + q] = __builtin_amdgcn_sqrtf(om) * (ii * cv[4 * n + q]); }
                u32x4 w; w.x = pk2(la[0], la[1]); w.y = pk2(la[2], la[3]); w.z = pk2(la[4], la[5]); w.w = pk2(la[6], la[7]); *(u32x4*)(LA + row * 512 + ch) = w;
                w.x = pk2(bb[0], bb[1]); w.y = pk2(bb[2], bb[3]); w.z = pk2(bb[4], bb[5]); w.w = pk2(bb[6], bb[7]); *(u32x4*)(BBs + row * 512 + ch) = w; }
    }
};
struct EpiResB {
    static constexpr int PERM = 1; static constexpr int NST = 16;
    bf16_t* O; const bf16_t* R; float scale;
    __device__ __forceinline__ void operator()(const f32x4 (&acc)[2][2][4][2], const GUnit& u, int wr, int wc, int fr, int fq) const {
        const int row0 = u.x * 256 + wr * 64 + fr; const int colt = u.y * 256 + wc * 32 + 8 * fq;
        u32x4 r0 = (u32x4){0u, 0u, 0u, 0u}, r1 = r0;
        if (R) { const size_t off0 = (size_t)row0 * D + colt; r0 = *(const u32x4*)(R + off0); r1 = *(const u32x4*)(R + off0 + HALF); }
#pragma unroll
        for (int idx = 0; idx < 8; ++idx) { const int ai = idx >> 2, m = idx & 3; const size_t off = (size_t)(row0 + ai * HALF + m * 16) * D + colt;
            u32x4 r0n = r0, r1n = r1;
            if (R && idx < 7) { const size_t offn = (size_t)(row0 + ((idx + 1) >> 2) * HALF + ((idx + 1) & 3) * 16) * D + colt; r0n = *(const u32x4*)(R + offn); r1n = *(const u32x4*)(R + offn + HALF); }
#pragma unroll
            for (int bj = 0; bj < 2; ++bj) { f32x4 v0 = acc[ai][bj][m][0], v1 = acc[ai][bj][m][1]; const u32x4 r = bj ? r1 : r0;
                if (R) { v0 = v0 + (f32x4){bflo(r.x), bfhi(r.x), bflo(r.y), bfhi(r.y)} * scale; v1 = v1 + (f32x4){bflo(r.z), bfhi(r.z), bflo(r.w), bfhi(r.w)} * scale; }
                u32x4 w; w.x = pk2(v0[0], v0[1]); w.y = pk2(v0[2], v0[3]); w.z = pk2(v1[0], v1[1]); w.w = pk2(v1[2], v1[3]); *(u32x4*)(O + off + bj * HALF) = w; }
            r0 = r0n; r1 = r1n; }
    }
};
struct EpiGLU {
    static constexpr int PERM = 1; static constexpr int NST = 0;
    unsigned char* Hout; float* LG; bool moe;
    __device__ __forceinline__ void operator()(const f32x4 (&acc)[2][2][4][2], const GUnit& u, int wr, int wc, int fr, int fq) const {
        const int row0 = u.x * 256 + wr * 64 + fr;
        if (!moe && u.y == 2) {
            if (wc < 2) {
#pragma unroll
                for (int ai = 0; ai < 2; ++ai)
#pragma unroll
                    for (int m = 0; m < 4; ++m) { float* lp = LG + (size_t)(row0 + ai * HALF + m * 16) * 64 + wc * 32 + 8 * fq;
#pragma unroll
                        for (int n = 0; n < 2; ++n) *(f32x4*)(lp + 4 * n) = acc[ai][0][m][n]; }
            }
            return;
        }
        const int colt = u.y * 128 + wc * 32 + 8 * fq;
#pragma unroll
        for (int ai = 0; ai < 2; ++ai)
#pragma unroll
            for (int m = 0; m < 4; ++m) { unsigned char* hp = Hout + (size_t)(row0 + ai * HALF + m * 16) * DEXP + colt;
                const f32x4 a0 = acc[ai][0][m][0], b0 = acc[ai][1][m][0], a1 = acc[ai][0][m][1], b1 = acc[ai][1][m][1];
                u32x2 w; w.x = pk4_fp8s(siluf_(a0[0]) * b0[0], siluf_(a0[1]) * b0[1], siluf_(a0[2]) * b0[2], siluf_(a0[3]) * b0[3], 1.0f); w.y = pk4_fp8s(siluf_(a1[0]) * b1[0], siluf_(a1[1]) * b1[1], siluf_(a1[2]) * b1[2], siluf_(a1[3]) * b1[3], 1.0f);
                *(u32x2*)hp = w; }
    }
};
constexpr float Y_SCALE = 16.0f;
__device__ __forceinline__ unsigned pk4_fp8(f32x4 a) { int w = 0; w = __builtin_amdgcn_cvt_pk_fp8_f32(a[0] * Y_SCALE, a[1] * Y_SCALE, w, false); w = __builtin_amdgcn_cvt_pk_fp8_f32(a[2] * Y_SCALE, a[3] * Y_SCALE, w, true); return (unsigned)w; }
struct EpiExpDown {
    static constexpr int PERM = 2; static constexpr int NST = 8;
    unsigned char* Y;
    __device__ __forceinline__ void operator()(const f32x4 (&acc)[2][2][4][2], const GUnit& u, int wr, int wc, int fr, int fq) const {
        const int colt = u.y * 256 + wc * 64 + 16 * fq;
#pragma unroll
        for (int ai = 0; ai < 2; ++ai)
#pragma unroll
            for (int m = 0; m < 4; ++m) { const int r = ai * HALF + wr * 64 + m * 16 + fr;
                u32x4 w; w.x = pk4_fp8(acc[ai][0][m][0]); w.y = pk4_fp8(acc[ai][0][m][1]); w.z = pk4_fp8(acc[ai][1][m][0]); w.w = pk4_fp8(acc[ai][1][m][1]);
                *(u32x4*)(Y + (size_t)(u.x * 256 + r) * D + colt) = w; }
    }
};

template <class Map>
__device__ __forceinline__ void transpose_item(const float* W, int K, int N, bf16_t* WT, const Map& map, LAS float* scr, int item, int lane, int ldo = 0) {
    if (ldo == 0) ldo = K;
    const int nblk = N / 32, kb = item / nblk, nb = item % nblk, k0 = 64 * kb, n0 = 32 * nb;
    { f32x4 t[8];
#pragma unroll
      for (int i = 0; i < 8; ++i) t[i] = *(const f32x4*)(W + (size_t)(k0 + 8 * i + (lane >> 3)) * N + n0 + 4 * (lane & 7));
#pragma unroll
      for (int i = 0; i < 8; ++i) { LAS float* d = scr + (8 * i + (lane >> 3)) * 33 + 4 * (lane & 7); d[0] = t[i][0]; d[1] = t[i][1]; d[2] = t[i][2]; d[3] = t[i][3]; } }
    LDS_WAIT(); asm volatile("" ::: "memory");
    const int c = lane & 7;
#pragma unroll
    for (int j = 0; j < 4; ++j) { const int n = (lane >> 3) + 8 * j; const LAS float* s = scr + (8 * c) * 33 + n;
        u32x4 o; o.x = pk2(s[0 * 33], s[1 * 33]); o.y = pk2(s[2 * 33], s[3 * 33]); o.z = pk2(s[4 * 33], s[5 * 33]); o.w = pk2(s[6 * 33], s[7 * 33]);
        *(u32x4*)(WT + (size_t)map(n0 + n) * ldo + k0 + 8 * c) = o; }
    LDS_WAIT(); asm volatile("" ::: "memory");
}
template <class Map>
__device__ __forceinline__ void transpose_item8(const float* W, int K, int N, unsigned char* WT, const Map& map, LAS float* scr, int item, int lane, const float wscale = W8_SCALE) {
    const int nblk = N / 32, kb = item / nblk, nb = item % nblk, k0 = 64 * kb, n0 = 32 * nb;
    { f32x4 t[8];
#pragma unroll
      for (int i = 0; i < 8; ++i) t[i] = *(const f32x4*)(W + (size_t)(k0 + 8 * i + (lane >> 3)) * N + n0 + 4 * (lane & 7));
#pragma unroll
      for (int i = 0; i < 8; ++i) { LAS float* d = scr + (8 * i + (lane >> 3)) * 33 + 4 * (lane & 7); d[0] = t[i][0]; d[1] = t[i][1]; d[2] = t[i][2]; d[3] = t[i][3]; } }
    LDS_WAIT(); asm volatile("" ::: "memory");
    const int c = lane & 7;
#pragma unroll
    for (int j = 0; j < 4; ++j) { const int n = (lane >> 3) + 8 * j; const LAS float* s = scr + (8 * c) * 33 + n;
        u32x2 o; o.x = pk4_fp8s(s[0 * 33], s[1 * 33], s[2 * 33], s[3 * 33], wscale); o.y = pk4_fp8s(s[4 * 33], s[5 * 33], s[6 * 33], s[7 * 33], wscale);
        *(u32x2*)(WT + (size_t)map(n0 + n) * K + k0 + 8 * c) = o; }
    LDS_WAIT(); asm volatile("" ::: "memory");
}
struct MapId { int off; __device__ __forceinline__ int operator()(int n) const { return off + n; } };
struct MapIn { __device__ __forceinline__ int operator()(int n) const { if (n >= 1024) return n; const int d = n & 127; return (n & ~127) + 2 * (d & 63) + (d >> 6); } };
struct MapGlu { int off; __device__ __forceinline__ int operator()(int n) const { return (n >> 7) * 256 + off + (n & 127); } };

__device__ __forceinline__ void phase_cvt(const Ctx& c) {
    const int layer = c.layer; const size_t L = (size_t)layer;
    LAS float* scr = (LAS float*)(c.lds + c.wave * 16384);
    const int gw = c.bid * 8 + c.wave, NGW = c.G * 8;
    unsigned char* w_in8 = (unsigned char*)(c.ws + W_IN); unsigned char* e13_8 = (unsigned char*)(c.ws + W_E13); bf16_t* w_brT = (bf16_t*)(c.ws + W_BR); bf16_t* w_outT = (bf16_t*)(c.ws + W_OUT); bf16_t* smT = (bf16_t*)(c.ws + W_SM);
    bf16_t* shupT = (bf16_t*)(c.ws + W_SHUP); unsigned char* shdn8 = (unsigned char*)(c.ws + W_SHDN); unsigned char* e2_8 = (unsigned char*)(c.ws + W_E2);
    constexpr int I_IN = (D / 64) * (INW / 32), I_BR = (512 / 64) * (D / 32), I_OUT = (D / 64) * (D / 32), I_SM = (128 / 64) * (128 / 32), I_UP = (D / 64) * (DEXP / 32), I_DN = (DEXP / 64) * (D / 32), I_RT = (D / 64) * (64 / 32);
    constexpr int N0 = I_IN, N1 = N0 + 3 * I_BR, N2 = N1 + I_OUT, N3 = N2 + 12 * I_SM, N4 = N3 + 2 * I_UP, N5 = N4 + I_RT, N6 = N5 + I_DN, N7 = N6 + 2 * NEXP * I_UP, N8 = N7 + NEXP * I_DN;
    for (int it = gw; it < N8; it += NGW) {
        int r = it;
        if (r < N0) { transpose_item8(inp(c, I_WIN, L * D * INW), D, INW, w_in8, MapIn{}, scr, r, c.lane); continue; }
        if (r < N1) { r -= N0; const int i = r / I_BR; transpose_item8(inp(c, I_WBR, L * 3 * 512 * D) + (size_t)i * 512 * D, 512, D, (unsigned char*)w_brT + (size_t)i * D * 512, MapId{0}, scr, r % I_BR, c.lane, W8_SCALE * (256.0f / 255.0f)); continue; }
        if (r < N2) { r -= N1; transpose_item8(inp(c, I_WOUT, L * D * D), D, D, (unsigned char*)w_outT, MapId{0}, scr, r, c.lane); continue; }
        if (r < N3) { r -= N2; const int i = r / I_SM, which = i / 4, g = i % 4; const float* src = inp(c, which == 0 ? I_POOLW : (which == 1 ? I_WA : I_WX), L * 4 * 128 * 128) + (size_t)g * 128 * 128;
            bf16_t* dst = which == 0 ? smT + (size_t)(g >> 1) * 65536 + (size_t)(g & 1) * 128 * 256 + (g & 1) * 128 : smT + (size_t)(2 + g) * 65536 + (size_t)(which - 1) * 128 * 256 + (g & 1) * 128;
            transpose_item(src, 128, 128, dst, MapId{0}, scr, r % I_SM, c.lane, 256); continue; }
        if (r < N4) { r -= N3; const int i = r / I_UP; transpose_item(inp(c, i == 0 ? I_SW1 : I_SW3, L * D * DEXP), D, DEXP, shupT, MapGlu{i * 128}, scr, r % I_UP, c.lane); continue; }
        if (r < N5) { r -= N4; transpose_item(inp(c, I_RW, L * D * 64), D, 64, shupT, MapId{512}, scr, r, c.lane); continue; }
        if (r < N6) { r -= N5; transpose_item8(inp(c, I_SW2, L * DEXP * D), DEXP, D, shdn8, MapId{0}, scr, r, c.lane); continue; }
        if (r < N7) { r -= N6; const int i = r / I_UP, e = i >> 1, which = i & 1; transpose_item8(inp(c, which ? I_EW3 : I_EW1, L * NEXP * D * DEXP) + (size_t)e * D * DEXP, D, DEXP, e13_8 + (size_t)e * 512 * D, MapGlu{which * 128}, scr, r % I_UP, c.lane); continue; }
        r -= N7; { const int e = r / I_DN; transpose_item8(inp(c, I_EW2, L * NEXP * DEXP * D) + (size_t)e * DEXP * D, DEXP, D, e2_8 + (size_t)e * D * DEXP, MapId{0}, scr, r % I_DN, c.lane); }
    }
    { u32x4* z = (u32x4*)(shupT + (size_t)576 * D); const int nz = 192 * D * 2 / 16; for (int i = c.bid * 512 + c.tid; i < nz; i += c.G * 512) z[i] = (u32x4){0u, 0u, 0u, 0u}; }
    {
        u32x4* z = (u32x4*)smT;
        for (int i = c.bid * 512 + c.tid; i < 6 * 256 * 16; i += c.G * 512) { const int t = i / (256 * 16), rr = (i / 16) % 256, ch = i % 16;
            const int khalf = t < 2 ? ((rr >> 7) ^ 1) : (((t - 2) & 1) ^ 1);
            z[((size_t)t * 65536 + (size_t)rr * 256 + khalf * 128) / 8 + ch] = (u32x4){0u, 0u, 0u, 0u}; }
        float* lsT = (float*)(c.ws + W_SM + 768 * 1024); const float* lam_ = inp(c, I_LAM, L * 512);
        for (int i = c.bid * 512 + c.tid; i < 512; i += c.G * 512) lsT[i] = -log1pf(expf(-lam_[i]));
    }
    if (layer == 0) {
        const f32x4* xs = (const f32x4*)inp(c, I_X, 0); u32x2* xd = (u32x2*)(c.ws + WS_XB); unsigned* xd8 = (unsigned*)(c.ws + WS_XB8);
        for (size_t i = (size_t)c.bid * 512 + c.tid; i < (size_t)T * D / 4; i += (size_t)c.G * 512) { const f32x4 v = xs[i]; u32x2 w; w.x = pk2(v[0], v[1]); w.y = pk2(v[2], v[3]); xd[i] = w; xd8[i] = pk4_fp8s(v[0], v[1], v[2], v[3], 1.0f); }
        unsigned* csT = (unsigned*)(c.ws + WS_COS);
        for (int i = c.bid * 512 + c.tid; i < SEQ * 64; i += c.G * 512) { const int s = i >> 6, j = i & 63; const float inv = powf(10000.0f, -(float)j / 64.0f); const float ang = (float)((const int*)inp(c, I_POS, 0))[s] * inv; csT[i] = pk2(cosf(ang), sinf(ang)); }
    }
}

constexpr int TP = 272;
__device__ __forceinline__ void load_tile128(lds_t* dst, const bf16_t* src, int gp, int rows, int tid) {
    for (int v = tid; v < rows * 16; v += 512) { const int r = v >> 4, cb = v & 15; *(LAS u32x4*)(dst + r * TP + cb * 16) = *(const u32x4*)(src + (size_t)r * gp + cb * 8); }
}
__device__ __forceinline__ float ret_log2g(int h) { return log2f(1.0f - exp2f(-5.0f - (float)h)); }

__device__ __forceinline__ void frag_col8(bf16x8 (&out)[8], const lds_t* X, int pitchB, int k0, int fr, int fq) {
    const int q = fr >> 2, p = fr & 3;
    const unsigned a0 = (unsigned)(size_t)X + (unsigned)((k0 + 8 * fq + q) * pitchB + 4 * p * 2), a1 = a0 + 4u * (unsigned)pitchB;
    u16x4 lo[8], hi[8];
    asm volatile("ds_read_b64_tr_b16 %0, %16\n\tds_read_b64_tr_b16 %1, %16 offset:32\n\tds_read_b64_tr_b16 %2, %16 offset:64\n\tds_read_b64_tr_b16 %3, %16 offset:96\n\t"
                 "ds_read_b64_tr_b16 %4, %16 offset:128\n\tds_read_b64_tr_b16 %5, %16 offset:160\n\tds_read_b64_tr_b16 %6, %16 offset:192\n\tds_read_b64_tr_b16 %7, %16 offset:224\n\t"
                 "ds_read_b64_tr_b16 %8, %17\n\tds_read_b64_tr_b16 %9, %17 offset:32\n\tds_read_b64_tr_b16 %10, %17 offset:64\n\tds_read_b64_tr_b16 %11, %17 offset:96\n\t"
                 "ds_read_b64_tr_b16 %12, %17 offset:128\n\tds_read_b64_tr_b16 %13, %17 offset:160\n\tds_read_b64_tr_b16 %14, %17 offset:192\n\tds_read_b64_tr_b16 %15, %17 offset:224\n\ts_waitcnt lgkmcnt(0)"
                 : "=&v"(lo[0]), "=&v"(lo[1]), "=&v"(lo[2]), "=&v"(lo[3]), "=&v"(lo[4]), "=&v"(lo[5]), "=&v"(lo[6]), "=&v"(lo[7]),
                   "=&v"(hi[0]), "=&v"(hi[1]), "=&v"(hi[2]), "=&v"(hi[3]), "=&v"(hi[4]), "=&v"(hi[5]), "=&v"(hi[6]), "=&v"(hi[7])
                 : "v"(a0), "v"(a1) : "memory");
#pragma unroll
    for (int i = 0; i < 8; ++i) { bf16x8 r; r[0] = (short)lo[i][0]; r[1] = (short)lo[i][1]; r[2] = (short)lo[i][2]; r[3] = (short)lo[i][3]; r[4] = (short)hi[i][0]; r[5] = (short)hi[i][1]; r[6] = (short)hi[i][2]; r[7] = (short)hi[i][3]; out[i] = r; }
}
#define ACC8(S, X, OP) do { S[0] OP bflo((X).x); S[1] OP bfhi((X).x); S[2] OP bflo((X).y); S[3] OP bfhi((X).y); S[4] OP bflo((X).z); S[5] OP bfhi((X).z); S[6] OP bflo((X).w); S[7] OP bfhi((X).w); } while (0)
template <int W>
__device__ __forceinline__ void pool_fill(bf16_t* dst, const bf16_t* Hcol, int r0, int s0) {
#pragma unroll 1
    for (int blk = 0; blk < 2; ++blk) {
        const int rb = r0 + blk * 4 - (W - 1);
        u32x4 lo[3], hi[4]; float sum[8];
#pragma unroll
        for (int e = 0; e < 8; ++e) sum[e] = 0.f;
#pragma unroll
        for (int j = 0; j < W + 3; ++j) { const int rr = rb + j; const int rc = rr < -s0 ? -s0 : rr; u32x4 xv = *(const u32x4*)(Hcol + (ptrdiff_t)rc * HW); if (s0 + rr < 0) xv = (u32x4){0u, 0u, 0u, 0u};
            if (j < W) ACC8(sum, xv, +=);
            if (j < 3) lo[j] = xv;
            if (j >= W - 1) hi[j - (W - 1)] = xv; }
#pragma unroll
        for (int o = 0; o < 4; ++o) {
            if (o > 0) { ACC8(sum, hi[o], +=); ACC8(sum, lo[o - 1], -=); }
            const int rr = r0 + blk * 4 + o; const int s = s0 + rr; const int nn = (s + 1) < W ? (s + 1) : W; const float inv = 1.0f / (float)nn; const u32x4 self = hi[o];
            u32x4 ov; ov.x = pk2(sum[0] * inv - bflo(self.x), sum[1] * inv - bfhi(self.x)); ov.y = pk2(sum[2] * inv - bflo(self.y), sum[3] * inv - bfhi(self.y));
            ov.z = pk2(sum[4] * inv - bflo(self.z), sum[5] * inv - bfhi(self.z)); ov.w = pk2(sum[6] * inv - bflo(self.w), sum[7] * inv - bfhi(self.w));
            *(u32x4*)(dst + (size_t)rr * 1536) = ov;
        }
    }
}
__device__ __forceinline__ void phase_mix1(const Ctx& c) {
    const size_t L = (size_t)c.layer;
    const float* conv_w = inp(c, I_CONVW, L * 4 * 512); const float* conv_b = inp(c, I_CONVB, L * 512); const float* pool_scale = inp(c, I_POOLS, L * 512);
    const float* ba_ = inp(c, I_BA, L * 512); const float* bx_ = inp(c, I_BX, L * 512); const float* lam_ = inp(c, I_LAM, L * 512);
    const int tid = c.tid, lane = c.lane, wave = c.wave, fr = lane & 15, fq = lane >> 4;
    const bf16_t* H = (const bf16_t*)(c.ws + S_H7); bf16_t* KV = (bf16_t*)(c.ws + S_KV); bf16_t* BR = (bf16_t*)(c.ws + S_BR);
    bf16_t* LA = (bf16_t*)(c.ws + S_LA); bf16_t* BBs = (bf16_t*)(c.ws + S_BB);
    const bf16_t* smT = (const bf16_t*)(c.ws + W_SM);
    lds_t* L0 = c.lds; lds_t* L1 = c.lds + 128 * TP;
    for (int p = c.bid; p < NPANEL; p += c.G) {
        const int b = p >> 4, t0 = p * 256;
        u32x4 kraw[4], vraw[4];
#pragma unroll
        for (int it = 0; it < 4; ++it) { const int v = tid + it * 512, r = v >> 4, cb = v & 15; kraw[it] = *(const u32x4*)(H + (size_t)(t0 + r) * HW + 512 + cb * 8); vraw[it] = *(const u32x4*)(H + (size_t)(t0 + r) * HW + 1024 + cb * 8); }
#pragma unroll 1
        for (int u = 0; u < 8; ++u) {
            const int cc = u >> 2, h = u & 3, n = (p & 15) * 2 + cc; const float l2g = ret_log2g(h);
            __syncthreads();
#pragma unroll
            for (int it = 0; it < 4; ++it) { const int v = tid + it * 512, r = v >> 4, cb = v & 15; const float dk = exp2f(l2g * (float)(127 - r)); const u32x4 kv = kraw[it];
                u32x4 ko; ko.x = pk2(bflo(kv.x) * dk, bfhi(kv.x) * dk); ko.y = pk2(bflo(kv.y) * dk, bfhi(kv.y) * dk); ko.z = pk2(bflo(kv.z) * dk, bfhi(kv.z) * dk); ko.w = pk2(bflo(kv.w) * dk, bfhi(kv.w) * dk);
                *(LAS u32x4*)(L0 + r * TP + cb * 16) = ko; *(LAS u32x4*)(L1 + r * TP + cb * 16) = vraw[it]; }
            __syncthreads();
            if (u < 7) { const int u2 = u + 1, cc2 = u2 >> 2, h2 = u2 & 3, tc2 = t0 + cc2 * 128;
#pragma unroll
                for (int it = 0; it < 4; ++it) { const int v = tid + it * 512, r = v >> 4, cb = v & 15; kraw[it] = *(const u32x4*)(H + (size_t)(tc2 + r) * HW + 512 + h2 * 128 + cb * 8); vraw[it] = *(const u32x4*)(H + (size_t)(tc2 + r) * HW + 1024 + h2 * 128 + cb * 8); } }
            f32x4 acc[8];
#pragma unroll
            for (int i = 0; i < 8; ++i) acc[i] = (f32x4){0.f, 0.f, 0.f, 0.f};
#pragma unroll
            for (int j0 = 0; j0 < 128; j0 += 32) {
                const bf16x8 a = frag_col(L1, TP, j0, wave * 16, fr, fq);
                bf16x8 kb[8]; frag_col8(kb, L0, TP, j0, fr, fq);
#pragma unroll
                for (int i = 0; i < 8; ++i) acc[i] = mfma16(kb[i], a, acc[i]);
            }
            bf16_t* kvp = KV + ((size_t)((b * 4 + h) * 32 + n)) * 16384;
#pragma unroll
            for (int i = 0; i < 8; ++i) { u32x2 w; w.x = pk2(acc[i][0], acc[i][1]); w.y = pk2(acc[i][2], acc[i][3]); *(u32x2*)(kvp + (wave * 16 + fr) * 128 + i * 16 + 4 * fq) = w; }
        }
        {
            const int cb = lane & 15, rl = lane >> 4, s0 = t0 & (SEQ - 1), g = wave & 3, r0 = rl * 64;
            if (wave < 4) {
                const int W = 2 << g; const bf16_t* Hcol = H + (size_t)t0 * HW + 2048 + g * 128 + cb * 8; bf16_t* dst = BR + (size_t)t0 * 1536 + g * 128 + cb * 8;
                float sum[8];
#pragma unroll
                for (int e = 0; e < 8; ++e) sum[e] = 0.f;
                for (int r = r0 - W + 1; r < r0; ++r) { const int rc = r < -s0 ? -s0 : r; u32x4 xv = *(const u32x4*)(Hcol + (ptrdiff_t)rc * HW); if (s0 + r < 0) xv = (u32x4){0u, 0u, 0u, 0u}; ACC8(sum, xv, +=); }
#pragma unroll 1
                for (int rb = r0; rb < r0 + 64; rb += 8) {
                    u32x4 xn[8], xo[8];
#pragma unroll
                    for (int i = 0; i < 8; ++i) { const int r = rb + i, ro = r - W; const int rcn = r < -s0 ? -s0 : r, rco = ro < -s0 ? -s0 : ro;
                        xn[i] = *(const u32x4*)(Hcol + (ptrdiff_t)rcn * HW); xo[i] = *(const u32x4*)(Hcol + (ptrdiff_t)rco * HW); if (s0 + ro < 0) xo[i] = (u32x4){0u, 0u, 0u, 0u}; }
#pragma unroll
                    for (int i = 0; i < 8; ++i) { const int r = rb + i; ACC8(sum, xn[i], +=); if (r > r0) ACC8(sum, xo[i], -=);
                        const int s = s0 + r; const int nn = (s + 1) < W ? (s + 1) : W; const float inv = 1.0f / (float)nn; const u32x4 self = xn[i];
                        u32x4 ov; ov.x = pk2(sum[0] * inv - bflo(self.x), sum[1] * inv - bfhi(self.x)); ov.y = pk2(sum[2] * inv - bflo(self.y), sum[3] * inv - bfhi(self.y));
                        ov.z = pk2(sum[4] * inv - bflo(self.z), sum[5] * inv - bfhi(self.z)); ov.w = pk2(sum[6] * inv - bflo(self.w), sum[7] * inv - bfhi(self.w));
                        *(u32x4*)(dst + (size_t)r * 1536) = ov; }
                }
            } else {
                const int ch = g * 128 + cb * 8; const bf16_t* Hcol = H + (size_t)t0 * HW + 2560 + ch; bf16_t* dst = BR + (size_t)t0 * 1536 + 1024 + ch;
                float cwv[4][8], cbv[8];
#pragma unroll
                for (int e = 0; e < 8; ++e) { cbv[e] = conv_b[ch + e];
#pragma unroll
                    for (int k = 0; k < 4; ++k) cwv[k][e] = conv_w[k * 512 + ch + e]; }
                u32x4 p1, p2, p3;
                { const int ra = r0 - 1, rb2 = r0 - 2, rc3 = r0 - 3; p1 = *(const u32x4*)(Hcol + (ptrdiff_t)(ra < -s0 ? -s0 : ra) * HW); p2 = *(const u32x4*)(Hcol + (ptrdiff_t)(rb2 < -s0 ? -s0 : rb2) * HW); p3 = *(const u32x4*)(Hcol + (ptrdiff_t)(rc3 < -s0 ? -s0 : rc3) * HW);
                  if (s0 + ra < 0) p1 = (u32x4){0u, 0u, 0u, 0u}; if (s0 + rb2 < 0) p2 = (u32x4){0u, 0u, 0u, 0u}; if (s0 + rc3 < 0) p3 = (u32x4){0u, 0u, 0u, 0u}; }
#pragma unroll 1
                for (int rb = r0; rb < r0 + 64; rb += 8) {
                    u32x4 xn[8];
#pragma unroll
                    for (int i = 0; i < 8; ++i) xn[i] = *(const u32x4*)(Hcol + (ptrdiff_t)(rb + i) * HW);
#pragma unroll
                    for (int i = 0; i < 8; ++i) { float sum[8];
#pragma unroll
                        for (int e = 0; e < 8; ++e) sum[e] = cbv[e];
                        const u32x4 t0x = xn[i];
#define TAP8(X, K) do { sum[0] += bflo((X).x) * cwv[K][0]; sum[1] += bfhi((X).x) * cwv[K][1]; sum[2] += bflo((X).y) * cwv[K][2]; sum[3] += bfhi((X).y) * cwv[K][3]; sum[4] += bflo((X).z) * cwv[K][4]; sum[5] += bfhi((X).z) * cwv[K][5]; sum[6] += bflo((X).w) * cwv[K][6]; sum[7] += bfhi((X).w) * cwv[K][7]; } while (0)
                        TAP8(t0x, 0); TAP8(p1, 1); TAP8(p2, 2); TAP8(p3, 3);
#undef TAP8
                        u32x4 ov; ov.x = pk2(sum[0], sum[1]); ov.y = pk2(sum[2], sum[3]); ov.z = pk2(sum[4], sum[5]); ov.w = pk2(sum[6], sum[7]);
                        *(u32x4*)(dst + (size_t)(rb + i) * 1536) = ov; p3 = p2; p2 = p1; p1 = t0x; }
                }
            }
        }
    }
}

__device__ __forceinline__ void phase_rgscan(const Ctx& c) {
    bf16_t* LA = (bf16_t*)(c.ws + S_LA); bf16_t* BBs = (bf16_t*)(c.ws + S_BB); float* AE = (float*)(c.ws + S_RGC); float* HE = AE + 262144;
    for (int p = c.bid; p < NPANEL; p += c.G) {
        const int cp = c.tid & 255, ck = p * 2 + (c.tid >> 8); const size_t base = (size_t)ck * 128 * 512 + 2 * cp; float h0 = 0.f, P0 = 1.f, h1 = 0.f, P1 = 1.f;
#pragma unroll 8
        for (int j = 0; j < 128; ++j) { const size_t o = base + (size_t)j * 512; const unsigned la = *(const unsigned*)(LA + o), bb = *(const unsigned*)(BBs + o);
            const float a0 = __expf(bflo(la)), a1 = __expf(bfhi(la));
            h0 = a0 * h0 + bflo(bb); P0 *= a0; h1 = a1 * h1 + bfhi(bb); P1 *= a1;
            *(unsigned*)(LA + o) = pk2(h0, h1); *(unsigned*)(BBs + o) = pk2(P0, P1); }
        *(f32x2*)(AE + (size_t)ck * 512 + 2 * cp) = (f32x2){P0, P1}; *(f32x2*)(HE + (size_t)ck * 512 + 2 * cp) = (f32x2){h0, h1};
    }
}
__device__ __forceinline__ void phase_scan(const Ctx& c) {
    u32x4* KV = (u32x4*)(c.ws + S_KV);
    for (int i = c.bid * 512 + c.tid; i < 64 * 2048; i += c.G * 512) { const int bh = i >> 11, e = i & 2047; const float cd = exp2f(ret_log2g(bh & 3) * 128.0f);
        float st[8];
#pragma unroll
        for (int q = 0; q < 8; ++q) st[q] = 0.f;
        u32x4* p = KV + (size_t)bh * 32 * 2048 + e;
#pragma unroll 8
        for (int n = 0; n < 32; ++n) { const u32x4 v = p[(size_t)n * 2048]; u32x4 o; o.x = pk2(st[0], st[1]); o.y = pk2(st[2], st[3]); o.z = pk2(st[4], st[5]); o.w = pk2(st[6], st[7]); p[(size_t)n * 2048] = o;
            st[0] = st[0] * cd + bflo(v.x); st[1] = st[1] * cd + bfhi(v.x); st[2] = st[2] * cd + bflo(v.y); st[3] = st[3] * cd + bfhi(v.y); st[4] = st[4] * cd + bflo(v.z); st[5] = st[5] * cd + bfhi(v.z); st[6] = st[6] * cd + bflo(v.w); st[7] = st[7] * cd + bfhi(v.w); } }
    float* AE = (float*)(c.ws + S_RGC); float* HE = AE + 262144; float* CI = HE + 262144;
    for (int i = c.bid * 512 + c.tid; i < NBATCH * 512; i += c.G * 512) { const int b = i >> 9, ch = i & 511; float cr = 0.f;
        for (int n = 0; n < 32; ++n) { const size_t o = (size_t)(b * 32 + n) * 512 + ch; CI[o] = cr; cr = AE[o] * cr + HE[o]; } }
}
__device__ __forceinline__ void frag_tr8(bf16x8 (&out)[8], const lds_t* X, int pitchB, int rbase, int hrows, int fr) {
    const int q = fr >> 2, p = fr & 3;
    const unsigned a0 = (unsigned)(size_t)X + (unsigned)((rbase + q) * pitchB + 4 * p * 2), a1 = a0 + (unsigned)(hrows * pitchB);
    u16x4 lo[8], hi[8];
    asm volatile("ds_read_b64_tr_b16 %0, %16\n\tds_read_b64_tr_b16 %1, %16 offset:32\n\tds_read_b64_tr_b16 %2, %16 offset:64\n\tds_read_b64_tr_b16 %3, %16 offset:96\n\t"
                 "ds_read_b64_tr_b16 %4, %16 offset:128\n\tds_read_b64_tr_b16 %5, %16 offset:160\n\tds_read_b64_tr_b16 %6, %16 offset:192\n\tds_read_b64_tr_b16 %7, %16 offset:224\n\t"
                 "ds_read_b64_tr_b16 %8, %17\n\tds_read_b64_tr_b16 %9, %17 offset:32\n\tds_read_b64_tr_b16 %10, %17 offset:64\n\tds_read_b64_tr_b16 %11, %17 offset:96\n\t"
                 "ds_read_b64_tr_b16 %12, %17 offset:128\n\tds_read_b64_tr_b16 %13, %17 offset:160\n\tds_read_b64_tr_b16 %14, %17 offset:192\n\tds_read_b64_tr_b16 %15, %17 offset:224\n\ts_waitcnt lgkmcnt(0)"
                 : "=&v"(lo[0]), "=&v"(lo[1]), "=&v"(lo[2]), "=&v"(lo[3]), "=&v"(lo[4]), "=&v"(lo[5]), "=&v"(lo[6]), "=&v"(lo[7]),
                   "=&v"(hi[0]), "=&v"(hi[1]), "=&v"(hi[2]), "=&v"(hi[3]), "=&v"(hi[4]), "=&v"(hi[5]), "=&v"(hi[6]), "=&v"(hi[7])
                 : "v"(a0), "v"(a1) : "memory");
#pragma unroll
    for (int i = 0; i < 8; ++i) { bf16x8 r; r[0] = (short)lo[i][0]; r[1] = (short)lo[i][1]; r[2] = (short)lo[i][2]; r[3] = (short)lo[i][3]; r[4] = (short)hi[i][0]; r[5] = (short)hi[i][1]; r[6] = (short)hi[i][2]; r[7] = (short)hi[i][3]; out[i] = r; }
}
__device__ __forceinline__ void phase_mix2(const Ctx& c) {
    const int tid = c.tid, lane = c.lane, wave = c.wave, fr = lane & 15, fq = lane >> 4;
    const bf16_t* H = (const bf16_t*)(c.ws + S_H7); const bf16_t* KV = (const bf16_t*)(c.ws + S_KV); bf16_t* BR = (bf16_t*)(c.ws + S_BR);
    const bf16_t* HL = (const bf16_t*)(c.ws + S_LA); const bf16_t* PP = (const bf16_t*)(c.ws + S_BB); const float* CI = (const float*)(c.ws + S_RGC) + 2 * 262144;
    lds_t* LK = c.lds; lds_t* LV = c.lds + 128 * TP; lds_t* LP = c.lds + 256 * TP;
    for (int p = c.bid; p < NPANEL; p += c.G) {
        const int b = p >> 4, t0 = p * 256;
        u32x4 kraw[4], vraw[4], praw[4];
        {
            const int n0 = (p & 15) * 2;
#pragma unroll
            for (int it = 0; it < 4; ++it) { const int v = tid + it * 512, r = v >> 4, cb = v & 15; kraw[it] = *(const u32x4*)(H + (size_t)(t0 + r) * HW + 512 + cb * 8); vraw[it] = *(const u32x4*)(H + (size_t)(t0 + r) * HW + 1024 + cb * 8); }
            if (n0 > 0) { const bf16_t* kvp = KV + ((size_t)((b * 4 + 0) * 32 + n0)) * 16384;
#pragma unroll
                for (int it = 0; it < 4; ++it) { const int v = tid + it * 512; praw[it] = *(const u32x4*)(kvp + (size_t)v * 8); } }
        }
#pragma unroll 1
        for (int u = 0; u < 8; ++u) {
            const int cc = u >> 2, h = u & 3, n = (p & 15) * 2 + cc, tc = t0 + cc * 128; const float l2g = ret_log2g(h);
            bf16x8 qf[4];
#pragma unroll
            for (int d = 0; d < 4; ++d) qf[d] = *(const bf16x8*)(H + (size_t)(tc + wave * 16 + fr) * HW + h * 128 + d * 32 + 8 * fq);
            u32x2 gv[8];
#pragma unroll
            for (int i = 0; i < 8; ++i) gv[i] = *(const u32x2*)(H + (size_t)(tc + wave * 16 + fr) * HW + 1536 + h * 128 + i * 16 + 4 * fq);
            __syncthreads();
#pragma unroll
            for (int it = 0; it < 4; ++it) { const int v = tid + it * 512, r = v >> 4, cb = v & 15; *(LAS u32x4*)(LK + r * TP + cb * 16) = kraw[it]; *(LAS u32x4*)(LV + r * TP + cb * 16) = vraw[it]; }
            if (n > 0) {
#pragma unroll
                for (int it = 0; it < 4; ++it) { const int v = tid + it * 512, r = v >> 4, cb = v & 15; *(LAS u32x4*)(LP + r * TP + cb * 16) = praw[it]; } }
            __syncthreads();
            if (u < 7) {
                const int u2 = u + 1, cc2 = u2 >> 2, h2 = u2 & 3, tc2 = t0 + cc2 * 128, n2 = (p & 15) * 2 + cc2;
#pragma unroll
                for (int it = 0; it < 4; ++it) { const int v = tid + it * 512, r = v >> 4, cb = v & 15; kraw[it] = *(const u32x4*)(H + (size_t)(tc2 + r) * HW + 512 + h2 * 128 + cb * 8); vraw[it] = *(const u32x4*)(H + (size_t)(tc2 + r) * HW + 1024 + h2 * 128 + cb * 8); }
                if (n2 > 0) { const bf16_t* kvp = KV + ((size_t)((b * 4 + h2) * 32 + n2)) * 16384;
#pragma unroll
                    for (int it = 0; it < 4; ++it) { const int v = tid + it * 512; praw[it] = *(const u32x4*)(kvp + (size_t)v * 8); } }
            }
            const float gc = exp2f(l2g * (float)fr);
            float gj[4];
#pragma unroll
            for (int r = 0; r < 4; ++r) gj[r] = exp2f(-l2g * (float)(4 * fq + r));
            bf16x8 sb[4];
#pragma unroll
            for (int s = 0; s < 4; ++s) {
                u32x2 half[2];
#pragma unroll
                for (int hh = 0; hh < 2; ++hh) { const int jt = 2 * s + hh; f32x4 st = (f32x4){0.f, 0.f, 0.f, 0.f};
                    if (jt <= wave) {
#pragma unroll
                        for (int d = 0; d < 4; ++d) { const bf16x8 a = frag_row(LK, TP, jt * 16, d * 32, fr, fq); st = mfma16(a, qf[d], st); }
                        const float gt = gc * exp2f(l2g * (float)(16 * (wave - jt)));
#pragma unroll
                        for (int r = 0; r < 4; ++r) { const bool ok = (jt < wave) || (4 * fq + r <= fr); st[r] = ok ? st[r] * gt * gj[r] : 0.f; } }
                    half[hh].x = pk2(st[0], st[1]); half[hh].y = pk2(st[2], st[3]); }
                const u32x4 w = (u32x4){half[0].x, half[0].y, half[1].x, half[1].y}; sb[s] = __builtin_bit_cast(bf16x8, w);
            }
            f32x4 o[8];
#pragma unroll
            for (int i = 0; i < 8; ++i) o[i] = (f32x4){0.f, 0.f, 0.f, 0.f};
            if (n > 0) {
#pragma unroll
                for (int d = 0; d < 4; ++d)
#pragma unroll
                    for (int i = 0; i < 8; ++i) { const bf16x8 a = frag_row(LP, TP, i * 16, d * 32, fr, fq); o[i] = mfma16(a, qf[d], o[i]); }
                const float qd = exp2f(l2g * (float)(wave * 16 + fr + 1));
#pragma unroll
                for (int i = 0; i < 8; ++i) o[i] = o[i] * qd;
            }
#pragma unroll
            for (int s = 0; s < 4; ++s) if (2 * s <= wave) { bf16x8 vt[8]; frag_tr8(vt, LV, TP, 32 * s + 4 * fq, 16, fr);
#pragma unroll
                for (int i = 0; i < 8; ++i) o[i] = mfma16(vt[i], sb[s], o[i]); }
            {
                float sm = 0.f;
#pragma unroll
                for (int i = 0; i < 8; ++i) sm += (o[i][0] + o[i][1]) + (o[i][2] + o[i][3]);
                sm += __shfl_xor(sm, 16); sm += __shfl_xor(sm, 32);
                const float mu = sm * (1.0f / 128.0f); float sq = 0.f;
#pragma unroll
                for (int i = 0; i < 8; ++i) { o[i] = o[i] - mu; sq += (o[i][0] * o[i][0] + o[i][1] * o[i][1]) + (o[i][2] * o[i][2] + o[i][3] * o[i][3]); }
                sq += __shfl_xor(sq, 16); sq += __shfl_xor(sq, 32);
                const float rstd = 1.0f / sqrtf(sq * (1.0f / 128.0f) + GN_EPS);
                const size_t row = (size_t)(tc + wave * 16 + fr);
#pragma unroll
                for (int i = 0; i < 8; ++i) { const int col = h * 128 + i * 16 + 4 * fq; const u32x2 g = gv[i];
                    *(unsigned*)((unsigned char*)BR + row * 3072 + col) = pk4_fp8s(bflo(g.x) * o[i][0] * rstd, bfhi(g.x) * o[i][1] * rstd, bflo(g.y) * o[i][2] * rstd, bfhi(g.y) * o[i][3] * rstd, 1.0f); }
            }
        }
#pragma unroll 4
        for (int v = tid; v < 256 * 64; v += 512) { const int r = v >> 6, c8 = v & 63; const size_t row = (size_t)(t0 + r); const int ck = (t0 + r) >> 7;
            const u32x4 hl = *(const u32x4*)(HL + row * 512 + c8 * 8), pp = *(const u32x4*)(PP + row * 512 + c8 * 8), gy = *(const u32x4*)(H + row * HW + 3072 + c8 * 8);
            const f32x4 ci0 = *(const f32x4*)(CI + (size_t)ck * 512 + c8 * 8), ci1 = *(const f32x4*)(CI + (size_t)ck * 512 + c8 * 8 + 4);
            u32x2 o; o.x = pk4_fp8s((bflo(hl.x) + bflo(pp.x) * ci0[0]) * bflo(gy.x), (bfhi(hl.x) + bfhi(pp.x) * ci0[1]) * bfhi(gy.x), (bflo(hl.y) + bflo(pp.y) * ci0[2]) * bflo(gy.y), (bfhi(hl.y) + bfhi(pp.y) * ci0[3]) * bfhi(gy.y), 1.0f);
            o.y = pk4_fp8s((bflo(hl.z) + bflo(pp.z) * ci1[0]) * bflo(gy.z), (bfhi(hl.z) + bfhi(pp.z) * ci1[1]) * bfhi(gy.z), (bflo(hl.w) + bflo(pp.w) * ci1[2]) * bflo(gy.w), (bfhi(hl.w) + bfhi(pp.w) * ci1[3]) * bfhi(gy.w), 1.0f);
            *(u32x2*)((unsigned char*)BR + row * 3072 + 1536 + c8 * 8) = o; }
    }
}

__device__ __forceinline__ void ln16_store(f32x4 (&v)[4], int lane, const f32x4 (&gg)[4], const f32x4 (&bb)[4], float* of, bf16_t* ob, unsigned char* o8 = nullptr) {
    float s = 0.f;
#pragma unroll
    for (int j = 0; j < 4; ++j) s += (v[j][0] + v[j][1]) + (v[j][2] + v[j][3]);
    const float mean = wave_sum(s) * (1.f / D); float s2 = 0.f;
#pragma unroll
    for (int j = 0; j < 4; ++j) { v[j] = v[j] - mean; s2 += (v[j][0] * v[j][0] + v[j][1] * v[j][1]) + (v[j][2] * v[j][2] + v[j][3] * v[j][3]); }
    const float rstd = 1.f / sqrtf(wave_sum(s2) * (1.f / D) + LN_EPS);
    f32x4 o[4];
#pragma unroll
    for (int j = 0; j < 4; ++j) o[j] = v[j] * rstd * gg[j] + bb[j];
    if (of) {
#pragma unroll
        for (int j = 0; j < 4; ++j) *(f32x4*)(of + 16 * lane + 4 * j) = o[j]; }
    if (ob) { u32x4 w0, w1; w0.x = pk2(o[0][0], o[0][1]); w0.y = pk2(o[0][2], o[0][3]); w0.z = pk2(o[1][0], o[1][1]); w0.w = pk2(o[1][2], o[1][3]); w1.x = pk2(o[2][0], o[2][1]); w1.y = pk2(o[2][2], o[2][3]); w1.z = pk2(o[3][0], o[3][1]); w1.w = pk2(o[3][2], o[3][3]);
        *(u32x4*)(ob + 16 * lane) = w0; *(u32x4*)(ob + 16 * lane + 8) = w1; }
    if (o8) { u32x4 w; w.x = pk4_fp8s(o[0][0], o[0][1], o[0][2], o[0][3], 1.0f); w.y = pk4_fp8s(o[1][0], o[1][1], o[1][2], o[1][3], 1.0f); w.z = pk4_fp8s(o[2][0], o[2][1], o[2][2], o[2][3], 1.0f); w.w = pk4_fp8s(o[3][0], o[3][1], o[3][2], o[3][3], 1.0f); *(u32x4*)(o8 + 16 * lane) = w; }
}
__device__ __forceinline__ void ld16_bf16(const bf16_t* row, int lane, f32x4 (&v)[4]) {
    const u32x4 a = *(const u32x4*)(row + 16 * lane), b = *(const u32x4*)(row + 16 * lane + 8);
    v[0] = (f32x4){bflo(a.x), bfhi(a.x), bflo(a.y), bfhi(a.y)}; v[1] = (f32x4){bflo(a.z), bfhi(a.z), bflo(a.w), bfhi(a.w)}; v[2] = (f32x4){bflo(b.x), bfhi(b.x), bflo(b.y), bfhi(b.y)}; v[3] = (f32x4){bflo(b.z), bfhi(b.z), bflo(b.w), bfhi(b.w)};
}
__device__ __forceinline__ void phase_ln1(const Ctx& c, bool dummy) {
    const float* g = inp(c, I_LN1G, (size_t)c.layer * D); const float* bt = inp(c, I_LN1B, (size_t)c.layer * D);
    bf16_t* xb = (bf16_t*)(c.ws + WS_XB); const bf16_t* PRE = (const bf16_t*)(c.ws + S_PRE); const int lane = c.lane;
    f32x4 gg[4], bb[4];
#pragma unroll
    for (int j = 0; j < 4; ++j) { gg[j] = *(const f32x4*)(g + 16 * lane + 4 * j); bb[j] = *(const f32x4*)(bt + 16 * lane + 4 * j); }
    int row = c.bid * 8 + c.wave; const int step = c.G * 8;
    u32x4 a = *(const u32x4*)(PRE + (size_t)row * D + 16 * lane), b = *(const u32x4*)(PRE + (size_t)row * D + 16 * lane + 8);
    for (; row < T; row += step) {
        const int nrow = row + step < T ? row + step : row;
        const u32x4 na = *(const u32x4*)(PRE + (size_t)nrow * D + 16 * lane), nb = *(const u32x4*)(PRE + (size_t)nrow * D + 16 * lane + 8);
        f32x4 v[4]; v[0] = (f32x4){bflo(a.x), bfhi(a.x), bflo(a.y), bfhi(a.y)}; v[1] = (f32x4){bflo(a.z), bfhi(a.z), bflo(a.w), bfhi(a.w)}; v[2] = (f32x4){bflo(b.x), bfhi(b.x), bflo(b.y), bfhi(b.y)}; v[3] = (f32x4){bflo(b.z), bfhi(b.z), bflo(b.w), bfhi(b.w)};
        float s = 0.f;
#pragma unroll
        for (int j = 0; j < 4; ++j) s += (v[j][0] + v[j][1]) + (v[j][2] + v[j][3]);
        const float mean = wave_sum(s) * (1.f / D); float s2 = 0.f;
#pragma unroll
        for (int j = 0; j < 4; ++j) { v[j] = v[j] - mean; s2 += (v[j][0] * v[j][0] + v[j][1] * v[j][1]) + (v[j][2] * v[j][2] + v[j][3] * v[j][3]); }
        const float rstd = 1.f / sqrtf(wave_sum(s2) * (1.f / D) + LN_EPS);
        f32x4 o[4];
#pragma unroll
        for (int j = 0; j < 4; ++j) o[j] = v[j] * rstd * gg[j] + bb[j];
        bf16_t* ob = dummy ? (bf16_t*)(c.ws + S_Y) + (size_t)row * D : xb + (size_t)row * D;
        u32x4 w0, w1; w0.x = pk2(o[0][0], o[0][1]); w0.y = pk2(o[0][2], o[0][3]); w0.z = pk2(o[1][0], o[1][1]); w0.w = pk2(o[1][2], o[1][3]); w1.x = pk2(o[2][0], o[2][1]); w1.y = pk2(o[2][2], o[2][3]); w1.z = pk2(o[3][0], o[3][1]); w1.w = pk2(o[3][2], o[3][3]);
        *(u32x4*)(ob + 16 * lane) = w0; *(u32x4*)(ob + 16 * lane + 8) = w1;
        if (!dummy) { u32x4 w; w.x = pk4_fp8s(o[0][0], o[0][1], o[0][2], o[0][3], 1.0f); w.y = pk4_fp8s(o[1][0], o[1][1], o[1][2], o[1][3], 1.0f); w.z = pk4_fp8s(o[2][0], o[2][1], o[2][2], o[2][3], 1.0f); w.w = pk4_fp8s(o[3][0], o[3][1], o[3][2], o[3][3], 1.0f);
            *(u32x4*)((unsigned char*)(c.ws + WS_XB8) + (size_t)row * D + 16 * lane) = w; }
        a = na; b = nb;
    }
}

__device__ __forceinline__ void phase_route(const Ctx& c) {
    const int layer = c.layer;
    const int lane = c.lane, wave = c.wave;
    const float* LG = (const float*)(c.ws + S_LG); unsigned* PE = (unsigned*)(c.ws + S_PE); float* GW = (float*)(c.ws + S_GW); unsigned* LIST = (unsigned*)(c.ws + S_LIST);
    LAS int* lcnt = (LAS int*)(c.lds); LAS int* lbase = lcnt + 64; LAS unsigned* ent = (LAS unsigned*)(lcnt + 128);
    const float rb = inp(c, I_RB, (size_t)layer * 64)[lane];
    for (int p = c.bid; p < NPANEL; p += c.G) {
        const int sub = p / PSUB; unsigned* gcnt = (unsigned*)(c.ws + WS_CTL) + CW_CNT + (layer * NSUB + sub) * 64;
        __syncthreads();
        if (c.tid < 64) lcnt[c.tid] = 0;
        __syncthreads();
        float lgn = LG[(size_t)(p * 256 + wave * 32) * 64 + lane];
        for (int ti = 0; ti < 32; ++ti) {
            const int tl = wave * 32 + ti, t = p * 256 + tl;
            const float lg = lgn; if (ti < 31) lgn = LG[(size_t)(t + 1) * 64 + lane]; const float sc = 1.0f / (1.0f + expf(-lg)); const float bs = sc + rb;
            float m1 = bs; int i1 = lane;
#pragma unroll
            for (int o = 1; o < 8; o <<= 1) { const float om = __shfl_xor(m1, o); const int oi = __shfl_xor(i1, o); if (om > m1 || (om == m1 && oi < i1)) { m1 = om; i1 = oi; } }
            float m2 = (lane == i1) ? -INFINITY : bs;
#pragma unroll
            for (int o = 1; o < 8; o <<= 1) m2 = fmaxf(m2, __shfl_xor(m2, o));
            const float gs = m1 + m2; const int g = lane >> 3; int grank = 0;
#pragma unroll
            for (int gg = 0; gg < 8; ++gg) { const float og = __shfl(gs, gg * 8); grank += (og > gs || (og == gs && gg < g)) ? 1 : 0; }
            unsigned key = __builtin_bit_cast(unsigned, bs); key = (key & 0x80000000u) ? ~key : (key | 0x80000000u); key = (key & ~63u) | (unsigned)(63 - lane); if (grank >= 4) key = (unsigned)(63 - lane);
            unsigned thr = 0u;
#pragma unroll 1
            for (int bit = 31; bit >= 0; --bit) { const unsigned cand = thr | (1u << bit); const int cntb = __builtin_popcountll(__ballot(key >= cand)); if (cntb >= 8) thr = cand; }
            const unsigned long long selm = __ballot(key >= thr);
            const int rank = (key >= thr) ? __builtin_popcountll(selm & ((1ull << lane) - 1ull)) : 8;
            const bool sel = rank < 8; const float ssum = wave_sum(sel ? sc : 0.f);
            if (sel) { const int ls = __hip_atomic_fetch_add(lcnt + lane, 1, __ATOMIC_RELAXED, __HIP_MEMORY_SCOPE_WORKGROUP); ent[tl * 8 + rank] = ((unsigned)lane << 16) | (unsigned)ls; GW[(size_t)t * 8 + rank] = sc / ssum * 2.5f; }
        }
        __syncthreads();
        if (c.tid < 64) lbase[c.tid] = (int)atomicAdd(gcnt + c.tid, (unsigned)lcnt[c.tid]);
        __syncthreads();
        for (int i = c.tid; i < 2048; i += 512) { const unsigned en = ent[i]; const int e = en >> 16, slot = lbase[e] + (int)(en & 0xffffu); const unsigned a = (unsigned)(p * 256) * 8u + (unsigned)i;
            __hip_atomic_store(LIST + ((size_t)sub * NEXP + e) * TSUB + slot, a, __ATOMIC_RELAXED, __HIP_MEMORY_SCOPE_AGENT);
            PE[a] = ((unsigned)e << 20) | (unsigned)slot; }
    }
}
__device__ __forceinline__ void moe_tables(const Ctx& c, int layer, int sub, LAS int* cnt, LAS int* tp) {
    const unsigned* gcnt = (const unsigned*)(c.ws + WS_CTL) + CW_CNT + (layer * NSUB + sub) * 64;
    __syncthreads();
    if (c.tid < 64) { const int n = (int)gcnt[c.tid]; cnt[c.tid] = n; int v = (n + 255) >> 8;
#pragma unroll
        for (int o = 1; o < 64; o <<= 1) { const int t = __shfl_up(v, o); if (c.tid >= o) v += t; }
        tp[c.tid + 1] = v; if (c.tid == 0) tp[0] = 0; }
    __syncthreads();
}
__device__ __forceinline__ void phase_combine(const Ctx& c, int sub, const LAS int* tp, bool last_layer, bool dummy) {
    const float* g2 = inp(c, I_LN2G, (size_t)c.layer * D); const float* b2 = inp(c, I_LN2B, (size_t)c.layer * D);
    const unsigned char* Y = (const unsigned char*)(c.ws + S_Y); const unsigned* PE = (const unsigned*)(c.ws + S_PE); const float* GWp = (const float*)(c.ws + S_GW); bf16_t* xb = (bf16_t*)(c.ws + WS_XB);
    const unsigned char* SF = (const unsigned char*)(c.ws + S_SF);
    const int lane = c.lane;
    f32x4 gg[4], bb[4];
#pragma unroll
    for (int j = 0; j < 4; ++j) { gg[j] = *(const f32x4*)(g2 + 16 * lane + 4 * j); bb[j] = *(const f32x4*)(b2 + 16 * lane + 4 * j); }
    for (int t = sub * TSUB + c.bid * 8 + c.wave; t < (sub + 1) * TSUB; t += c.G * 8) {
        f32x4 v[4]; ld16_bf16(xb + (size_t)t * D, lane, v); const u32x4 sfw = *(const u32x4*)(SF + (size_t)t * D + 16 * lane);
        unsigned pe[8]; float gw[8];
#pragma unroll
        for (int k = 0; k < 8; ++k) { pe[k] = 0; gw[k] = 0.f; }
        { const u32x4 p0 = *(const u32x4*)(PE + (size_t)t * 8), p1 = *(const u32x4*)(PE + (size_t)t * 8 + 4); const f32x4 w0 = *(const f32x4*)(GWp + (size_t)t * 8) * (1.0f / Y_SCALE), w1 = *(const f32x4*)(GWp + (size_t)t * 8 + 4) * (1.0f / Y_SCALE);
          pe[0] = p0.x; pe[1] = p0.y; pe[2] = p0.z; pe[3] = p0.w; pe[4] = p1.x; pe[5] = p1.y; pe[6] = p1.z; pe[7] = p1.w; gw[0] = w0[0]; gw[1] = w0[1]; gw[2] = w0[2]; gw[3] = w0[3]; gw[4] = w1[0]; gw[5] = w1[1]; gw[6] = w1[2]; gw[7] = w1[3]; }
        u32x4 y[8];
#pragma unroll
        for (int k = 0; k < 8; ++k) { const int e = pe[k] >> 20, slot = pe[k] & 0xfffffu; const size_t R = (size_t)tp[e] * 256 + slot; y[k] = *(const u32x4*)(Y + R * D + 16 * lane); }
#pragma unroll
        for (int j = 0; j < 4; ++j) { const unsigned w = j == 0 ? sfw.x : (j == 1 ? sfw.y : (j == 2 ? sfw.z : sfw.w)); const f32x2 lo = __builtin_amdgcn_cvt_pk_f32_fp8((int)w, false), hi = __builtin_amdgcn_cvt_pk_f32_fp8((int)w, true);
            v[j] = v[j] * ALPHA + (f32x4){lo.x, lo.y, hi.x, hi.y} * (1.0f / Y_SCALE); }
#pragma unroll
        for (int k = 0; k < 8; ++k) { const unsigned yw[4] = {y[k].x, y[k].y, y[k].z, y[k].w};
#pragma unroll
            for (int j = 0; j < 4; ++j) { const f32x2 lo = __builtin_amdgcn_cvt_pk_f32_fp8((int)yw[j], false), hi = __builtin_amdgcn_cvt_pk_f32_fp8((int)yw[j], true); v[j] = v[j] + (f32x4){lo.x, lo.y, hi.x, hi.y} * gw[k]; } }
        if (dummy) ln16_store(v, lane, gg, bb, nullptr, (bf16_t*)(c.ws + S_H7 + 876 * MiB) );
        else ln16_store(v, lane, gg, bb, last_layer ? c.out + (size_t)t * D : (float*)nullptr, last_layer ? (bf16_t*)nullptr : xb + (size_t)t * D, last_layer ? (unsigned char*)nullptr : (unsigned char*)(c.ws + WS_XB8) + (size_t)t * D);
    }
}

constexpr int NPH = 21;
__global__ void __launch_bounds__(512, 2) mk_fwd(Args args) {
    extern __shared__ __attribute__((aligned(16))) unsigned char lds_raw[];
    Ctx c0; c0.lds = (lds_t*)lds_raw; c0.tid = threadIdx.x; c0.lane = c0.tid & 63; c0.wave = __builtin_amdgcn_readfirstlane(c0.tid >> 6); c0.G = gridDim.x; c0.bid = blockIdx.x;
    c0.ws = args.ws; c0.out = args.out; c0.layer = 0;
    volatile LAS unsigned* MISC = (volatile LAS unsigned*)(c0.lds + LDS_MISC);
    LAS int* mcnt = (LAS int*)(c0.lds + LDS_MISC + 256); LAS int* mtp = mcnt + 64;
    if (c0.tid < 16) MISC[c0.tid] = 0u;
    if (c0.tid == 0) { LAS unsigned long long* pt = (LAS unsigned long long*)(c0.lds + LDS_PTAB);
#pragma unroll
        for (int i = 0; i < 27; ++i) pt[i] = (unsigned long long)args.in[i]; }
    __syncthreads();
#ifdef X7
    __builtin_amdgcn_fence(__ATOMIC_ACQUIRE, ""); asm volatile("s_waitcnt vmcnt(0)" ::: "memory"); __syncthreads();
#endif
#if MK_ONE_LAUNCH
    XcdBarrier bar = xcd_barrier_post((unsigned*)(c0.ws + WS_CTL) + CW_BAR, MISC + 8);
#define SEAM() xcd_barrier(bar)
#define LSEAM() do { asm volatile("s_waitcnt vmcnt(0)" ::: "memory"); __syncthreads(); if (c0.wave == 0) { __builtin_amdgcn_fence(__ATOMIC_ACQUIRE, "agent"); asm volatile("s_waitcnt vmcnt(0)" ::: "memory"); } __syncthreads(); } while (0)
#else
#define SEAM() do {} while (0)
#define LSEAM() do {} while (0)
#error one launch only
#endif
    const int lo = args.ph_lo, hi = args.ph_hi;
#define IN(k) (lo <= (k) && (k) < hi)
#ifndef PHSEL
#define PHSEL 0xffffffffu
#endif
#define PHS(k) ((PHSEL >> (k)) & 1u)
#ifndef REP_PH
#define REP_PH -1
#define REP_N 0
#endif
#define RP(k) for (int rep_ = 0; rep_ < ((REP_PH == (k)) ? 1 + REP_N : 1); ++rep_)
    for (int l = 0; l < DEPTH; ++l) {
        const int pb = l * NPH;
        c0.layer = l;

        if (PHS(0) && IN(pb + 0)) RP(0) { const Ctx c = fresh(c0); phase_cvt(c); SEAM(); }
        if (PHS(1) && IN(pb + 1)) RP(1) {
            const Ctx c = fresh(c0);
            PanelOrder S{(const char*)(c.ws + WS_XB8), (const char*)(c.ws + W_IN), 14, c.G, c.bid, (size_t)256 * D, (size_t)256 * D};
            EpiIn E{(bf16_t*)(c.ws + S_H7), (const unsigned*)(c.ws + WS_COS), c.lds + LDS_EPI};
            gemm_phase<EpiIn, PanelOrder, false, true>(c.lds, c.tid, D, D, S, E); SEAM(); }
        if (PHS(2) && IN(pb + 2)) RP(2) { { const Ctx c = fresh(c0); phase_mix1(c); LSEAM(); }
            { const Ctx c = fresh(c0);
              OwnOrder S{(const char*)(c.ws + S_BR), (const char*)(c.ws + W_SM), 2, c.G, c.bid, (size_t)256 * 1536 * 2, (size_t)256 * 2, (size_t)65536 * 2, 0};
              EpiPool E{(bf16_t*)(c.ws + S_BR), inp(c, I_POOLS, (size_t)c.layer * 512)};
              gemm_phase<EpiPool, OwnOrder, false>(c.lds, c.tid, 256, 1536 * 2, S, E); }
            { const Ctx c = fresh(c0);
              OwnOrder S{(const char*)(c.ws + S_BR) + 1024 * 2, (const char*)(c.ws + W_SM) + (size_t)2 * 65536 * 2, 4, c.G, c.bid, (size_t)256 * 1536 * 2, (size_t)256 * 2, (size_t)65536 * 2, 1};
              EpiRG E{(const bf16_t*)(c.ws + S_BR), (bf16_t*)(c.ws + S_LA), (bf16_t*)(c.ws + S_BB), inp(c, I_BA, (size_t)c.layer * 512), inp(c, I_BX, (size_t)c.layer * 512), (const float*)(c.ws + W_SM + 768 * 1024)};
              gemm_phase<EpiRG, OwnOrder, false>(c.lds, c.tid, 256, 1536 * 2, S, E); }
            LSEAM(); }
        if (PHS(3) && IN(pb + 3)) RP(3) { const Ctx c = fresh(c0); phase_rgscan(c); SEAM(); }
        if (PHS(4) && IN(pb + 4)) RP(4) { const Ctx c = fresh(c0); phase_scan(c); SEAM(); }
        if (PHS(5) && IN(pb + 5)) RP(5) { const Ctx c = fresh(c0); phase_mix2(c); SEAM(); }
        if (PHS(6) && IN(pb + 6)) RP(6) {
            const Ctx c = fresh(c0);
            PanelOrder S{(const char*)(c.ws + WS_XB8), (const char*)(c.ws + W_IN) + (size_t)HW * D, 12, c.G, c.bid, (size_t)256 * D, (size_t)256 * D};
            EpiGates E{(unsigned char*)(c.ws + S_H7), inp(c, I_GATEB, (size_t)c.layer * 3 * D)};
            gemm_phase<EpiGates, PanelOrder, false, true>(c.lds, c.tid, D, D, S, E); SEAM(); }
#if 1
        if (PHS(7) && IN(pb + 7)) RP(7) {
            const Ctx c = fresh(c0);
            MergeOrder S{(const char*)(c.ws + S_BR), (const char*)(c.ws + W_BR), c.G, c.bid, -1};
            EpiMerge E{(bf16_t*)(c.ws + S_MG), (const unsigned char*)(c.ws + S_H7), (unsigned char*)(c.ws + S_KV + 64 * MiB)};
            gemm_phase<EpiMerge, MergeOrder, false, true>(c.lds, c.tid, 512, 3072, S, E, MX_WG); SEAM(); }
#else
        for (int i = 0; i < 3; ++i) if (PHS(7) && IN(pb + 7 + i)) {
            const Ctx c = fresh(c0);
            MergeOrder S{(const char*)(c.ws + S_BR), (const char*)(c.ws + W_BR), c.G, c.bid, i};
            EpiMerge E{(bf16_t*)(c.ws + S_MG), (const unsigned char*)(c.ws + S_H7), (unsigned char*)(c.ws + S_KV + 64 * MiB)};
            gemm_phase<EpiMerge, MergeOrder, false, true>(c.lds, c.tid, 512, 3072, S, E, MX_WG); if (i == 2) SEAM(); }
#endif
        if (PHS(10) && IN(pb + 10)) RP(10) {
            const Ctx c = fresh(c0);
            PanelOrder S{(const char*)(c.ws + S_KV + 64 * MiB), (const char*)(c.ws + W_OUT), 4, c.G, c.bid, (size_t)256 * D, (size_t)256 * D};
            EpiResB E{rep_ > 0 ? (bf16_t*)(c.ws + S_Y) : (bf16_t*)(c.ws + S_PRE), (const bf16_t*)(c.ws + WS_XB), ALPHA};
            gemm_phase<EpiResB, PanelOrder, false, true>(c.lds, c.tid, D, D, S, E); SEAM(); }
        if (PHS(11) && IN(pb + 11)) RP(11) { const Ctx c = fresh(c0); phase_ln1(c, rep_ > 0); SEAM(); }
        if (PHS(12) && IN(pb + 12)) RP(12) {
            const Ctx c = fresh(c0);
            PanelOrder S{(const char*)(c.ws + WS_XB), (const char*)(c.ws + W_SHUP), 3, c.G, c.bid, (size_t)256 * D * 2, (size_t)256 * D * 2};
            EpiGLU E{(unsigned char*)(c.ws + S_HS), (float*)(c.ws + S_LG), false};
            gemm_phase<EpiGLU, PanelOrder, false>(c.lds, c.tid, D, D * 2, S, E); SEAM(); }
        if (PHS(14) && IN(pb + 13)) RP(14) {
            const Ctx c = fresh(c0);
            PanelOrder S{(const char*)(c.ws + S_HS), (const char*)(c.ws + W_SHDN), 4, c.G, c.bid, (size_t)256 * DEXP, (size_t)256 * DEXP};
            EpiExpDown E{(unsigned char*)(c.ws + S_SF)};
            gemm_phase<EpiExpDown, PanelOrder, false, true>(c.lds, c.tid, DEXP, DEXP, S, E); }
        if (PHS(13) && IN(pb + 14)) RP(13) { const Ctx c = fresh(c0); phase_route(c); SEAM(); }
        for (int s = 0; s < NSUB; ++s) {
            if (PHS(15) && IN(pb + 15 + 3 * s)) RP(15) { const Ctx c = fresh(c0); moe_tables(c, c.layer, s, mcnt, mtp);
                const unsigned* list = (const unsigned*)(c.ws + S_LIST) + (size_t)s * NEXP * TSUB;
                MoeOrder S{(const char*)(c.ws + WS_XB8), (const char*)(c.ws + W_E13), 2, c.G, c.bid, (size_t)512 * D, (size_t)256 * D, 0, mtp, mcnt, list, true, c.lane};
                EpiGLU E{(unsigned char*)(c.ws + S_HE), nullptr, true};
                gemm_phase<EpiGLU, MoeOrder, true, true>(c.lds, c.tid, D, D, S, E); SEAM(); }
            if (PHS(16) && IN(pb + 16 + 3 * s)) RP(16) { const Ctx c = fresh(c0); moe_tables(c, c.layer, s, mcnt, mtp);
                const unsigned* list = (const unsigned*)(c.ws + S_LIST) + (size_t)s * NEXP * TSUB;
                MoeOrder S{(const char*)(c.ws + S_HE), (const char*)(c.ws + W_E2), 4, c.G, c.bid, (size_t)D * DEXP, (size_t)256 * DEXP, (size_t)256 * DEXP, mtp, mcnt, list, false, c.lane};
                EpiExpDown E{(unsigned char*)(c.ws + S_Y)};
                gemm_phase<EpiExpDown, MoeOrder, false, true>(c.lds, c.tid, DEXP, DEXP, S, E); SEAM(); }
            if (PHS(17) && IN(pb + 17 + 3 * s)) RP(17) { const Ctx c = fresh(c0); moe_tables(c, c.layer, s, mcnt, mtp); phase_combine(c, s, mtp, c.layer == DEPTH - 1, rep_ > 0); }
        }
    }
#undef IN
#ifdef X7
    asm volatile("s_waitcnt vmcnt(0)" ::: "memory"); __syncthreads(); __builtin_amdgcn_fence(__ATOMIC_RELEASE, "agent"); asm volatile("s_waitcnt vmcnt(0)" ::: "memory");
#endif
}

extern "C" void kernel_launch(void* const* d_in, const int* in_sizes, int n_in, void* d_out, int out_size, void* d_ws, size_t ws_size, hipStream_t stream) {
    static int grid = 0;
    if (grid == 0) {
        if (n_in != 27 || ws_size < WS_END) { fprintf(stderr, "kernel_launch: n_in %d ws %zu (need %zu)\n", n_in, ws_size, (size_t)WS_END); grid = -1; return; }
        if (hipFuncSetAttribute((const void*)mk_fwd, hipFuncAttributeMaxDynamicSharedMemorySize, LDS_BYTES) != hipSuccess) { fprintf(stderr, "kernel_launch: hipFuncSetAttribute failed\n"); grid = -1; return; }
        int dev = 0, cus = 0, per_cu = 0;
        hipGetDevice(&dev); hipDeviceGetAttribute(&cus, hipDeviceAttributeMultiprocessorCount, dev);
        hipOccupancyMaxActiveBlocksPerMultiprocessor(&per_cu, (const void*)mk_fwd, 512, LDS_BYTES);
        (void)hipGetLastError();
        grid = cus > 0 ? cus : 256; if (grid > 256) grid = 256;
        fprintf(stderr, "kernel_launch: grid %d (occupancy query %d per CU)\n", grid, per_cu);
    }
    if (grid < 0) return;
    hipMemsetAsync((char*)d_ws + WS_CTL, 0, 1 * MiB, stream);
    Args a{};
    for (int i = 0; i < 27; ++i) a.in[i] = d_in[i];
    a.out = (float*)d_out; a.ws = (unsigned char*)d_ws;
#if MK_ONE_LAUNCH
#ifndef MAXPH
#define MAXPH (DEPTH * NPH)
#endif
    a.ph_lo = 0; a.ph_hi = MAXPH;
    hipLaunchKernelGGL(mk_fwd, dim3(grid), dim3(512), LDS_BYTES, stream, a);
#else
#ifndef MAXPH
#define MAXPH (DEPTH * NPH)
#endif
    for (int ph = 0; ph < MAXPH; ++ph) { a.ph_lo = ph; a.ph_hi = ph + 1; hipLaunchKernelGGL(mk_fwd, dim3(grid), dim3(512), LDS_BYTES, stream, a); }
#endif
}
```

```cpp
#include <hip/hip_runtime.h>
#include <cstdio>
#include <cstdint>

#ifndef MK_ONE_LAUNCH
#define MK_ONE_LAUNCH 1
#endif
#ifndef SIMPLE_GEMM
#define SIMPLE_GEMM 0
#endif

#define LAS __attribute__((address_space(3)))
#define GAS __attribute__((address_space(1)))
typedef unsigned short bf16_t;
typedef short bf16x8 __attribute__((ext_vector_type(8)));
typedef unsigned short u16x4 __attribute__((ext_vector_type(4)));
typedef float f32x4 __attribute__((ext_vector_type(4)));
typedef float f32x2 __attribute__((ext_vector_type(2)));
typedef unsigned u32x4 __attribute__((ext_vector_type(4)));
typedef unsigned u32x2 __attribute__((ext_vector_type(2)));
typedef LAS unsigned char lds_t;

constexpr int T = 65536, D = 1024, SEQ = 4096, NBATCH = 16, DEPTH = 4;
constexpr int NPANEL = 256;
constexpr int HW = 3584;
constexpr int INW = 6656;
constexpr int NEXP = 64, DEXP = 256;
constexpr int NSUB = 1, TSUB = T / NSUB, PSUB = NPANEL / NSUB;
constexpr int ROWS_MAX = TSUB * 8 + NEXP * 256;
constexpr float ALPHA = 1.681792830507429f;
constexpr float LN_EPS = 1e-5f, GN_EPS = 1e-6f;

constexpr size_t MiB = 1u << 20;
constexpr size_t WS_CTL = 0;
constexpr size_t WS_COS = 1 * MiB, WS_SIN = 2 * MiB;
constexpr size_t WS_W = 3 * MiB;
constexpr size_t W_IN = WS_W, W_BR = WS_W + 7 * MiB, W_OUT = WS_W + 10 * MiB, W_SM = WS_W + 12 * MiB;
constexpr size_t W_SHUP = WS_W + 13 * MiB, W_SHDN = W_SHUP + 3 * MiB / 2, W_E13 = WS_W + 15 * MiB, W_E2 = WS_W + 47 * MiB;
constexpr size_t WS_XB = 82 * MiB;
constexpr size_t WS_XB8 = 210 * MiB;
constexpr size_t WS_S = 274 * MiB;
constexpr size_t S_H7 = WS_S, S_KV = WS_S + 448 * MiB, S_BR = WS_S + 576 * MiB, S_MG = WS_S + 768 * MiB, S_RGC = WS_S + 896 * MiB;
constexpr size_t S_LA = S_MG, S_BB = S_MG + 64 * MiB;
constexpr size_t S_PE = WS_S, S_GW = WS_S + 2 * MiB, S_LIST = WS_S + 4 * MiB, S_SF = WS_S + 20 * MiB;
constexpr size_t S_HE = WS_S + 84 * MiB, S_Y = WS_S + 348 * MiB;
constexpr size_t S_HS = S_HE, S_LG = S_HE + 32 * MiB;
constexpr size_t S_PRE = S_H7;
constexpr size_t WS_END = WS_S + 899 * MiB;
static_assert(S_HE + (size_t)ROWS_MAX * 512 <= S_Y && S_Y + (size_t)ROWS_MAX * 1024 <= WS_END && S_SF + (size_t)T * D <= S_HE, "moe scratch");
constexpr int CW_BAR = 4096;
constexpr int CW_CNT = 16384;

constexpr int LDS_STAGE = 131072;
constexpr int LDS_MISC = 143360;
constexpr int LDS_IDX = 143360 + 1536;
constexpr int LDS_EPI = 147456;
constexpr int LDS_BYTES = 163840;

__device__ __forceinline__ unsigned f2bf(float f) { unsigned u = __builtin_bit_cast(unsigned, f); return (u + 0x7fffu + ((u >> 16) & 1u)) >> 16; }
typedef __bf16 bf16x2_t __attribute__((ext_vector_type(2)));
__device__ __forceinline__ unsigned pk2(float lo, float hi) { const bf16x2_t v = __builtin_convertvector((f32x2){lo, hi}, bf16x2_t); return __builtin_bit_cast(unsigned, v); }
__device__ __forceinline__ float bf2f(unsigned short b) { return __builtin_bit_cast(float, (unsigned)b << 16); }
__device__ __forceinline__ float bflo(unsigned w) { return __builtin_bit_cast(float, w << 16); }
__device__ __forceinline__ float bfhi(unsigned w) { return __builtin_bit_cast(float, w & 0xffff0000u); }
__device__ __forceinline__ float sigmoidf_(float x) { return __builtin_amdgcn_rcpf(1.0f + __expf(-x)); }
__device__ __forceinline__ float siluf_(float x) { return x * __builtin_amdgcn_rcpf(1.0f + __expf(-x)); }
__device__ __forceinline__ float gelu_tanh(float x) { const float u = 0.7978845608028654f * (x + 0.044715f * x * x * x); return x * __builtin_amdgcn_rcpf(1.0f + __expf(-2.0f * u)); }
__device__ __forceinline__ float wave_sum(float v) {
#pragma unroll
    for (int o = 1; o < 64; o <<= 1) v += __shfl_xor(v, o);
    return v;
}
#define LDS_WAIT() asm volatile("s_waitcnt lgkmcnt(0)" ::: "memory")
#define VM_WAIT() asm volatile("s_waitcnt vmcnt(0)" ::: "memory")

typedef int i32x8 __attribute__((ext_vector_type(8)));
typedef int i32x4 __attribute__((ext_vector_type(4)));
constexpr float W8_SCALE = 32.0f;
constexpr int MX_ONE = 0x7f7f7f7f, MX_W = 0x7a7a7a7a, MX_WG = 0x72727272;
__device__ __forceinline__ unsigned pk4_fp8s(float a, float b, float c2, float d, float s) { int w = 0; w = __builtin_amdgcn_cvt_pk_fp8_f32(a * s, b * s, w, false); w = __builtin_amdgcn_cvt_pk_fp8_f32(c2 * s, d * s, w, true); return (unsigned)w; }
__device__ __forceinline__ f32x4 mfma16(bf16x8 a, bf16x8 b, f32x4 c) { return __builtin_amdgcn_mfma_f32_16x16x32_bf16(a, b, c, 0, 0, 0); }
__device__ __forceinline__ bf16x8 frag_row(const lds_t* X, int pitchB, int r0, int k0, int fr, int fq) {
    return *(const LAS bf16x8*)(X + (r0 + fr) * pitchB + (k0 + 8 * fq) * 2);
}
__device__ __forceinline__ bf16x8 frag_col(const lds_t* X, int pitchB, int k0, int c0, int fr, int fq) {
    const int q = fr >> 2, p = fr & 3;
    const unsigned a0 = (unsigned)(size_t)X + (unsigned)((k0 + 8 * fq + q) * pitchB + (c0 + 4 * p) * 2);
    u16x4 lo, hi;
    asm volatile("ds_read_b64_tr_b16 %0, %2\n\tds_read_b64_tr_b16 %1, %3\n\ts_waitcnt lgkmcnt(0)" : "=&v"(lo), "=&v"(hi) : "v"(a0), "v"(a0 + 4u * (unsigned)pitchB) : "memory");
    bf16x8 r; r[0] = (short)lo[0]; r[1] = (short)lo[1]; r[2] = (short)lo[2]; r[3] = (short)lo[3]; r[4] = (short)hi[0]; r[5] = (short)hi[1]; r[6] = (short)hi[2]; r[7] = (short)hi[3];
    return r;
}

#define XB_TMO      128
#define XB_XCNT(j)  (256  + 64 * (j))
#define XB_XSUB(j)  (1280 + 64 * (j))
#define XB_XGEN(j)  (2304 + 64 * (j))
#define XB_TOP      3328
#define XB_TOPGEN   3392
#define XCD_BAR_WORDS 3456
#define XB_SPIN_CAP (1u << 20)
__device__ __forceinline__ unsigned xb_ld(unsigned* p)              { return __hip_atomic_load(p, __ATOMIC_RELAXED, __HIP_MEMORY_SCOPE_AGENT); }
__device__ __forceinline__ unsigned xb_add(unsigned* p, unsigned v) { return __hip_atomic_fetch_add(p, v, __ATOMIC_RELAXED, __HIP_MEMORY_SCOPE_AGENT); }
__device__ __forceinline__ unsigned xb_xcc_id() { return (unsigned)__builtin_amdgcn_s_getreg((3 << 11) | 20) & 0xFu; }
#define XB_SPIN(cond, bar) do { unsigned _sp = 0; while (cond) { __builtin_amdgcn_s_sleep(1); \
    if ((++_sp & 255u) == 0u) { if (xb_ld(&(bar)[XB_TMO])) break; if (_sp > XB_SPIN_CAP) { atomicAdd(&(bar)[XB_TMO], 1u); break; } } } } while (0)
struct XcdBarrier { unsigned* bar; unsigned x; volatile LAS unsigned* st; };
__device__ __forceinline__ XcdBarrier xcd_barrier_post(unsigned* bar, volatile LAS unsigned* st) {
    XcdBarrier b; b.bar = bar; b.x = xb_xcc_id(); b.st = st;
    if (threadIdx.x == 0) (void)xb_add(&bar[XB_XCNT(b.x)], 1u);
    return b;
}
__device__ __forceinline__ void xcd_barrier_complete(unsigned* bar, unsigned x, unsigned& nloc, unsigned& nx) {
    const unsigned G = gridDim.x * gridDim.y * gridDim.z;
    unsigned sum, cnt, mine, sp = 0u;
    for (;;) {
        sum = 0u; cnt = 0u; mine = 0u;
#pragma unroll
        for (unsigned j = 0; j < 16; ++j) { const unsigned c = xb_ld(&bar[XB_XCNT(j)]); sum += c; cnt += (c > 0u) ? 1u : 0u; mine = (j == x) ? c : mine; }
        if (sum == G) break;
        __builtin_amdgcn_s_sleep(1);
        if ((++sp & 255u) == 0u) { if (xb_ld(&bar[XB_TMO])) break; if (sp > XB_SPIN_CAP) { atomicAdd(&bar[XB_TMO], 1u); break; } }
    }
    nloc = mine > 0u ? mine : 1u; nx = cnt > 0u ? cnt : 1u;
}
__device__ __forceinline__ void xcd_barrier(const XcdBarrier& b) {
    asm volatile("s_waitcnt vmcnt(0)" ::: "memory");
    __syncthreads();
    if (threadIdx.x == 0) {
        unsigned* bar = b.bar;
        __builtin_amdgcn_s_waitcnt(0);
        unsigned nloc = b.st[0], nx = b.st[1];
        if (nloc == 0u) { xcd_barrier_complete(bar, b.x, nloc, nx); b.st[0] = nloc; b.st[1] = nx; }
        const unsigned old = xb_add(&bar[XB_XSUB(b.x)], 1u);
        const unsigned gen = old / nloc;
        if (old + 1u == (gen + 1u) * nloc) {
            __builtin_amdgcn_fence(__ATOMIC_RELEASE, "agent");
            asm volatile("s_waitcnt vmcnt(0)" ::: "memory");
            const unsigned og = xb_add(&bar[XB_TOP], 1u);
            const unsigned tg = og / nx;
            if (og + 1u == (tg + 1u) * nx) xb_add(&bar[XB_TOPGEN], 1u);
            else XB_SPIN(xb_ld(&bar[XB_TOPGEN]) == tg, bar);
            __builtin_amdgcn_fence(__ATOMIC_ACQUIRE, "agent");
            xb_add(&bar[XB_XGEN(b.x)], 1u);
            asm volatile("s_waitcnt vmcnt(0)" ::: "memory");
        } else {
            XB_SPIN(xb_ld(&bar[XB_XGEN(b.x)]) == gen, bar);
            __builtin_amdgcn_fence(__ATOMIC_ACQUIRE, "agent");
            asm volatile("s_waitcnt vmcnt(0)" ::: "memory");
        }
    }
    __syncthreads();
}

struct GUnit { const char* A; const char* B; int x, y, z, w; };

constexpr int BK = 64, HALF = 128, HTB = HALF * BK * 2;
__host__ __device__ __forceinline__ int lds_byte(int r, int c) { const int st = (r >> 4) * 2 + (c >> 5), rr = r & 15, cc = c & 31, ob = rr * 64 + cc * 2; return st * 1024 + (ob ^ (((ob >> 9) & 1) << 5)); }
__host__ __device__ __forceinline__ int perm32(int rho) { const int n = rho >> 4, i = rho & 15; return 8 * (i >> 2) + 4 * n + (i & 3); }
__host__ __device__ __forceinline__ void stage_rc(int b, int& R, int& C) { const int st = b / 1024, sb = b % 1024, swz = sb ^ (((sb >> 9) & 1) << 5); R = (st >> 1) * 16 + swz / 64; C = (st & 1) * 32 + (swz % 64) / 2; }

#if SIMPLE_GEMM
template <class Epi, class Sched, bool GATHER, bool F8 = false>
__device__ __forceinline__ void gemm_phase(lds_t* lds, const int tid, const int K, const unsigned ldaB, const Sched& S, const Epi& E) {
    const int wid = __builtin_amdgcn_readfirstlane(tid >> 6), lane = tid & 63, wr = wid >> 2, wc = wid & 3, fr = lane & 15, fq = lane >> 4;
    GUnit cur;
    for (int ui = 0; S.next(ui, cur); ++ui) {
        f32x4 acc[2][2][4][2];
#pragma unroll
        for (int a = 0; a < 2; ++a)
#pragma unroll
            for (int b = 0; b < 2; ++b)
#pragma unroll
                for (int m = 0; m < 4; ++m)
#pragma unroll
                    for (int n = 0; n < 2; ++n) acc[a][b][m][n] = (f32x4){0.f, 0.f, 0.f, 0.f};
        unsigned ao[2][4], bo[2][2];
#pragma unroll
        for (int ai = 0; ai < 2; ++ai)
#pragma unroll
            for (int m = 0; m < 4; ++m) { const int r = ai * HALF + wr * 64 + m * 16 + fr; const unsigned ro = GATHER ? (unsigned)S.gather_row(cur, r) : (unsigned)r; ao[ai][m] = ro * ldaB + fq * 16; }
#pragma unroll
        for (int bj = 0; bj < 2; ++bj)
#pragma unroll
            for (int n = 0; n < 2; ++n) { const int r = bj * HALF + wc * 32 + n * 16 + fr; bo[bj][n] = (unsigned)(r * K * 2 + fq * 16); }
#pragma unroll 1
        for (int k0 = 0; k0 < K; k0 += 32) {
            bf16x8 af[2][4], bfr[2][2];
#pragma unroll
            for (int ai = 0; ai < 2; ++ai)
#pragma unroll
                for (int m = 0; m < 4; ++m) af[ai][m] = *(const bf16x8*)(cur.A + ao[ai][m] + k0 * 2);
#pragma unroll
            for (int bj = 0; bj < 2; ++bj)
#pragma unroll
                for (int n = 0; n < 2; ++n) bfr[bj][n] = *(const bf16x8*)(cur.B + bo[bj][n] + k0 * 2);
#pragma unroll
            for (int ai = 0; ai < 2; ++ai)
#pragma unroll
                for (int bj = 0; bj < 2; ++bj)
#pragma unroll
                    for (int m = 0; m < 4; ++m)
#pragma unroll
                        for (int n = 0; n < 2; ++n) acc[ai][bj][m][n] = mfma16(bfr[bj][n], af[ai][m], acc[ai][bj][m][n]);
        }
        E(acc, cur, wr, wc, fr, fq);
    }
}
#else
template <class Epi, class Sched, bool GATHER, bool F8 = false>
__device__ __forceinline__ void gemm_phase(lds_t* lds, const int tid, const int K, const unsigned ldaB, const Sched& S, const Epi& E, const int mxw = MX_W) {
    const int wid = __builtin_amdgcn_readfirstlane(tid >> 6), lane = tid & 63, wr = wid >> 2, wc = wid & 3, fr = lane & 15, fq = lane >> 4;
    const int KB = F8 ? K : K * 2;
    const int nt = KB / 128;
    unsigned voffB[2], voffA[2][2];
#pragma unroll
    for (int i = 0; i < 2; ++i) { int sR, sC; stage_rc(tid * 16 + i * 8192, sR, sC); int Rb;
        if (Epi::PERM == 2) { const int rho = sR & 31; Rb = 64 * (sR >> 5) + 16 * ((rho & 15) >> 2) + 4 * (rho >> 4) + (rho & 3); }
        else Rb = (Epi::PERM == 1 ? ((sR & ~31) + perm32(sR & 31)) : sR);
        voffB[i] = (unsigned)(Rb * KB + sC * 2); }
    const size_t kstep = (size_t)(BK * 2);
    const size_t hstepB = (size_t)(Epi::PERM == 2 ? 8 : HALF) * KB;
    const size_t hstepA = (size_t)HALF * ldaB;
    const unsigned ldsw = (unsigned)wid * 1024u;
    const int aoff = lds_byte(wr * 64 + fr, fq * 8), boff = lds_byte(wc * 32 + fr, fq * 8);
    constexpr int koffA = 1024, koffB = 1024;
#define PG8_SA(b, h) (((b) * 2 + (h)) * HTB)
#define PG8_SB(b, h) ((4 + (b) * 2 + (h)) * HTB)
#define PG8_STAGE(bufoff, gbase, voff) do { _Pragma("unroll") for (int _i = 0; _i < 2; ++_i) { unsigned _v = (voff)[_i]; asm volatile("" : "+v"(_v));   \
        __builtin_amdgcn_global_load_lds((const unsigned*)((const char*)(gbase) + _v), (LAS unsigned*)(lds + (bufoff) + ldsw + _i * 8192), 16, 0, 0); } } while (0)
#define PG8_STAGEB(b, h, gbase) PG8_STAGE(PG8_SB(b, h), (gbase) + (h) * hstepB, voffB)
#define PG8_STAGEA(b, h, gbase, vo) do { if (GATHER) { PG8_STAGE(PG8_SA(b, h), gbase, (vo)[h]); } else { PG8_STAGE(PG8_SA(b, h), (gbase) + (h) * hstepA, voffA[0]); } } while (0)
#define PG8_STAGEA1(b, gbase) do { if (GATHER) { PG8_STAGE(PG8_SA(b, 1), gbase, va1); } else { PG8_STAGE(PG8_SA(b, 1), (gbase) + hstepA, voffA[0]); } } while (0)
#define PG8_RD16(off) (*(const LAS i32x4*)(lds + (off)))
#define PG8_LDA(dst, b, h) do { _Pragma("unroll") for (int m = 0; m < 4; ++m) { if (F8) { const i32x4 _l = PG8_RD16(PG8_SA(b, h) + aoff + m * 2048), _h = PG8_RD16(PG8_SA(b, h) + aoff + m * 2048 + koffA); dst##8[m] = __builtin_shufflevector(_l, _h, 0, 1, 2, 3, 4, 5, 6, 7); } \
        else { _Pragma("unroll") for (int k = 0; k < 2; ++k) dst[m][k] = *(const LAS bf16x8*)(lds + PG8_SA(b, h) + aoff + m * 2048 + k * 1024); } } } while (0)
#define PG8_LDB(dst, b, h) do { _Pragma("unroll") for (int n = 0; n < 2; ++n) { if (F8) { const i32x4 _l = PG8_RD16(PG8_SB(b, h) + boff + n * 2048), _h = PG8_RD16(PG8_SB(b, h) + boff + n * 2048 + koffB); dst##8[n] = __builtin_shufflevector(_l, _h, 0, 1, 2, 3, 4, 5, 6, 7); } \
        else { _Pragma("unroll") for (int k = 0; k < 2; ++k) dst[n][k] = *(const LAS bf16x8*)(lds + PG8_SB(b, h) + boff + n * 2048 + k * 1024); } } } while (0)
#define PG8_MMA(ai, bj, At, Bt) do { __builtin_amdgcn_s_setprio(1); _Pragma("unroll") for (int m = 0; m < 4; ++m) _Pragma("unroll") for (int n = 0; n < 2; ++n) { \
        if (F8) asm volatile("v_mfma_scale_f32_16x16x128_f8f6f4 %0, %1, %2, %0, %3, %4 op_sel_hi:[0,0,0]" : "+v"(acc[ai][bj][m][n]) : "v"(Bt##8[n]), "v"(At##8[m]), "v"(sc_w), "v"(sc_x)); \
        else { _Pragma("unroll") for (int k = 0; k < 2; ++k) acc[ai][bj][m][n] = __builtin_amdgcn_mfma_f32_16x16x32_bf16(Bt[n][k], At[m][k], acc[ai][bj][m][n], 0, 0, 0); } } \
        __builtin_amdgcn_s_setprio(0); } while (0)
#define PG8_WAIT_V(n) asm volatile("s_waitcnt vmcnt(" #n ")" ::: "memory")
#define PG8_WAIT_V8R do { if (Epi::NST > 0 && relax) asm volatile("s_waitcnt vmcnt(%0)" :: "n"(8 + Epi::NST) : "memory"); else PG8_WAIT_V(8); } while (0)
#define PG8_WAIT_L(n) asm volatile("s_waitcnt lgkmcnt(" #n ")" ::: "memory")
#define PG8_BAR __builtin_amdgcn_s_barrier()
#define PG8_SCHED __builtin_amdgcn_sched_barrier(0)
#define PG8_AOFFS(dst, U) do { int _tz = tid; asm volatile("" : "+v"(_tz)); _Pragma("unroll") for (int _h = 0; _h < 2; ++_h) _Pragma("unroll") for (int _i = 0; _i < 2; ++_i) { int _R, _C; stage_rc(_tz * 16 + _i * 8192, _R, _C); \
        const unsigned _row = GATHER ? (unsigned)S.gather_row(U, _h * HALF + _R) : (unsigned)(_h * HALF + _R); dst[_h][_i] = _row * ldaB + (unsigned)_C * 2u; } } while (0)
    GUnit cur, nxt; int ui = 0;
    if (!S.next(0, cur)) return;
    f32x4 acc[2][2][4][2];
#pragma unroll
    for (int a = 0; a < 2; ++a)
#pragma unroll
        for (int b = 0; b < 2; ++b)
#pragma unroll
            for (int m = 0; m < 4; ++m)
#pragma unroll
                for (int n = 0; n < 2; ++n) acc[a][b][m][n] = (f32x4){0.f, 0.f, 0.f, 0.f};
    int sc_w = mxw, sc_x = MX_ONE; asm volatile("" : "+v"(sc_w), "+v"(sc_x));
    bf16x8 At[4][2], B0[2][2], B1[2][2]; i32x8 At8[4], B08[2], B18[2];
    const char* cA = cur.A; const char* cB = cur.B;
    PG8_AOFFS(voffA, cur);
    PG8_STAGEB(0, 0, cB); PG8_STAGEB(0, 1, cB); PG8_STAGEA(0, 0, cA, voffA); PG8_STAGEA(0, 1, cA, voffA);
    if (wr == 1) PG8_BAR;
    PG8_WAIT_V(2); PG8_BAR;
    PG8_STAGEB(1, 0, cB + kstep); PG8_STAGEA(1, 0, cA + kstep, voffA); PG8_STAGEB(1, 1, cB + kstep);
    PG8_WAIT_V(6); PG8_BAR;
    for (;;) {
        const bool has_next = S.next(ui + 1, nxt);
        const char* nA = has_next ? nxt.A : cA; const char* nB = has_next ? nxt.B : cB;
        if (has_next && GATHER) {
            if (wid < 4) __builtin_amdgcn_global_load_lds(S.idx_ptr(nxt, (wid & 3) * 64 + lane), (LAS unsigned*)(lds + LDS_IDX + ((ui + 1) & 1) * 1024 + (wid & 3) * 256), 4, 0, 0);
        }
#pragma unroll 1
        for (int t = 0; t < nt; t += 2) {
            const bool last = (t == nt - 2);
            const bool relax = (t == 0) && (ui > 0);
            const char* a1 = cA + (size_t)(t + 1) * kstep;
            const char* a2 = last ? nA : cA + (size_t)(t + 2) * kstep; const char* b2 = last ? nB : cB + (size_t)(t + 2) * kstep;
            const char* a3 = a2 + kstep; const char* b3 = b2 + kstep;
            unsigned va1[2] = {voffA[1][0], voffA[1][1]};
            if (GATHER && last && has_next) {
                int _tz = tid; asm volatile("" : "+v"(_tz));
#pragma unroll
                for (int _h = 0; _h < 2; ++_h)
#pragma unroll
                    for (int _i = 0; _i < 2; ++_i) { int _R, _C; stage_rc(_tz * 16 + _i * 8192, _R, _C);
                        const unsigned _a = *(const LAS unsigned*)(lds + LDS_IDX + ((ui + 1) & 1) * 1024 + (_h * HALF + _R) * 4); voffA[_h][_i] = (_a >> 3) * ldaB + (unsigned)_C * 2u; } }
            PG8_LDB(B0, 0, 0); PG8_LDB(B1, 0, 1); PG8_SCHED; PG8_LDA(At, 0, 0); PG8_STAGEA1(1, a1);
            PG8_WAIT_V8R; PG8_WAIT_L(0); PG8_BAR; PG8_MMA(0, 0, At, B0); PG8_MMA(0, 1, At, B1); PG8_BAR; PG8_SCHED;
            PG8_LDA(At, 0, 1); PG8_STAGEB(0, 0, b2); PG8_STAGEB(0, 1, b2); PG8_STAGEA(0, 0, a2, voffA);
            PG8_WAIT_V8R; PG8_WAIT_L(0); PG8_BAR; PG8_MMA(1, 0, At, B0); PG8_MMA(1, 1, At, B1); PG8_BAR; PG8_SCHED;
            PG8_LDB(B0, 1, 0); PG8_LDB(B1, 1, 1); PG8_SCHED; PG8_LDA(At, 1, 0); PG8_STAGEA(0, 1, a2, voffA);
            PG8_WAIT_V(8); PG8_WAIT_L(0); PG8_BAR; PG8_MMA(0, 0, At, B0); PG8_MMA(0, 1, At, B1); PG8_BAR; PG8_SCHED;
            PG8_LDA(At, 1, 1); PG8_STAGEB(1, 0, b3); PG8_STAGEB(1, 1, b3); PG8_STAGEA(1, 0, a3, voffA);
            PG8_WAIT_V(8); PG8_WAIT_L(0); PG8_BAR; PG8_MMA(1, 0, At, B0); PG8_MMA(1, 1, At, B1); PG8_BAR; PG8_SCHED;
        }
        if (wr == 0) PG8_BAR;
        if (F8) asm volatile("s_nop 15\n\ts_nop 15" ::: "memory");
        E(acc, cur, wr, wc, fr, fq);
        if (!has_next) break;
#pragma unroll
        for (int a = 0; a < 2; ++a)
#pragma unroll
            for (int b = 0; b < 2; ++b)
#pragma unroll
                for (int m = 0; m < 4; ++m)
#pragma unroll
                    for (int n = 0; n < 2; ++n) acc[a][b][m][n] = (f32x4){0.f, 0.f, 0.f, 0.f};
        cur = nxt; cA = nA; cB = nB; ++ui;
        if (wr == 1) PG8_BAR;
    }
    PG8_WAIT_V(0);
    PG8_BAR;
#undef PG8_SA
#undef PG8_SB
#undef PG8_STAGE
#undef PG8_LDA
#undef PG8_STAGEB
#undef PG8_STAGEA
#undef PG8_LDB
#undef PG8_MMA
#undef PG8_WAIT_V
#undef PG8_WAIT_L
#undef PG8_BAR
#undef PG8_SCHED
#undef PG8_AOFFS
}
#endif

struct Args { const void* in[27]; float* out; unsigned char* ws; int ph_lo, ph_hi; };
struct Ctx {
    lds_t* lds; int tid, lane, wave; int G, bid, layer;
    unsigned char* ws; float* out;
};
enum { I_X = 0, I_POS = 1, I_WIN = 2, I_GATEB = 3, I_WBR = 4, I_WOUT = 5, I_POOLW = 6, I_POOLS = 7, I_CONVW = 8, I_CONVB = 9, I_WA = 10, I_BA = 11, I_WX = 12, I_BX = 13, I_LAM = 14,
       I_LN1G = 15, I_LN1B = 16, I_RW = 17, I_RB = 18, I_EW1 = 19, I_EW3 = 20, I_EW2 = 21, I_SW1 = 22, I_SW3 = 23, I_SW2 = 24, I_LN2G = 25, I_LN2B = 26 };
constexpr int LDS_PTAB = 143360 + 1024;
__device__ __forceinline__ const float* inp(const Ctx& c, int idx, size_t off) {
    const unsigned long long v = ((const LAS unsigned long long*)(c.lds + LDS_PTAB))[idx];
    const unsigned lo = __builtin_amdgcn_readfirstlane((unsigned)v), hi = __builtin_amdgcn_readfirstlane((unsigned)(v >> 32));
    return (const float*)(const GAS float*)(((unsigned long long)hi << 32) | lo) + off;
}
__device__ __forceinline__ Ctx fresh(const Ctx& c0) {
    Ctx c = c0; int t = c0.tid; asm volatile("" : "+v"(t));
    int g = c0.G, b = c0.bid, l = c0.layer; asm volatile("" : "+s"(g), "+s"(b), "+s"(l));
    unsigned long long w = (unsigned long long)c0.ws, o = (unsigned long long)c0.out; unsigned ld = (unsigned)(size_t)c0.lds; asm volatile("" : "+s"(w), "+s"(o), "+s"(ld));
    c.tid = t; c.lane = t & 63; c.wave = __builtin_amdgcn_readfirstlane(t >> 6); c.G = g; c.bid = b; c.layer = l;
    c.ws = (unsigned char*)(GAS unsigned char*)w; c.out = (float*)(GAS float*)o; c.lds = (lds_t*)ld; return c;
}

struct PanelOrder {
    const char* A; const char* B; int NT, G, bid; size_t a_panel_bytes, b_tile_bytes;
    __device__ __forceinline__ bool next(int i, GUnit& u) const {
        const int L = i * G + bid; if (L >= NPANEL * NT) return false;
        const int wgid = (L & 7) * (NPANEL / 8 * NT) + (L >> 3); const int nig = 8 * NT, gid = wgid / nig, rem = wgid - gid * nig;
        const int p = gid * 8 + (rem & 7), pn = rem >> 3;
        u.A = A + (size_t)p * a_panel_bytes; u.B = B + (size_t)pn * b_tile_bytes; u.x = p; u.y = pn; u.z = 0; u.w = 0; return true;
    }
    __device__ __forceinline__ int gather_row(const GUnit&, int r) const { return r; }
    __device__ __forceinline__ const unsigned* idx_ptr(const GUnit&, int) const { return nullptr; }
};
struct OwnOrder {
    const char* A; const char* B; int NT, G, bid; size_t a_panel_bytes, a_tile_bytes, b_tile_bytes; int a_pair;
    __device__ __forceinline__ bool next(int i, GUnit& u) const {
        const int pi = i / NT, pn = i - pi * NT; const int p = bid + pi * G; if (p >= NPANEL) return false;
        u.A = A + (size_t)p * a_panel_bytes + (size_t)(a_pair ? (pn >> 1) : pn) * a_tile_bytes; u.B = B + (size_t)pn * b_tile_bytes; u.x = p; u.y = pn; u.z = 0; u.w = 0; return true;
    }
    __device__ __forceinline__ int gather_row(const GUnit&, int r) const { return r; }
    __device__ __forceinline__ const unsigned* idx_ptr(const GUnit&, int) const { return nullptr; }
};
struct MergeOrder {
    const char* A; const char* B; int G, bid, fixed_pass;
    __device__ __forceinline__ bool next(int i, GUnit& u) const {
        const int it = fixed_pass < 0 ? i / 3 : i, pass = fixed_pass < 0 ? i - it * 3 : fixed_pass; const int L = it * G + bid; if (L >= NPANEL * 4) return false;
        const int wgid = (L & 7) * (NPANEL / 8 * 4) + (L >> 3); const int gid = wgid >> 5, rem = wgid & 31; const int p = gid * 8 + (rem & 7), pn = rem >> 3;
        u.A = A + (size_t)p * (256 * 3072) + (pass == 0 ? 0 : (pass == 1 ? 1024 : 1536)); u.B = B + (size_t)pass * (D * 512) + (size_t)pn * (256 * 512); u.x = p; u.y = pn; u.z = pass; u.w = 0; return true;
    }
    __device__ __forceinline__ int gather_row(const GUnit&, int r) const { return r; }
    __device__ __forceinline__ const unsigned* idx_ptr(const GUnit&, int) const { return nullptr; }
};
struct MoeOrder {
    const char* A; const char* B; int NT, G, bid; size_t b_exp_bytes, b_tile_bytes, a_tile_bytes; const LAS int* tp; const LAS int* cnt; const unsigned* list; bool gather; int lane;
    __device__ __forceinline__ bool next(int i, GUnit& u) const {
#if 1
        const int lu = (bid >> 3) + (G >> 3) * i; const int tq = lu / NT, pn = lu - tq * NT; const int ti = tq * 8 + (bid & 7); const int ntile = tp[64]; if (ti >= ntile) return false;
#else
        const int g = bid + i * G; const int ti = g / NT, pn = g - ti * NT; const int ntile = tp[64]; if (ti >= ntile) return false;
#endif
        const unsigned long long m = __ballot(tp[lane + 1] > ti);
        const int e = __builtin_amdgcn_readfirstlane((int)__builtin_ctzll(m));
        const int tl = ti - tp[e];
        u.A = gather ? A : A + (size_t)ti * a_tile_bytes; u.B = B + (size_t)e * b_exp_bytes + (size_t)pn * b_tile_bytes; u.x = ti; u.y = pn; u.z = e; u.w = tl; return true;
    }
    __device__ __forceinline__ const unsigned* idx_ptr(const GUnit& u, int r) const { const int c = cnt[u.z]; int j = u.w * 256 + r; j = j < c ? j : c - 1; return list + (size_t)u.z * TSUB + j; }
    __device__ __forceinline__ int gather_row(const GUnit& u, int r) const {
        const int c = cnt[u.z]; int j = u.w * 256 + r; j = j < c ? j : c - 1;
#ifdef X6
        return r;
#endif
        return (int)(list[(size_t)u.z * TSUB + j] >> 3);
    }
};

__device__ __forceinline__ void stage_store16(lds_t* lw, unsigned char* gbase, size_t pitchB, int lane, u32x4 lo, u32x4 hi) {
    const int fr = lane & 15, fq = lane >> 4;
    *(LAS u32x4*)(lw + fr * 128 + fq * 32) = lo; *(LAS u32x4*)(lw + fr * 128 + fq * 32 + 16) = hi;
    const u32x4 a = *(const LAS u32x4*)(lw + (lane >> 3) * 128 + (lane & 7) * 16), b = *(const LAS u32x4*)(lw + (8 + (lane >> 3)) * 128 + (lane & 7) * 16);
    __builtin_nontemporal_store(a, (u32x4*)(gbase + (size_t)(lane >> 3) * pitchB + (lane & 7) * 16)); __builtin_nontemporal_store(b, (u32x4*)(gbase + (size_t)(8 + (lane >> 3)) * pitchB + (lane & 7) * 16));
}
struct EpiIn {
    static constexpr int PERM = 2; static constexpr int NST = 16;
    bf16_t* H; const unsigned* csT; lds_t* lepi;
    __device__ __forceinline__ void operator()(const f32x4 (&acc)[2][2][4][2], const GUnit& u, int wr, int wc, int fr, int fq) const {
        const int seg = u.y >> 1; const int lane = fr + 16 * fq; lds_t* lw = lepi + (wr * 4 + wc) * 2048;
        const int i0 = 32 * (wc & 1) + 8 * fq;
        u32x4 t0 = (u32x4){0u, 0u, 0u, 0u}, t1 = t0;
        if (seg < 2) { const int s0_ = (u.x * 256 + wr * 64 + fr) & (SEQ - 1); t0 = *(const u32x4*)(csT + s0_ * 64 + i0); t1 = *(const u32x4*)(csT + s0_ * 64 + i0 + 4); }
#pragma unroll
        for (int idx = 0; idx < 8; ++idx) { const int ai = idx >> 2, m = idx & 3;
                const int rg = u.x * 256 + ai * HALF + wr * 64 + m * 16;
                u32x4 t0n = t0, t1n = t1;
                if (seg < 2 && idx < 7) { const int sn = (u.x * 256 + ((idx + 1) >> 2) * HALF + wr * 64 + ((idx + 1) & 3) * 16 + fr) & (SEQ - 1); t0n = *(const u32x4*)(csT + sn * 64 + i0); t1n = *(const u32x4*)(csT + sn * 64 + i0 + 4); }
                f32x4 v0 = acc[ai][0][m][0], v1 = acc[ai][0][m][1], v2 = acc[ai][1][m][0], v3 = acc[ai][1][m][1];
#define ROPE4(X, CA, SA, CB, SB) (f32x4){((X)[0] * (CA) - (X)[1] * (SA)) * sc, ((X)[0] * (SA) + (X)[1] * (CA)) * sc, ((X)[2] * (CB) - (X)[3] * (SB)) * sc, ((X)[2] * (SB) + (X)[3] * (CB)) * sc}
#define MAP4(F, X) (f32x4){F((X)[0]), F((X)[1]), F((X)[2]), F((X)[3])}
                if (seg < 2) { const float sc = seg == 1 ? 0.08838834764831845f : 1.0f;
                    v0 = ROPE4(v0, bflo(t0.x), bfhi(t0.x), bflo(t0.y), bfhi(t0.y)); v1 = ROPE4(v1, bflo(t0.z), bfhi(t0.z), bflo(t0.w), bfhi(t0.w)); v2 = ROPE4(v2, bflo(t1.x), bfhi(t1.x), bflo(t1.y), bfhi(t1.y)); v3 = ROPE4(v3, bflo(t1.z), bfhi(t1.z), bflo(t1.w), bfhi(t1.w));
                } else if (seg == 3) { v0 = MAP4(siluf_, v0); v1 = MAP4(siluf_, v1); v2 = MAP4(siluf_, v2); v3 = MAP4(siluf_, v3); }
                else if (seg == 6) { v0 = MAP4(gelu_tanh, v0); v1 = MAP4(gelu_tanh, v1); v2 = MAP4(gelu_tanh, v2); v3 = MAP4(gelu_tanh, v3); }
#undef ROPE4
#undef MAP4
                u32x4 lo, hi; lo.x = pk2(v0[0], v0[1]); lo.y = pk2(v0[2], v0[3]); lo.z = pk2(v1[0], v1[1]); lo.w = pk2(v1[2], v1[3]); hi.x = pk2(v2[0], v2[1]); hi.y = pk2(v2[2], v2[3]); hi.z = pk2(v3[0], v3[1]); hi.w = pk2(v3[2], v3[3]);
                stage_store16(lw, (unsigned char*)(H + (size_t)rg * HW + u.y * 256 + wc * 64), (size_t)HW * 2, lane, lo, hi);
                t0 = t0n; t1 = t1n;
            }
    }
};
__device__ __forceinline__ float ub0(unsigned w) { return (float)(w & 0xffu); }
__device__ __forceinline__ float ub1(unsigned w) { return (float)((w >> 8) & 0xffu); }
__device__ __forceinline__ float ub2(unsigned w) { return (float)((w >> 16) & 0xffu); }
__device__ __forceinline__ float ub3(unsigned w) { return (float)(w >> 24); }
constexpr int GBP = 3 * D;
__device__ __forceinline__ unsigned pk4_u8(float a, float b, float c, float d) { unsigned w = 0; w = __builtin_amdgcn_cvt_pk_u8_f32(a * 255.0f, 0, w); w = __builtin_amdgcn_cvt_pk_u8_f32(b * 255.0f, 1, w); w = __builtin_amdgcn_cvt_pk_u8_f32(c * 255.0f, 2, w); w = __builtin_amdgcn_cvt_pk_u8_f32(d * 255.0f, 3, w); return w; }
struct EpiGates {
    static constexpr int PERM = 2; static constexpr int NST = 8;
    unsigned char* GB; const float* gb;
    __device__ __forceinline__ void operator()(const f32x4 (&acc)[2][2][4][2], const GUnit& u, int wr, int wc, int fr, int fq) const {
        const int colt = u.y * 256 + wc * 64 + 16 * fq;
        f32x4 bv[4];
#pragma unroll
        for (int q = 0; q < 4; ++q) bv[q] = *(const f32x4*)(gb + colt + 4 * q);
#pragma unroll
        for (int ai = 0; ai < 2; ++ai)
#pragma unroll
            for (int m = 0; m < 4; ++m) { const int row = u.x * 256 + ai * HALF + wr * 64 + m * 16 + fr;
                const f32x4 v0 = acc[ai][0][m][0] + bv[0], v1 = acc[ai][0][m][1] + bv[1], v2 = acc[ai][1][m][0] + bv[2], v3 = acc[ai][1][m][1] + bv[3];
                u32x4 w; w.x = pk4_u8(sigmoidf_(v0[0]), sigmoidf_(v0[1]), sigmoidf_(v0[2]), sigmoidf_(v0[3])); w.y = pk4_u8(sigmoidf_(v1[0]), sigmoidf_(v1[1]), sigmoidf_(v1[2]), sigmoidf_(v1[3]));
                w.z = pk4_u8(sigmoidf_(v2[0]), sigmoidf_(v2[1]), sigmoidf_(v2[2]), sigmoidf_(v2[3])); w.w = pk4_u8(sigmoidf_(v3[0]), sigmoidf_(v3[1]), sigmoidf_(v3[2]), sigmoidf_(v3[3]));
                __builtin_nontemporal_store(w, (u32x4*)(GB + (size_t)row * GBP + colt)); }
    }
};
struct EpiMerge {
    static constexpr int PERM = 2; static constexpr int NST = 16;
    bf16_t* MG; const unsigned char* GB; unsigned char* MG8;
    template <int PASS>
    __device__ __forceinline__ void run(const f32x4 (&acc)[2][2][4][2], const GUnit& u, int wr, int wc, int fr, int fq) const {
        const int row0 = u.x * 256 + wr * 64 + fr; const int colt = u.y * 256 + wc * 64 + 16 * fq;
        u32x4 g = *(const u32x4*)(GB + (size_t)row0 * GBP + PASS * D + colt), o0 = (u32x4){0u, 0u, 0u, 0u}, o1 = o0;
        if (PASS > 0) { const bf16_t* mp0 = MG + (size_t)row0 * D + colt; o0 = *(const u32x4*)mp0; o1 = *(const u32x4*)(mp0 + 8); }
#pragma unroll
        for (int idx = 0; idx < 8; ++idx) { const int ai = idx >> 2, m = idx & 3; const int row = row0 + ai * HALF + m * 16; bf16_t* mp = MG + (size_t)row * D + colt;
            u32x4 gn = g, o0n = o0, o1n = o1;
            if (idx < 7) { const int rown = row0 + ((idx + 1) >> 2) * HALF + ((idx + 1) & 3) * 16; gn = *(const u32x4*)(GB + (size_t)rown * GBP + PASS * D + colt);
                if (PASS > 0) { const bf16_t* mpn = MG + (size_t)rown * D + colt; o0n = *(const u32x4*)mpn; o1n = *(const u32x4*)(mpn + 8); } }
            const f32x4 a0 = acc[ai][0][m][0], a1 = acc[ai][0][m][1], a2 = acc[ai][1][m][0], a3 = acc[ai][1][m][1];
            f32x4 v0 = (f32x4){ub0(g.x) * a0[0], ub1(g.x) * a0[1], ub2(g.x) * a0[2], ub3(g.x) * a0[3]}, v1 = (f32x4){ub0(g.y) * a1[0], ub1(g.y) * a1[1], ub2(g.y) * a1[2], ub3(g.y) * a1[3]};
            f32x4 v2 = (f32x4){ub0(g.z) * a2[0], ub1(g.z) * a2[1], ub2(g.z) * a2[2], ub3(g.z) * a2[3]}, v3 = (f32x4){ub0(g.w) * a3[0], ub1(g.w) * a3[1], ub2(g.w) * a3[2], ub3(g.w) * a3[3]};
            if (PASS > 0) {
                v0 = v0 + (f32x4){bflo(o0.x), bfhi(o0.x), bflo(o0.y), bfhi(o0.y)}; v1 = v1 + (f32x4){bflo(o0.z), bfhi(o0.z), bflo(o0.w), bfhi(o0.w)};
                v2 = v2 + (f32x4){bflo(o1.x), bfhi(o1.x), bflo(o1.y), bfhi(o1.y)}; v3 = v3 + (f32x4){bflo(o1.z), bfhi(o1.z), bflo(o1.w), bfhi(o1.w)}; }
            if (PASS == 2) { u32x4 w8; w8.x = pk4_fp8s(v0[0], v0[1], v0[2], v0[3], 1.0f); w8.y = pk4_fp8s(v1[0], v1[1], v1[2], v1[3], 1.0f); w8.z = pk4_fp8s(v2[0], v2[1], v2[2], v2[3], 1.0f); w8.w = pk4_fp8s(v3[0], v3[1], v3[2], v3[3], 1.0f);
                *(u32x4*)(MG8 + (size_t)row * D + colt) = w8; }
            else { u32x4 w0, w1; w0.x = pk2(v0[0], v0[1]); w0.y = pk2(v0[2], v0[3]); w0.z = pk2(v1[0], v1[1]); w0.w = pk2(v1[2], v1[3]); w1.x = pk2(v2[0], v2[1]); w1.y = pk2(v2[2], v2[3]); w1.z = pk2(v3[0], v3[1]); w1.w = pk2(v3[2], v3[3]);
                *(u32x4*)mp = w0; *(u32x4*)(mp + 8) = w1; }
            g = gn; o0 = o0n; o1 = o1n; }
    }
    __device__ __forceinline__ void operator()(const f32x4 (&acc)[2][2][4][2], const GUnit& u, int wr, int wc, int fr, int fq) const {
        if (u.z == 0) run<0>(acc, u, wr, wc, fr, fq); else if (u.z == 1) run<1>(acc, u, wr, wc, fr, fq); else run<2>(acc, u, wr, wc, fr, fq);
    }
};
struct EpiPool {
    static constexpr int PERM = 1; static constexpr int NST = 0;
    bf16_t* BR; const float* scale;
    __device__ __forceinline__ void operator()(const f32x4 (&acc)[2][2][4][2], const GUnit& u, int wr, int wc, int fr, int fq) const {
        const int row0 = u.x * 256 + wr * 64 + fr; const int colt = u.y * 256 + wc * 32 + 8 * fq;
        f32x4 sv[2][2];
#pragma unroll
        for (int bj = 0; bj < 2; ++bj)
#pragma unroll
            for (int n = 0; n < 2; ++n) sv[bj][n] = *(const f32x4*)(scale + colt + bj * HALF + 4 * n);
#pragma unroll
        for (int ai = 0; ai < 2; ++ai)
#pragma unroll
            for (int m = 0; m < 4; ++m) { unsigned char* rowp = (unsigned char*)BR + (size_t)(row0 + ai * HALF + m * 16) * 3072 + 1024 + colt;
#pragma unroll
                for (int bj = 0; bj < 2; ++bj) { const f32x4 v0 = acc[ai][bj][m][0] * sv[bj][0], v1 = acc[ai][bj][m][1] * sv[bj][1];
                    u32x2 w; w.x = pk4_fp8s(v0[0], v0[1], v0[2], v0[3], 1.0f); w.y = pk4_fp8s(v1[0], v1[1], v1[2], v1[3], 1.0f); *(u32x2*)(rowp + bj * HALF) = w; } }
    }
};
struct EpiRG {
    static constexpr int PERM = 1; static constexpr int NST = 0;
    const bf16_t* BR; bf16_t* LA; bf16_t* BBs; const float* ba; const float* bx; const float* ls;
    __device__ __forceinline__ void operator()(const f32x4 (&acc)[2][2][4][2], const GUnit& u, int wr, int wc, int fr, int fq) const {
        const int row0 = u.x * 256 + wr * 64 + fr; const int ch = u.y * 128 + wc * 32 + 8 * fq;
        f32x4 bav[2], bxv[2], lsv[2];
#pragma unroll
        for (int n = 0; n < 2; ++n) { bav[n] = *(const f32x4*)(ba + ch + 4 * n); bxv[n] = *(const f32x4*)(bx + ch + 4 * n); lsv[n] = *(const f32x4*)(ls + ch + 4 * n); }
#pragma unroll
        for (int ai = 0; ai < 2; ++ai)
#pragma unroll
            for (int m = 0; m < 4; ++m) { const size_t row = (size_t)(row0 + ai * HALF + m * 16);
                const u32x4 cw = *(const u32x4*)(BR + row * 1536 + 1024 + ch); const float cv[8] = {bflo(cw.x), bfhi(cw.x), bflo(cw.y), bfhi(cw.y), bflo(cw.z), bfhi(cw.z), bflo(cw.w), bfhi(cw.w)};
                float la[8], bb[8];
#pragma unroll
                for (int n = 0; n < 2; ++n)
#pragma unroll
                    for (int q = 0; q < 4; ++q) { const float rr = sigmoidf_(acc[ai][0][m][n][q] + bav[n][q]), ii = sigmoidf_(acc[ai][1][m][n][q] + bxv[n][q]);
                        const float l = 8.0f * rr * lsv[n][q]; const float x2 = 2.0f * l; const float om = x2 > -0.02f ? -x2 * (1.0f + x2 * (0.5f + x2 * 0.16666667f)) : 1.0f - __expf(x2);
                        la[4 * n + q] = l; bb[4 * n + q] = __builtin_amdgcn_sqrtf(om) * (ii * cv[4 * n + q]); }
                u32x4 w; w.x = pk2(la[0], la[1]); w.y = pk2(la[2], la[3]); w.z = pk2(la[4], la[5]); w.w = pk2(la[6], la[7]); *(u32x4*)(LA + row * 512 + ch) = w;
                w.x = pk2(bb[0], bb[1]); w.y = pk2(bb[2], bb[3]); w.z = pk2(bb[4], bb[5]); w.w = pk2(bb[6], bb[7]); *(u32x4*)(BBs + row * 512 + ch) = w; }
    }
};
struct EpiResB {
    static constexpr int PERM = 1; static constexpr int NST = 16;
    bf16_t* O; const bf16_t* R; float scale;
    __device__ __forceinline__ void operator()(const f32x4 (&acc)[2][2][4][2], const GUnit& u, int wr, int wc, int fr, int fq) const {
        const int row0 = u.x * 256 + wr * 64 + fr; const int colt = u.y * 256 + wc * 32 + 8 * fq;
        u32x4 r0 = (u32x4){0u, 0u, 0u, 0u}, r1 = r0;
        if (R) { const size_t off0 = (size_t)row0 * D + colt; r0 = *(const u32x4*)(R + off0); r1 = *(const u32x4*)(R + off0 + HALF); }
#pragma unroll
        for (int idx = 0; idx < 8; ++idx) { const int ai = idx >> 2, m = idx & 3; const size_t off = (size_t)(row0 + ai * HALF + m * 16) * D + colt;
            u32x4 r0n = r0, r1n = r1;
            if (R && idx < 7) { const size_t offn = (size_t)(row0 + ((idx + 1) >> 2) * HALF + ((idx + 1) & 3) * 16) * D + colt; r0n = *(const u32x4*)(R + offn); r1n = *(const u32x4*)(R + offn + HALF); }
#pragma unroll
            for (int bj = 0; bj < 2; ++bj) { f32x4 v0 = acc[ai][bj][m][0], v1 = acc[ai][bj][m][1]; const u32x4 r = bj ? r1 : r0;
                if (R) { v0 = v0 + (f32x4){bflo(r.x), bfhi(r.x), bflo(r.y), bfhi(r.y)} * scale; v1 = v1 + (f32x4){bflo(r.z), bfhi(r.z), bflo(r.w), bfhi(r.w)} * scale; }
                u32x4 w; w.x = pk2(v0[0], v0[1]); w.y = pk2(v0[2], v0[3]); w.z = pk2(v1[0], v1[1]); w.w = pk2(v1[2], v1[3]); *(u32x4*)(O + off + bj * HALF) = w; }
            r0 = r0n; r1 = r1n; }
    }
};
struct EpiGLU {
    static constexpr int PERM = 1; static constexpr int NST = 0;
    unsigned char* Hout; float* LG; bool moe;
    __device__ __forceinline__ void operator()(const f32x4 (&acc)[2][2][4][2], const GUnit& u, int wr, int wc, int fr, int fq) const {
        const int row0 = u.x * 256 + wr * 64 + fr;
        if (!moe && u.y == 2) {
            if (wc < 2) {
#pragma unroll
                for (int ai = 0; ai < 2; ++ai)
#pragma unroll
                    for (int m = 0; m < 4; ++m) { float* lp = LG + (size_t)(row0 + ai * HALF + m * 16) * 64 + wc * 32 + 8 * fq;
#pragma unroll
                        for (int n = 0; n < 2; ++n) *(f32x4*)(lp + 4 * n) = acc[ai][0][m][n]; }
            }
            return;
        }
        const int colt = u.y * 128 + wc * 32 + 8 * fq;
#pragma unroll
        for (int ai = 0; ai < 2; ++ai)
#pragma unroll
            for (int m = 0; m < 4; ++m) { unsigned char* hp = Hout + (size_t)(row0 + ai * HALF + m * 16) * DEXP + colt;
                const f32x4 a0 = acc[ai][0][m][0], b0 = acc[ai][1][m][0], a1 = acc[ai][0][m][1], b1 = acc[ai][1][m][1];
                u32x2 w; w.x = pk4_fp8s(siluf_(a0[0]) * b0[0], siluf_(a0[1]) * b0[1], siluf_(a0[2]) * b0[2], siluf_(a0[3]) * b0[3], 1.0f); w.y = pk4_fp8s(siluf_(a1[0]) * b1[0], siluf_(a1[1]) * b1[1], siluf_(a1[2]) * b1[2], siluf_(a1[3]) * b1[3], 1.0f);
                *(u32x2*)hp = w; }
    }
};
constexpr float Y_SCALE = 16.0f;
__device__ __forceinline__ unsigned pk4_fp8(f32x4 a) { int w = 0; w = __builtin_amdgcn_cvt_pk_fp8_f32(a[0] * Y_SCALE, a[1] * Y_SCALE, w, false); w = __builtin_amdgcn_cvt_pk_fp8_f32(a[2] * Y_SCALE, a[3] * Y_SCALE, w, true); return (unsigned)w; }
struct EpiExpDown {
    static constexpr int PERM = 2; static constexpr int NST = 8;
    unsigned char* Y;
    __device__ __forceinline__ void operator()(const f32x4 (&acc)[2][2][4][2], const GUnit& u, int wr, int wc, int fr, int fq) const {
        const int colt = u.y * 256 + wc * 64 + 16 * fq;
#pragma unroll
        for (int ai = 0; ai < 2; ++ai)
#pragma unroll
            for (int m = 0; m < 4; ++m) { const int r = ai * HALF + wr * 64 + m * 16 + fr;
                u32x4 w; w.x = pk4_fp8(acc[ai][0][m][0]); w.y = pk4_fp8(acc[ai][0][m][1]); w.z = pk4_fp8(acc[ai][1][m][0]); w.w = pk4_fp8(acc[ai][1][m][1]);
                *(u32x4*)(Y + (size_t)(u.x * 256 + r) * D + colt) = w; }
    }
};

template <class Map>
__device__ __forceinline__ void transpose_item(const float* W, int K, int N, bf16_t* WT, const Map& map, LAS float* scr, int item, int lane, int ldo = 0) {
    if (ldo == 0) ldo = K;
    const int nblk = N / 32, kb = item / nblk, nb = item % nblk, k0 = 64 * kb, n0 = 32 * nb;
    { f32x4 t[8];
#pragma unroll
      for (int i = 0; i < 8; ++i) t[i] = *(const f32x4*)(W + (size_t)(k0 + 8 * i + (lane >> 3)) * N + n0 + 4 * (lane & 7));
#pragma unroll
      for (int i = 0; i < 8; ++i) { LAS float* d = scr + (8 * i + (lane >> 3)) * 33 + 4 * (lane & 7); d[0] = t[i][0]; d[1] = t[i][1]; d[2] = t[i][2]; d[3] = t[i][3]; } }
    LDS_WAIT(); asm volatile("" ::: "memory");
    const int c = lane & 7;
#pragma unroll
    for (int j = 0; j < 4; ++j) { const int n = (lane >> 3) + 8 * j; const LAS float* s = scr + (8 * c) * 33 + n;
        u32x4 o; o.x = pk2(s[0 * 33], s[1 * 33]); o.y = pk2(s[2 * 33], s[3 * 33]); o.z = pk2(s[4 * 33], s[5 * 33]); o.w = pk2(s[6 * 33], s[7 * 33]);
        *(u32x4*)(WT + (size_t)map(n0 + n) * ldo + k0 + 8 * c) = o; }
    LDS_WAIT(); asm volatile("" ::: "memory");
}
template <class Map>
__device__ __forceinline__ void transpose_item8(const float* W, int K, int N, unsigned char* WT, const Map& map, LAS float* scr, int item, int lane, const float wscale = W8_SCALE) {
    const int nblk = N / 32, kb = item / nblk, nb = item % nblk, k0 = 64 * kb, n0 = 32 * nb;
    { f32x4 t[8];
#pragma unroll
      for (int i = 0; i < 8; ++i) t[i] = *(const f32x4*)(W + (size_t)(k0 + 8 * i + (lane >> 3)) * N + n0 + 4 * (lane & 7));
#pragma unroll
      for (int i = 0; i < 8; ++i) { LAS float* d = scr + (8 * i + (lane >> 3)) * 33 + 4 * (lane & 7); d[0] = t[i][0]; d[1] = t[i][1]; d[2] = t[i][2]; d[3] = t[i][3]; } }
    LDS_WAIT(); asm volatile("" ::: "memory");
    const int c = lane & 7;
#pragma unroll
    for (int j = 0; j < 4; ++j) { const int n = (lane >> 3) + 8 * j; const LAS float* s = scr + (8 * c) * 33 + n;
        u32x2 o; o.x = pk4_fp8s(s[0 * 33], s[1 * 33], s[2 * 33], s[3 * 33], wscale); o.y = pk4_fp8s(s[4 * 33], s[5 * 33], s[6 * 33], s[7 * 33], wscale);
        *(u32x2*)(WT + (size_t)map(n0 + n) * K + k0 + 8 * c) = o; }
    LDS_WAIT(); asm volatile("" ::: "memory");
}
struct MapId { int off; __device__ __forceinline__ int operator()(int n) const { return off + n; } };
struct MapIn { __device__ __forceinline__ int operator()(int n) const { if (n >= 1024) return n; const int d = n & 127; return (n & ~127) + 2 * (d & 63) + (d >> 6); } };
struct MapGlu { int off; __device__ __forceinline__ int operator()(int n) const { return (n >> 7) * 256 + off + (n & 127); } };

__device__ __forceinline__ void phase_cvt(const Ctx& c) {
    const int layer = c.layer; const size_t L = (size_t)layer;
    LAS float* scr = (LAS float*)(c.lds + c.wave * 16384);
    const int gw = c.bid * 8 + c.wave, NGW = c.G * 8;
    unsigned char* w_in8 = (unsigned char*)(c.ws + W_IN); unsigned char* e13_8 = (unsigned char*)(c.ws + W_E13); bf16_t* w_brT = (bf16_t*)(c.ws + W_BR); bf16_t* w_outT = (bf16_t*)(c.ws + W_OUT); bf16_t* smT = (bf16_t*)(c.ws + W_SM);
    bf16_t* shupT = (bf16_t*)(c.ws + W_SHUP); unsigned char* shdn8 = (unsigned char*)(c.ws + W_SHDN); unsigned char* e2_8 = (unsigned char*)(c.ws + W_E2);
    constexpr int I_IN = (D / 64) * (INW / 32), I_BR = (512 / 64) * (D / 32), I_OUT = (D / 64) * (D / 32), I_SM = (128 / 64) * (128 / 32), I_UP = (D / 64) * (DEXP / 32), I_DN = (DEXP / 64) * (D / 32), I_RT = (D / 64) * (64 / 32);
    constexpr int N0 = I_IN, N1 = N0 + 3 * I_BR, N2 = N1 + I_OUT, N3 = N2 + 12 * I_SM, N4 = N3 + 2 * I_UP, N5 = N4 + I_RT, N6 = N5 + I_DN, N7 = N6 + 2 * NEXP * I_UP, N8 = N7 + NEXP * I_DN;
    for (int it = gw; it < N8; it += NGW) {
        int r = it;
        if (r < N0) { transpose_item8(inp(c, I_WIN, L * D * INW), D, INW, w_in8, MapIn{}, scr, r, c.lane); continue; }
        if (r < N1) { r -= N0; const int i = r / I_BR; transpose_item8(inp(c, I_WBR, L * 3 * 512 * D) + (size_t)i * 512 * D, 512, D, (unsigned char*)w_brT + (size_t)i * D * 512, MapId{0}, scr, r % I_BR, c.lane, W8_SCALE * (256.0f / 255.0f)); continue; }
        if (r < N2) { r -= N1; transpose_item8(inp(c, I_WOUT, L * D * D), D, D, (unsigned char*)w_outT, MapId{0}, scr, r, c.lane); continue; }
        if (r < N3) { r -= N2; const int i = r / I_SM, which = i / 4, g = i % 4; const float* src = inp(c, which == 0 ? I_POOLW : (which == 1 ? I_WA : I_WX), L * 4 * 128 * 128) + (size_t)g * 128 * 128;
            bf16_t* dst = which == 0 ? smT + (size_t)(g >> 1) * 65536 + (size_t)(g & 1) * 128 * 256 + (g & 1) * 128 : smT + (size_t)(2 + g) * 65536 + (size_t)(which - 1) * 128 * 256 + (g & 1) * 128;
            transpose_item(src, 128, 128, dst, MapId{0}, scr, r % I_SM, c.lane, 256); continue; }
        if (r < N4) { r -= N3; const int i = r / I_UP; transpose_item(inp(c, i == 0 ? I_SW1 : I_SW3, L * D * DEXP), D, DEXP, shupT, MapGlu{i * 128}, scr, r % I_UP, c.lane); continue; }
        if (r < N5) { r -= N4; transpose_item(inp(c, I_RW, L * D * 64), D, 64, shupT, MapId{512}, scr, r, c.lane); continue; }
        if (r < N6) { r -= N5; transpose_item8(inp(c, I_SW2, L * DEXP * D), DEXP, D, shdn8, MapId{0}, scr, r, c.lane); continue; }
        if (r < N7) { r -= N6; const int i = r / I_UP, e = i >> 1, which = i & 1; transpose_item8(inp(c, which ? I_EW3 : I_EW1, L * NEXP * D * DEXP) + (size_t)e * D * DEXP, D, DEXP, e13_8 + (size_t)e * 512 * D, MapGlu{which * 128}, scr, r % I_UP, c.lane); continue; }
        r -= N7; { const int e = r / I_DN; transpose_item8(inp(c, I_EW2, L * NEXP * DEXP * D) + (size_t)e * DEXP * D, DEXP, D, e2_8 + (size_t)e * D * DEXP, MapId{0}, scr, r % I_DN, c.lane); }
    }
    { u32x4* z = (u32x4*)(shupT + (size_t)576 * D); const int nz = 192 * D * 2 / 16; for (int i = c.bid * 512 + c.tid; i < nz; i += c.G * 512) z[i] = (u32x4){0u, 0u, 0u, 0u}; }
    {
        u32x4* z = (u32x4*)smT;
        for (int i = c.bid * 512 + c.tid; i < 6 * 256 * 16; i += c.G * 512) { const int t = i / (256 * 16), rr = (i / 16) % 256, ch = i % 16;
            const int khalf = t < 2 ? ((rr >> 7) ^ 1) : (((t - 2) & 1) ^ 1);
            z[((size_t)t * 65536 + (size_t)rr * 256 + khalf * 128) / 8 + ch] = (u32x4){0u, 0u, 0u, 0u}; }
        float* lsT = (float*)(c.ws + W_SM + 768 * 1024); const float* lam_ = inp(c, I_LAM, L * 512);
        for (int i = c.bid * 512 + c.tid; i < 512; i += c.G * 512) lsT[i] = -log1pf(expf(-lam_[i]));
    }
    if (layer == 0) {
        const f32x4* xs = (const f32x4*)inp(c, I_X, 0); u32x2* xd = (u32x2*)(c.ws + WS_XB); unsigned* xd8 = (unsigned*)(c.ws + WS_XB8);
        for (size_t i = (size_t)c.bid * 512 + c.tid; i < (size_t)T * D / 4; i += (size_t)c.G * 512) { const f32x4 v = xs[i]; u32x2 w; w.x = pk2(v[0], v[1]); w.y = pk2(v[2], v[3]); xd[i] = w; xd8[i] = pk4_fp8s(v[0], v[1], v[2], v[3], 1.0f); }
        unsigned* csT = (unsigned*)(c.ws + WS_COS);
        for (int i = c.bid * 512 + c.tid; i < SEQ * 64; i += c.G * 512) { const int s = i >> 6, j = i & 63; const float inv = powf(10000.0f, -(float)j / 64.0f); const float ang = (float)((const int*)inp(c, I_POS, 0))[s] * inv; csT[i] = pk2(cosf(ang), sinf(ang)); }
    }
}

constexpr int TP = 272;
__device__ __forceinline__ void load_tile128(lds_t* dst, const bf16_t* src, int gp, int rows, int tid) {
    for (int v = tid; v < rows * 16; v += 512) { const int r = v >> 4, cb = v & 15; *(LAS u32x4*)(dst + r * TP + cb * 16) = *(const u32x4*)(src + (size_t)r * gp + cb * 8); }
}
__device__ __forceinline__ float ret_log2g(int h) { return log2f(1.0f - exp2f(-5.0f - (float)h)); }

__device__ __forceinline__ void frag_col8(bf16x8 (&out)[8], const lds_t* X, int pitchB, int k0, int fr, int fq) {
    const int q = fr >> 2, p = fr & 3;
    const unsigned a0 = (unsigned)(size_t)X + (unsigned)((k0 + 8 * fq + q) * pitchB + 4 * p * 2), a1 = a0 + 4u * (unsigned)pitchB;
    u16x4 lo[8], hi[8];
    asm volatile("ds_read_b64_tr_b16 %0, %16\n\tds_read_b64_tr_b16 %1, %16 offset:32\n\tds_read_b64_tr_b16 %2, %16 offset:64\n\tds_read_b64_tr_b16 %3, %16 offset:96\n\t"
                 "ds_read_b64_tr_b16 %4, %16 offset:128\n\tds_read_b64_tr_b16 %5, %16 offset:160\n\tds_read_b64_tr_b16 %6, %16 offset:192\n\tds_read_b64_tr_b16 %7, %16 offset:224\n\t"
                 "ds_read_b64_tr_b16 %8, %17\n\tds_read_b64_tr_b16 %9, %17 offset:32\n\tds_read_b64_tr_b16 %10, %17 offset:64\n\tds_read_b64_tr_b16 %11, %17 offset:96\n\t"
                 "ds_read_b64_tr_b16 %12, %17 offset:128\n\tds_read_b64_tr_b16 %13, %17 offset:160\n\tds_read_b64_tr_b16 %14, %17 offset:192\n\tds_read_b64_tr_b16 %15, %17 offset:224\n\ts_waitcnt lgkmcnt(0)"
                 : "=&v"(lo[0]), "=&v"(lo[1]), "=&v"(lo[2]), "=&v"(lo[3]), "=&v"(lo[4]), "=&v"(lo[5]), "=&v"(lo[6]), "=&v"(lo[7]),
                   "=&v"(hi[0]), "=&v"(hi[1]), "=&v"(hi[2]), "=&v"(hi[3]), "=&v"(hi[4]), "=&v"(hi[5]), "=&v"(hi[6]), "=&v"(hi[7])
                 : "v"(a0), "v"(a1) : "memory");
#pragma unroll
    for (int i = 0; i < 8; ++i) { bf16x8 r; r[0] = (short)lo[i][0]; r[1] = (short)lo[i][1]; r[2] = (short)lo[i][2]; r[3] = (short)lo[i][3]; r[4] = (short)hi[i][0]; r[5] = (short)hi[i][1]; r[6] = (short)hi[i][2]; r[7] = (short)hi[i][3]; out[i] = r; }
}
#define ACC8(S, X, OP) do { S[0] OP bflo((X).x); S[1] OP bfhi((X).x); S[2] OP bflo((X).y); S[3] OP bfhi((X).y); S[4] OP bflo((X).z); S[5] OP bfhi((X).z); S[6] OP bflo((X).w); S[7] OP bfhi((X).w); } while (0)
template <int W>
__device__ __forceinline__ void pool_fill(bf16_t* dst, const bf16_t* Hcol, int r0, int s0) {
#pragma unroll 1
    for (int blk = 0; blk < 2; ++blk) {
        const int rb = r0 + blk * 4 - (W - 1);
        u32x4 lo[3], hi[4]; float sum[8];
#pragma unroll
        for (int e = 0; e < 8; ++e) sum[e] = 0.f;
#pragma unroll
        for (int j = 0; j < W + 3; ++j) { const int rr = rb + j; const int rc = rr < -s0 ? -s0 : rr; u32x4 xv = *(const u32x4*)(Hcol + (ptrdiff_t)rc * HW); if (s0 + rr < 0) xv = (u32x4){0u, 0u, 0u, 0u};
            if (j < W) ACC8(sum, xv, +=);
            if (j < 3) lo[j] = xv;
            if (j >= W - 1) hi[j - (W - 1)] = xv; }
#pragma unroll
        for (int o = 0; o < 4; ++o) {
            if (o > 0) { ACC8(sum, hi[o], +=); ACC8(sum, lo[o - 1], -=); }
            const int rr = r0 + blk * 4 + o; const int s = s0 + rr; const int nn = (s + 1) < W ? (s + 1) : W; const float inv = 1.0f / (float)nn; const u32x4 self = hi[o];
            u32x4 ov; ov.x = pk2(sum[0] * inv - bflo(self.x), sum[1] * inv - bfhi(self.x)); ov.y = pk2(sum[2] * inv - bflo(self.y), sum[3] * inv - bfhi(self.y));
            ov.z = pk2(sum[4] * inv - bflo(self.z), sum[5] * inv - bfhi(self.z)); ov.w = pk2(sum[6] * inv - bflo(self.w), sum[7] * inv - bfhi(self.w));
            *(u32x4*)(dst + (size_t)rr * 1536) = ov;
        }
    }
}
__device__ __forceinline__ void phase_mix1(const Ctx& c) {
    const size_t L = (size_t)c.layer;
    const float* conv_w = inp(c, I_CONVW, L * 4 * 512); const float* conv_b = inp(c, I_CONVB, L * 512); const float* pool_scale = inp(c, I_POOLS, L * 512);
    const float* ba_ = inp(c, I_BA, L * 512); const float* bx_ = inp(c, I_BX, L * 512); const float* lam_ = inp(c, I_LAM, L * 512);
    const int tid = c.tid, lane = c.lane, wave = c.wave, fr = lane & 15, fq = lane >> 4;
    const bf16_t* H = (const bf16_t*)(c.ws + S_H7); bf16_t* KV = (bf16_t*)(c.ws + S_KV); bf16_t* BR = (bf16_t*)(c.ws + S_BR);
    bf16_t* LA = (bf16_t*)(c.ws + S_LA); bf16_t* BBs = (bf16_t*)(c.ws + S_BB);
    const bf16_t* smT = (const bf16_t*)(c.ws + W_SM);
    lds_t* L0 = c.lds; lds_t* L1 = c.lds + 128 * TP;
    for (int p = c.bid; p < NPANEL; p += c.G) {
        const int b = p >> 4, t0 = p * 256;
        u32x4 kraw[4], vraw[4];
#pragma unroll
        for (int it = 0; it < 4; ++it) { const int v = tid + it * 512, r = v >> 4, cb = v & 15; kraw[it] = *(const u32x4*)(H + (size_t)(t0 + r) * HW + 512 + cb * 8); vraw[it] = *(const u32x4*)(H + (size_t)(t0 + r) * HW + 1024 + cb * 8); }
#pragma unroll 1
        for (int u = 0; u < 8; ++u) {
            const int cc = u >> 2, h = u & 3, n = (p & 15) * 2 + cc; const float l2g = ret_log2g(h);
            __syncthreads();
#pragma unroll
            for (int it = 0; it < 4; ++it) { const int v = tid + it * 512, r = v >> 4, cb = v & 15; const float dk = exp2f(l2g * (float)(127 - r)); const u32x4 kv = kraw[it];
                u32x4 ko; ko.x = pk2(bflo(kv.x) * dk, bfhi(kv.x) * dk); ko.y = pk2(bflo(kv.y) * dk, bfhi(kv.y) * dk); ko.z = pk2(bflo(kv.z) * dk, bfhi(kv.z) * dk); ko.w = pk2(bflo(kv.w) * dk, bfhi(kv.w) * dk);
                *(LAS u32x4*)(L0 + r * TP + cb * 16) = ko; *(LAS u32x4*)(L1 + r * TP + cb * 16) = vraw[it]; }
            __syncthreads();
            if (u < 7) { const int u2 = u + 1, cc2 = u2 >> 2, h2 = u2 & 3, tc2 = t0 + cc2 * 128;
#pragma unroll
                for (int it = 0; it < 4; ++it) { const int v = tid + it * 512, r = v >> 4, cb = v & 15; kraw[it] = *(const u32x4*)(H + (size_t)(tc2 + r) * HW + 512 + h2 * 128 + cb * 8); vraw[it] = *(const u32x4*)(H + (size_t)(tc2 + r) * HW + 1024 + h2 * 128 + cb * 8); } }
            f32x4 acc[8];
#pragma unroll
            for (int i = 0; i < 8; ++i) acc[i] = (f32x4){0.f, 0.f, 0.f, 0.f};
#pragma unroll
            for (int j0 = 0; j0 < 128; j0 += 32) {
                const bf16x8 a = frag_col(L1, TP, j0, wave * 16, fr, fq);
                bf16x8 kb[8]; frag_col8(kb, L0, TP, j0, fr, fq);
#pragma unroll
                for (int i = 0; i < 8; ++i) acc[i] = mfma16(kb[i], a, acc[i]);
            }
            bf16_t* kvp = KV + ((size_t)((b * 4 + h) * 32 + n)) * 16384;
#pragma unroll
            for (int i = 0; i < 8; ++i) { u32x2 w; w.x = pk2(acc[i][0], acc[i][1]); w.y = pk2(acc[i][2], acc[i][3]); *(u32x2*)(kvp + (wave * 16 + fr) * 128 + i * 16 + 4 * fq) = w; }
        }
        {
            const int cb = lane & 15, rl = lane >> 4, s0 = t0 & (SEQ - 1), g = wave & 3, r0 = rl * 64;
            if (wave < 4) {
                const int W = 2 << g; const bf16_t* Hcol = H + (size_t)t0 * HW + 2048 + g * 128 + cb * 8; bf16_t* dst = BR + (size_t)t0 * 1536 + g * 128 + cb * 8;
                float sum[8];
#pragma unroll
                for (int e = 0; e < 8; ++e) sum[e] = 0.f;
                for (int r = r0 - W + 1; r < r0; ++r) { const int rc = r < -s0 ? -s0 : r; u32x4 xv = *(const u32x4*)(Hcol + (ptrdiff_t)rc * HW); if (s0 + r < 0) xv = (u32x4){0u, 0u, 0u, 0u}; ACC8(sum, xv, +=); }
#pragma unroll 1
                for (int rb = r0; rb < r0 + 64; rb += 8) {
                    u32x4 xn[8], xo[8];
#pragma unroll
                    for (int i = 0; i < 8; ++i) { const int r = rb + i, ro = r - W; const int rcn = r < -s0 ? -s0 : r, rco = ro < -s0 ? -s0 : ro;
                        xn[i] = *(const u32x4*)(Hcol + (ptrdiff_t)rcn * HW); xo[i] = *(const u32x4*)(Hcol + (ptrdiff_t)rco * HW); if (s0 + ro < 0) xo[i] = (u32x4){0u, 0u, 0u, 0u}; }
#pragma unroll
                    for (int i = 0; i < 8; ++i) { const int r = rb + i; ACC8(sum, xn[i], +=); if (r > r0) ACC8(sum, xo[i], -=);
                        const int s = s0 + r; const int nn = (s + 1) < W ? (s + 1) : W; const float inv = 1.0f / (float)nn; const u32x4 self = xn[i];
                        u32x4 ov; ov.x = pk2(sum[0] * inv - bflo(self.x), sum[1] * inv - bfhi(self.x)); ov.y = pk2(sum[2] * inv - bflo(self.y), sum[3] * inv - bfhi(self.y));
                        ov.z = pk2(sum[4] * inv - bflo(self.z), sum[5] * inv - bfhi(self.z)); ov.w = pk2(sum[6] * inv - bflo(self.w), sum[7] * inv - bfhi(self.w));
                        *(u32x4*)(dst + (size_t)r * 1536) = ov; }
                }
            } else {
                const int ch = g * 128 + cb * 8; const bf16_t* Hcol = H + (size_t)t0 * HW + 2560 + ch; bf16_t* dst = BR + (size_t)t0 * 1536 + 1024 + ch;
                float cwv[4][8], cbv[8];
#pragma unroll
                for (int e = 0; e < 8; ++e) { cbv[e] = conv_b[ch + e];
#pragma unroll
                    for (int k = 0; k < 4; ++k) cwv[k][e] = conv_w[k * 512 + ch + e]; }
                u32x4 p1, p2, p3;
                { const int ra = r0 - 1, rb2 = r0 - 2, rc3 = r0 - 3; p1 = *(const u32x4*)(Hcol + (ptrdiff_t)(ra < -s0 ? -s0 : ra) * HW); p2 = *(const u32x4*)(Hcol + (ptrdiff_t)(rb2 < -s0 ? -s0 : rb2) * HW); p3 = *(const u32x4*)(Hcol + (ptrdiff_t)(rc3 < -s0 ? -s0 : rc3) * HW);
                  if (s0 + ra < 0) p1 = (u32x4){0u, 0u, 0u, 0u}; if (s0 + rb2 < 0) p2 = (u32x4){0u, 0u, 0u, 0u}; if (s0 + rc3 < 0) p3 = (u32x4){0u, 0u, 0u, 0u}; }
#pragma unroll 1
                for (int rb = r0; rb < r0 + 64; rb += 8) {
                    u32x4 xn[8];
#pragma unroll
                    for (int i = 0; i < 8; ++i) xn[i] = *(const u32x4*)(Hcol + (ptrdiff_t)(rb + i) * HW);
#pragma unroll
                    for (int i = 0; i < 8; ++i) { float sum[8];
#pragma unroll
                        for (int e = 0; e < 8; ++e) sum[e] = cbv[e];
                        const u32x4 t0x = xn[i];
#define TAP8(X, K) do { sum[0] += bflo((X).x) * cwv[K][0]; sum[1] += bfhi((X).x) * cwv[K][1]; sum[2] += bflo((X).y) * cwv[K][2]; sum[3] += bfhi((X).y) * cwv[K][3]; sum[4] += bflo((X).z) * cwv[K][4]; sum[5] += bfhi((X).z) * cwv[K][5]; sum[6] += bflo((X).w) * cwv[K][6]; sum[7] += bfhi((X).w) * cwv[K][7]; } while (0)
                        TAP8(t0x, 0); TAP8(p1, 1); TAP8(p2, 2); TAP8(p3, 3);
#undef TAP8
                        u32x4 ov; ov.x = pk2(sum[0], sum[1]); ov.y = pk2(sum[2], sum[3]); ov.z = pk2(sum[4], sum[5]); ov.w = pk2(sum[6], sum[7]);
                        *(u32x4*)(dst + (size_t)(rb + i) * 1536) = ov; p3 = p2; p2 = p1; p1 = t0x; }
                }
            }
        }
    }
}

__device__ __forceinline__ void phase_rgscan(const Ctx& c) {
    bf16_t* LA = (bf16_t*)(c.ws + S_LA); bf16_t* BBs = (bf16_t*)(c.ws + S_BB); float* AE = (float*)(c.ws + S_RGC); float* HE = AE + 262144;
    for (int p = c.bid; p < NPANEL; p += c.G) {
        const int cp = c.tid & 255, ck = p * 2 + (c.tid >> 8); const size_t base = (size_t)ck * 128 * 512 + 2 * cp; float h0 = 0.f, P0 = 1.f, h1 = 0.f, P1 = 1.f;
        unsigned la[8], bb[8];
#pragma unroll
        for (int i = 0; i < 8; ++i) { const size_t o = base + (size_t)i * 512; la[i] = *(const unsigned*)(LA + o); bb[i] = *(const unsigned*)(BBs + o); }
#pragma unroll 1
        for (int j0 = 0; j0 < 128; j0 += 8) {
            unsigned lan[8], bbn[8]; const int jn = j0 + 8 < 128 ? j0 + 8 : j0;
#pragma unroll
            for (int i = 0; i < 8; ++i) { const size_t o = base + (size_t)(jn + i) * 512; lan[i] = *(const unsigned*)(LA + o); bbn[i] = *(const unsigned*)(BBs + o); }
            unsigned ho[8], po[8];
#pragma unroll
            for (int i = 0; i < 8; ++i) { const float a0 = __expf(bflo(la[i])), a1 = __expf(bfhi(la[i]));
                h0 = a0 * h0 + bflo(bb[i]); P0 *= a0; h1 = a1 * h1 + bfhi(bb[i]); P1 *= a1; ho[i] = pk2(h0, h1); po[i] = pk2(P0, P1); }
#pragma unroll
            for (int i = 0; i < 8; ++i) { const size_t o = base + (size_t)(j0 + i) * 512; *(unsigned*)(LA + o) = ho[i]; *(unsigned*)(BBs + o) = po[i]; }
#pragma unroll
            for (int i = 0; i < 8; ++i) { la[i] = lan[i]; bb[i] = bbn[i]; }
        }
        *(f32x2*)(AE + (size_t)ck * 512 + 2 * cp) = (f32x2){P0, P1}; *(f32x2*)(HE + (size_t)ck * 512 + 2 * cp) = (f32x2){h0, h1};
    }
}
__device__ __forceinline__ void phase_scan(const Ctx& c) {
    u32x4* KV = (u32x4*)(c.ws + S_KV);
    for (int i = c.bid * 512 + c.tid; i < 64 * 2048; i += c.G * 512) { const int bh = i >> 11, e = i & 2047; const float cd = exp2f(ret_log2g(bh & 3) * 128.0f);
        float st[8];
#pragma unroll
        for (int q = 0; q < 8; ++q) st[q] = 0.f;
        u32x4* p = KV + (size_t)bh * 32 * 2048 + e;
#pragma unroll 8
        for (int n = 0; n < 32; ++n) { const u32x4 v = p[(size_t)n * 2048]; u32x4 o; o.x = pk2(st[0], st[1]); o.y = pk2(st[2], st[3]); o.z = pk2(st[4], st[5]); o.w = pk2(st[6], st[7]); p[(size_t)n * 2048] = o;
            st[0] = st[0] * cd + bflo(v.x); st[1] = st[1] * cd + bfhi(v.x); st[2] = st[2] * cd + bflo(v.y); st[3] = st[3] * cd + bfhi(v.y); st[4] = st[4] * cd + bflo(v.z); st[5] = st[5] * cd + bfhi(v.z); st[6] = st[6] * cd + bflo(v.w); st[7] = st[7] * cd + bfhi(v.w); } }
    float* AE = (float*)(c.ws + S_RGC); float* HE = AE + 262144; float* CI = HE + 262144;
    for (int i = c.bid * 512 + c.tid; i < NBATCH * 512; i += c.G * 512) { const int b = i >> 9, ch = i & 511; float cr = 0.f;
        for (int n = 0; n < 32; ++n) { const size_t o = (size_t)(b * 32 + n) * 512 + ch; CI[o] = cr; cr = AE[o] * cr + HE[o]; } }
}
__device__ __forceinline__ void frag_tr8(bf16x8 (&out)[8], const lds_t* X, int pitchB, int rbase, int hrows, int fr) {
    const int q = fr >> 2, p = fr & 3;
    const unsigned a0 = (unsigned)(size_t)X + (unsigned)((rbase + q) * pitchB + 4 * p * 2), a1 = a0 + (unsigned)(hrows * pitchB);
    u16x4 lo[8], hi[8];
    asm volatile("ds_read_b64_tr_b16 %0, %16\n\tds_read_b64_tr_b16 %1, %16 offset:32\n\tds_read_b64_tr_b16 %2, %16 offset:64\n\tds_read_b64_tr_b16 %3, %16 offset:96\n\t"
                 "ds_read_b64_tr_b16 %4, %16 offset:128\n\tds_read_b64_tr_b16 %5, %16 offset:160\n\tds_read_b64_tr_b16 %6, %16 offset:192\n\tds_read_b64_tr_b16 %7, %16 offset:224\n\t"
                 "ds_read_b64_tr_b16 %8, %17\n\tds_read_b64_tr_b16 %9, %17 offset:32\n\tds_read_b64_tr_b16 %10, %17 offset:64\n\tds_read_b64_tr_b16 %11, %17 offset:96\n\t"
                 "ds_read_b64_tr_b16 %12, %17 offset:128\n\tds_read_b64_tr_b16 %13, %17 offset:160\n\tds_read_b64_tr_b16 %14, %17 offset:192\n\tds_read_b64_tr_b16 %15, %17 offset:224\n\ts_waitcnt lgkmcnt(0)"
                 : "=&v"(lo[0]), "=&v"(lo[1]), "=&v"(lo[2]), "=&v"(lo[3]), "=&v"(lo[4]), "=&v"(lo[5]), "=&v"(lo[6]), "=&v"(lo[7]),
                   "=&v"(hi[0]), "=&v"(hi[1]), "=&v"(hi[2]), "=&v"(hi[3]), "=&v"(hi[4]), "=&v"(hi[5]), "=&v"(hi[6]), "=&v"(hi[7])
                 : "v"(a0), "v"(a1) : "memory");
#pragma unroll
    for (int i = 0; i < 8; ++i) { bf16x8 r; r[0] = (short)lo[i][0]; r[1] = (short)lo[i][1]; r[2] = (short)lo[i][2]; r[3] = (short)lo[i][3]; r[4] = (short)hi[i][0]; r[5] = (short)hi[i][1]; r[6] = (short)hi[i][2]; r[7] = (short)hi[i][3]; out[i] = r; }
}
__device__ __forceinline__ void phase_mix2(const Ctx& c) {
    const int tid = c.tid, lane = c.lane, wave = c.wave, fr = lane & 15, fq = lane >> 4;
    const bf16_t* H = (const bf16_t*)(c.ws + S_H7); const bf16_t* KV = (const bf16_t*)(c.ws + S_KV); bf16_t* BR = (bf16_t*)(c.ws + S_BR);
    const bf16_t* HL = (const bf16_t*)(c.ws + S_LA); const bf16_t* PP = (const bf16_t*)(c.ws + S_BB); const float* CI = (const float*)(c.ws + S_RGC) + 2 * 262144;
    lds_t* LK = c.lds; lds_t* LV = c.lds + 128 * TP; lds_t* LP = c.lds + 256 * TP;
    for (int p = c.bid; p < NPANEL; p += c.G) {
        const int b = p >> 4, t0 = p * 256;
        u32x4 kraw[4], vraw[4], praw[4];
        {
            const int n0 = (p & 15) * 2;
#pragma unroll
            for (int it = 0; it < 4; ++it) { const int v = tid + it * 512, r = v >> 4, cb = v & 15; kraw[it] = *(const u32x4*)(H + (size_t)(t0 + r) * HW + 512 + cb * 8); vraw[it] = *(const u32x4*)(H + (size_t)(t0 + r) * HW + 1024 + cb * 8); }
            if (n0 > 0) { const bf16_t* kvp = KV + ((size_t)((b * 4 + 0) * 32 + n0)) * 16384;
#pragma unroll
                for (int it = 0; it < 4; ++it) { const int v = tid + it * 512; praw[it] = *(const u32x4*)(kvp + (size_t)v * 8); } }
        }
#pragma unroll 1
        for (int u = 0; u < 8; ++u) {
            const int cc = u >> 2, h = u & 3, n = (p & 15) * 2 + cc, tc = t0 + cc * 128; const float l2g = ret_log2g(h);
            bf16x8 qf[4];
#pragma unroll
            for (int d = 0; d < 4; ++d) qf[d] = *(const bf16x8*)(H + (size_t)(tc + wave * 16 + fr) * HW + h * 128 + d * 32 + 8 * fq);
            u32x2 gv[8];
#pragma unroll
            for (int i = 0; i < 8; ++i) gv[i] = *(const u32x2*)(H + (size_t)(tc + wave * 16 + fr) * HW + 1536 + h * 128 + i * 16 + 4 * fq);
            __syncthreads();
#pragma unroll
            for (int it = 0; it < 4; ++it) { const int v = tid + it * 512, r = v >> 4, cb = v & 15; *(LAS u32x4*)(LK + r * TP + cb * 16) = kraw[it]; *(LAS u32x4*)(LV + r * TP + cb * 16) = vraw[it]; }
            if (n > 0) {
#pragma unroll
                for (int it = 0; it < 4; ++it) { const int v = tid + it * 512, r = v >> 4, cb = v & 15; *(LAS u32x4*)(LP + r * TP + cb * 16) = praw[it]; } }
            __syncthreads();
            if (u < 7) {
                const int u2 = u + 1, cc2 = u2 >> 2, h2 = u2 & 3, tc2 = t0 + cc2 * 128, n2 = (p & 15) * 2 + cc2;
#pragma unroll
                for (int it = 0; it < 4; ++it) { const int v = tid + it * 512, r = v >> 4, cb = v & 15; kraw[it] = *(const u32x4*)(H + (size_t)(tc2 + r) * HW + 512 + h2 * 128 + cb * 8); vraw[it] = *(const u32x4*)(H + (size_t)(tc2 + r) * HW + 1024 + h2 * 128 + cb * 8); }
                if (n2 > 0) { const bf16_t* kvp = KV + ((size_t)((b * 4 + h2) * 32 + n2)) * 16384;
#pragma unroll
                    for (int it = 0; it < 4; ++it) { const int v = tid + it * 512; praw[it] = *(const u32x4*)(kvp + (size_t)v * 8); } }
            }
            const float gc = exp2f(l2g * (float)fr);
            float gj[4];
#pragma unroll
            for (int r = 0; r < 4; ++r) gj[r] = exp2f(-l2g * (float)(4 * fq + r));
            bf16x8 sb[4];
#pragma unroll
            for (int s = 0; s < 4; ++s) {
                u32x2 half[2];
#pragma unroll
                for (int hh = 0; hh < 2; ++hh) { const int jt = 2 * s + hh; f32x4 st = (f32x4){0.f, 0.f, 0.f, 0.f};
                    if (jt <= wave) {
#pragma unroll
                        for (int d = 0; d < 4; ++d) { const bf16x8 a = frag_row(LK, TP, jt * 16, d * 32, fr, fq); st = mfma16(a, qf[d], st); }
                        const float gt = gc * exp2f(l2g * (float)(16 * (wave - jt)));
#pragma unroll
                        for (int r = 0; r < 4; ++r) { const bool ok = (jt < wave) || (4 * fq + r <= fr); st[r] = ok ? st[r] * gt * gj[r] : 0.f; } }
                    half[hh].x = pk2(st[0], st[1]); half[hh].y = pk2(st[2], st[3]); }
                const u32x4 w = (u32x4){half[0].x, half[0].y, half[1].x, half[1].y}; sb[s] = __builtin_bit_cast(bf16x8, w);
            }
            f32x4 o[8];
#pragma unroll
            for (int i = 0; i < 8; ++i) o[i] = (f32x4){0.f, 0.f, 0.f, 0.f};
            if (n > 0) {
#pragma unroll
                for (int d = 0; d < 4; ++d)
#pragma unroll
                    for (int i = 0; i < 8; ++i) { const bf16x8 a = frag_row(LP, TP, i * 16, d * 32, fr, fq); o[i] = mfma16(a, qf[d], o[i]); }
                const float qd = exp2f(l2g * (float)(wave * 16 + fr + 1));
#pragma unroll
                for (int i = 0; i < 8; ++i) o[i] = o[i] * qd;
            }
#pragma unroll
            for (int s = 0; s < 4; ++s) if (2 * s <= wave) { bf16x8 vt[8]; frag_tr8(vt, LV, TP, 32 * s + 4 * fq, 16, fr);
#pragma unroll
                for (int i = 0; i < 8; ++i) o[i] = mfma16(vt[i], sb[s], o[i]); }
            {
                float sm = 0.f;
#pragma unroll
                for (int i = 0; i < 8; ++i) sm += (o[i][0] + o[i][1]) + (o[i][2] + o[i][3]);
                sm += __shfl_xor(sm, 16); sm += __shfl_xor(sm, 32);
                const float mu = sm * (1.0f / 128.0f); float sq = 0.f;
#pragma unroll
                for (int i = 0; i < 8; ++i) { o[i] = o[i] - mu; sq += (o[i][0] * o[i][0] + o[i][1] * o[i][1]) + (o[i][2] * o[i][2] + o[i][3] * o[i][3]); }
                sq += __shfl_xor(sq, 16); sq += __shfl_xor(sq, 32);
                const float rstd = 1.0f / sqrtf(sq * (1.0f / 128.0f) + GN_EPS);
                const size_t row = (size_t)(tc + wave * 16 + fr);
#pragma unroll
                for (int i = 0; i < 8; ++i) { const int col = h * 128 + i * 16 + 4 * fq; const u32x2 g = gv[i];
                    *(unsigned*)((unsigned char*)BR + row * 3072 + col) = pk4_fp8s(bflo(g.x) * o[i][0] * rstd, bfhi(g.x) * o[i][1] * rstd, bflo(g.y) * o[i][2] * rstd, bfhi(g.y) * o[i][3] * rstd, 1.0f); }
            }
        }
#pragma unroll 4
        for (int v = tid; v < 256 * 64; v += 512) { const int r = v >> 6, c8 = v & 63; const size_t row = (size_t)(t0 + r); const int ck = (t0 + r) >> 7;
            const u32x4 hl = *(const u32x4*)(HL + row * 512 + c8 * 8), pp = *(const u32x4*)(PP + row * 512 + c8 * 8), gy = *(const u32x4*)(H + row * HW + 3072 + c8 * 8);
            const f32x4 ci0 = *(const f32x4*)(CI + (size_t)ck * 512 + c8 * 8), ci1 = *(const f32x4*)(CI + (size_t)ck * 512 + c8 * 8 + 4);
            u32x2 o; o.x = pk4_fp8s((bflo(hl.x) + bflo(pp.x) * ci0[0]) * bflo(gy.x), (bfhi(hl.x) + bfhi(pp.x) * ci0[1]) * bfhi(gy.x), (bflo(hl.y) + bflo(pp.y) * ci0[2]) * bflo(gy.y), (bfhi(hl.y) + bfhi(pp.y) * ci0[3]) * bfhi(gy.y), 1.0f);
            o.y = pk4_fp8s((bflo(hl.z) + bflo(pp.z) * ci1[0]) * bflo(gy.z), (bfhi(hl.z) + bfhi(pp.z) * ci1[1]) * bfhi(gy.z), (bflo(hl.w) + bflo(pp.w) * ci1[2]) * bflo(gy.w), (bfhi(hl.w) + bfhi(pp.w) * ci1[3]) * bfhi(gy.w), 1.0f);
            *(u32x2*)((unsigned char*)BR + row * 3072 + 1536 + c8 * 8) = o; }
    }
}

__device__ __forceinline__ void ln16_store(f32x4 (&v)[4], int lane, const f32x4 (&gg)[4], const f32x4 (&bb)[4], float* of, bf16_t* ob, unsigned char* o8 = nullptr) {
    float s = 0.f;
#pragma unroll
    for (int j = 0; j < 4; ++j) s += (v[j][0] + v[j][1]) + (v[j][2] + v[j][3]);
    const float mean = wave_sum(s) * (1.f / D); float s2 = 0.f;
#pragma unroll
    for (int j = 0; j < 4; ++j) { v[j] = v[j] - mean; s2 += (v[j][0] * v[j][0] + v[j][1] * v[j][1]) + (v[j][2] * v[j][2] + v[j][3] * v[j][3]); }
    const float rstd = 1.f / sqrtf(wave_sum(s2) * (1.f / D) + LN_EPS);
    f32x4 o[4];
#pragma unroll
    for (int j = 0; j < 4; ++j) o[j] = v[j] * rstd * gg[j] + bb[j];
    if (of) {
#pragma unroll
        for (int j = 0; j < 4; ++j) *(f32x4*)(of + 16 * lane + 4 * j) = o[j]; }
    if (ob) { u32x4 w0, w1; w0.x = pk2(o[0][0], o[0][1]); w0.y = pk2(o[0][2], o[0][3]); w0.z = pk2(o[1][0], o[1][1]); w0.w = pk2(o[1][2], o[1][3]); w1.x = pk2(o[2][0], o[2][1]); w1.y = pk2(o[2][2], o[2][3]); w1.z = pk2(o[3][0], o[3][1]); w1.w = pk2(o[3][2], o[3][3]);
        *(u32x4*)(ob + 16 * lane) = w0; *(u32x4*)(ob + 16 * lane + 8) = w1; }
    if (o8) { u32x4 w; w.x = pk4_fp8s(o[0][0], o[0][1], o[0][2], o[0][3], 1.0f); w.y = pk4_fp8s(o[1][0], o[1][1], o[1][2], o[1][3], 1.0f); w.z = pk4_fp8s(o[2][0], o[2][1], o[2][2], o[2][3], 1.0f); w.w = pk4_fp8s(o[3][0], o[3][1], o[3][2], o[3][3], 1.0f); *(u32x4*)(o8 + 16 * lane) = w; }
}
__device__ __forceinline__ void ld16_bf16(const bf16_t* row, int lane, f32x4 (&v)[4]) {
    const u32x4 a = *(const u32x4*)(row + 16 * lane), b = *(const u32x4*)(row + 16 * lane + 8);
    v[0] = (f32x4){bflo(a.x), bfhi(a.x), bflo(a.y), bfhi(a.y)}; v[1] = (f32x4){bflo(a.z), bfhi(a.z), bflo(a.w), bfhi(a.w)}; v[2] = (f32x4){bflo(b.x), bfhi(b.x), bflo(b.y), bfhi(b.y)}; v[3] = (f32x4){bflo(b.z), bfhi(b.z), bflo(b.w), bfhi(b.w)};
}
__device__ __forceinline__ void phase_ln1(const Ctx& c, bool dummy) {
    const float* g = inp(c, I_LN1G, (size_t)c.layer * D); const float* bt = inp(c, I_LN1B, (size_t)c.layer * D);
    bf16_t* xb = (bf16_t*)(c.ws + WS_XB); const bf16_t* PRE = (const bf16_t*)(c.ws + S_PRE); const int lane = c.lane;
    f32x4 gg[4], bb[4];
#pragma unroll
    for (int j = 0; j < 4; ++j) { gg[j] = *(const f32x4*)(g + 16 * lane + 4 * j); bb[j] = *(const f32x4*)(bt + 16 * lane + 4 * j); }
    int row = c.bid * 8 + c.wave; const int step = c.G * 8;
    u32x4 a = *(const u32x4*)(PRE + (size_t)row * D + 16 * lane), b = *(const u32x4*)(PRE + (size_t)row * D + 16 * lane + 8);
    for (; row < T; row += step) {
        const int nrow = row + step < T ? row + step : row;
        const u32x4 na = *(const u32x4*)(PRE + (size_t)nrow * D + 16 * lane), nb = *(const u32x4*)(PRE + (size_t)nrow * D + 16 * lane + 8);
        f32x4 v[4]; v[0] = (f32x4){bflo(a.x), bfhi(a.x), bflo(a.y), bfhi(a.y)}; v[1] = (f32x4){bflo(a.z), bfhi(a.z), bflo(a.w), bfhi(a.w)}; v[2] = (f32x4){bflo(b.x), bfhi(b.x), bflo(b.y), bfhi(b.y)}; v[3] = (f32x4){bflo(b.z), bfhi(b.z), bflo(b.w), bfhi(b.w)};
        float s = 0.f;
#pragma unroll
        for (int j = 0; j < 4; ++j) s += (v[j][0] + v[j][1]) + (v[j][2] + v[j][3]);
        const float mean = wave_sum(s) * (1.f / D); float s2 = 0.f;
#pragma unroll
        for (int j = 0; j < 4; ++j) { v[j] = v[j] - mean; s2 += (v[j][0] * v[j][0] + v[j][1] * v[j][1]) + (v[j][2] * v[j][2] + v[j][3] * v[j][3]); }
        const float rstd = 1.f / sqrtf(wave_sum(s2) * (1.f / D) + LN_EPS);
        f32x4 o[4];
#pragma unroll
        for (int j = 0; j < 4; ++j) o[j] = v[j] * rstd * gg[j] + bb[j];
        bf16_t* ob = dummy ? (bf16_t*)(c.ws + S_Y) + (size_t)row * D : xb + (size_t)row * D;
        u32x4 w0, w1; w0.x = pk2(o[0][0], o[0][1]); w0.y = pk2(o[0][2], o[0][3]); w0.z = pk2(o[1][0], o[1][1]); w0.w = pk2(o[1][2], o[1][3]); w1.x = pk2(o[2][0], o[2][1]); w1.y = pk2(o[2][2], o[2][3]); w1.z = pk2(o[3][0], o[3][1]); w1.w = pk2(o[3][2], o[3][3]);
        *(u32x4*)(ob + 16 * lane) = w0; *(u32x4*)(ob + 16 * lane + 8) = w1;
        if (!dummy) { u32x4 w; w.x = pk4_fp8s(o[0][0], o[0][1], o[0][2], o[0][3], 1.0f); w.y = pk4_fp8s(o[1][0], o[1][1], o[1][2], o[1][3], 1.0f); w.z = pk4_fp8s(o[2][0], o[2][1], o[2][2], o[2][3], 1.0f); w.w = pk4_fp8s(o[3][0], o[3][1], o[3][2], o[3][3], 1.0f);
            *(u32x4*)((unsigned char*)(c.ws + WS_XB8) + (size_t)row * D + 16 * lane) = w; }
        a = na; b = nb;
    }
}

__device__ __forceinline__ void phase_route(const Ctx& c) {
    const int layer = c.layer;
    const int lane = c.lane, wave = c.wave;
    const float* LG = (const float*)(c.ws + S_LG); unsigned* PE = (unsigned*)(c.ws + S_PE); float* GW = (float*)(c.ws + S_GW); unsigned* LIST = (unsigned*)(c.ws + S_LIST);
    LAS int* lcnt = (LAS int*)(c.lds); LAS int* lbase = lcnt + 64; LAS unsigned* ent = (LAS unsigned*)(lcnt + 128);
    const float rb = inp(c, I_RB, (size_t)layer * 64)[lane];
    for (int p = c.bid; p < NPANEL; p += c.G) {
        const int sub = p / PSUB; unsigned* gcnt = (unsigned*)(c.ws + WS_CTL) + CW_CNT + (layer * NSUB + sub) * 64;
        __syncthreads();
        if (c.tid < 64) lcnt[c.tid] = 0;
        __syncthreads();
        float lgn = LG[(size_t)(p * 256 + wave * 32) * 64 + lane];
        for (int ti = 0; ti < 32; ++ti) {
            const int tl = wave * 32 + ti, t = p * 256 + tl;
            const float lg = lgn; if (ti < 31) lgn = LG[(size_t)(t + 1) * 64 + lane]; const float sc = 1.0f / (1.0f + expf(-lg)); const float bs = sc + rb;
            float m1 = bs; int i1 = lane;
#pragma unroll
            for (int o = 1; o < 8; o <<= 1) { const float om = __shfl_xor(m1, o); const int oi = __shfl_xor(i1, o); if (om > m1 || (om == m1 && oi < i1)) { m1 = om; i1 = oi; } }
            float m2 = (lane == i1) ? -INFINITY : bs;
#pragma unroll
            for (int o = 1; o < 8; o <<= 1) m2 = fmaxf(m2, __shfl_xor(m2, o));
            const float gs = m1 + m2; const int g = lane >> 3; int grank = 0;
#pragma unroll
            for (int gg = 0; gg < 8; ++gg) { const float og = __shfl(gs, gg * 8); grank += (og > gs || (og == gs && gg < g)) ? 1 : 0; }
            unsigned key = __builtin_bit_cast(unsigned, bs); key = (key & 0x80000000u) ? ~key : (key | 0x80000000u); key = (key & ~63u) | (unsigned)(63 - lane); if (grank >= 4) key = (unsigned)(63 - lane);
            unsigned thr = 0u;
#pragma unroll 1
            for (int bit = 31; bit >= 0; --bit) { const unsigned cand = thr | (1u << bit); const int cntb = __builtin_popcountll(__ballot(key >= cand)); if (cntb >= 8) thr = cand; }
            const unsigned long long selm = __ballot(key >= thr);
            const int rank = (key >= thr) ? __builtin_popcountll(selm & ((1ull << lane) - 1ull)) : 8;
            const bool sel = rank < 8; const float ssum = wave_sum(sel ? sc : 0.f);
            if (sel) { const int ls = __hip_atomic_fetch_add(lcnt + lane, 1, __ATOMIC_RELAXED, __HIP_MEMORY_SCOPE_WORKGROUP); ent[tl * 8 + rank] = ((unsigned)lane << 16) | (unsigned)ls; GW[(size_t)t * 8 + rank] = sc / ssum * 2.5f; }
        }
        __syncthreads();
        if (c.tid < 64) lbase[c.tid] = (int)atomicAdd(gcnt + c.tid, (unsigned)lcnt[c.tid]);
        __syncthreads();
        for (int i = c.tid; i < 2048; i += 512) { const unsigned en = ent[i]; const int e = en >> 16, slot = lbase[e] + (int)(en & 0xffffu); const unsigned a = (unsigned)(p * 256) * 8u + (unsigned)i;
            __hip_atomic_store(LIST + ((size_t)sub * NEXP + e) * TSUB + slot, a, __ATOMIC_RELAXED, __HIP_MEMORY_SCOPE_AGENT);
            PE[a] = ((unsigned)e << 20) | (unsigned)slot; }
    }
}
__device__ __forceinline__ void moe_tables(const Ctx& c, int layer, int sub, LAS int* cnt, LAS int* tp) {
    const unsigned* gcnt = (const unsigned*)(c.ws + WS_CTL) + CW_CNT + (layer * NSUB + sub) * 64;
    __syncthreads();
    if (c.tid < 64) { const int n = (int)gcnt[c.tid]; cnt[c.tid] = n; int v = (n + 255) >> 8;
#pragma unroll
        for (int o = 1; o < 64; o <<= 1) { const int t = __shfl_up(v, o); if (c.tid >= o) v += t; }
        tp[c.tid + 1] = v; if (c.tid == 0) tp[0] = 0; }
    __syncthreads();
}
__device__ __forceinline__ void phase_combine(const Ctx& c, int sub, const LAS int* tp, bool last_layer, bool dummy) {
    const float* g2 = inp(c, I_LN2G, (size_t)c.layer * D); const float* b2 = inp(c, I_LN2B, (size_t)c.layer * D);
    const unsigned char* Y = (const unsigned char*)(c.ws + S_Y); const unsigned* PE = (const unsigned*)(c.ws + S_PE); const float* GWp = (const float*)(c.ws + S_GW); bf16_t* xb = (bf16_t*)(c.ws + WS_XB);
    const unsigned char* SF = (const unsigned char*)(c.ws + S_SF);
    const int lane = c.lane;
    f32x4 gg[4], bb[4];
#pragma unroll
    for (int j = 0; j < 4; ++j) { gg[j] = *(const f32x4*)(g2 + 16 * lane + 4 * j); bb[j] = *(const f32x4*)(b2 + 16 * lane + 4 * j); }
    for (int t = sub * TSUB + c.bid * 8 + c.wave; t < (sub + 1) * TSUB; t += c.G * 8) {
        f32x4 v[4]; ld16_bf16(xb + (size_t)t * D, lane, v); const u32x4 sfw = *(const u32x4*)(SF + (size_t)t * D + 16 * lane);
        unsigned pe[8]; float gw[8];
#pragma unroll
        for (int k = 0; k < 8; ++k) { pe[k] = 0; gw[k] = 0.f; }
        { const u32x4 p0 = *(const u32x4*)(PE + (size_t)t * 8), p1 = *(const u32x4*)(PE + (size_t)t * 8 + 4); const f32x4 w0 = *(const f32x4*)(GWp + (size_t)t * 8) * (1.0f / Y_SCALE), w1 = *(const f32x4*)(GWp + (size_t)t * 8 + 4) * (1.0f / Y_SCALE);
          pe[0] = p0.x; pe[1] = p0.y; pe[2] = p0.z; pe[3] = p0.w; pe[4] = p1.x; pe[5] = p1.y; pe[6] = p1.z; pe[7] = p1.w; gw[0] = w0[0]; gw[1] = w0[1]; gw[2] = w0[2]; gw[3] = w0[3]; gw[4] = w1[0]; gw[5] = w1[1]; gw[6] = w1[2]; gw[7] = w1[3]; }
        u32x4 y[8];
#pragma unroll
        for (int k = 0; k < 8; ++k) { const int e = pe[k] >> 20, slot = pe[k] & 0xfffffu; const size_t R = (size_t)tp[e] * 256 + slot; y[k] = *(const u32x4*)(Y + R * D + 16 * lane); }
#pragma unroll
        for (int j = 0; j < 4; ++j) { const unsigned w = j == 0 ? sfw.x : (j == 1 ? sfw.y : (j == 2 ? sfw.z : sfw.w)); const f32x2 lo = __builtin_amdgcn_cvt_pk_f32_fp8((int)w, false), hi = __builtin_amdgcn_cvt_pk_f32_fp8((int)w, true);
            v[j] = v[j] * ALPHA + (f32x4){lo.x, lo.y, hi.x, hi.y} * (1.0f / Y_SCALE); }
#pragma unroll
        for (int k = 0; k < 8; ++k) { const unsigned yw[4] = {y[k].x, y[k].y, y[k].z, y[k].w};
#pragma unroll
            for (int j = 0; j < 4; ++j) { const f32x2 lo = __builtin_amdgcn_cvt_pk_f32_fp8((int)yw[j], false), hi = __builtin_amdgcn_cvt_pk_f32_fp8((int)yw[j], true); v[j] = v[j] + (f32x4){lo.x, lo.y, hi.x, hi.y} * gw[k]; } }
        if (dummy) ln16_store(v, lane, gg, bb, nullptr, (bf16_t*)(c.ws + S_H7 + 876 * MiB) );
        else ln16_store(v, lane, gg, bb, last_layer ? c.out + (size_t)t * D : (float*)nullptr, last_layer ? (bf16_t*)nullptr : xb + (size_t)t * D, last_layer ? (unsigned char*)nullptr : (unsigned char*)(c.ws + WS_XB8) + (size_t)t * D);
    }
}

constexpr int NPH = 21;
__global__ void __launch_bounds__(512, 2) mk_fwd(Args args) {
    extern __shared__ __attribute__((aligned(16))) unsigned char lds_raw[];
    Ctx c0; c0.lds = (lds_t*)lds_raw; c0.tid = threadIdx.x; c0.lane = c0.tid & 63; c0.wave = __builtin_amdgcn_readfirstlane(c0.tid >> 6); c0.G = gridDim.x; c0.bid = blockIdx.x;
    c0.ws = args.ws; c0.out = args.out; c0.layer = 0;
    volatile LAS unsigned* MISC = (volatile LAS unsigned*)(c0.lds + LDS_MISC);
    LAS int* mcnt = (LAS int*)(c0.lds + LDS_MISC + 256); LAS int* mtp = mcnt + 64;
    if (c0.tid < 16) MISC[c0.tid] = 0u;
    if (c0.tid == 0) { LAS unsigned long long* pt = (LAS unsigned long long*)(c0.lds + LDS_PTAB);
#pragma unroll
        for (int i = 0; i < 27; ++i) pt[i] = (unsigned long long)args.in[i]; }
    __syncthreads();
#ifdef X7
    __builtin_amdgcn_fence(__ATOMIC_ACQUIRE, ""); asm volatile("s_waitcnt vmcnt(0)" ::: "memory"); __syncthreads();
#endif
#if MK_ONE_LAUNCH
    XcdBarrier bar = xcd_barrier_post((unsigned*)(c0.ws + WS_CTL) + CW_BAR, MISC + 8);
#define SEAM() xcd_barrier(bar)
#define LSEAM() do { asm volatile("s_waitcnt vmcnt(0)" ::: "memory"); __syncthreads(); if (c0.wave == 0) { __builtin_amdgcn_fence(__ATOMIC_ACQUIRE, "agent"); asm volatile("s_waitcnt vmcnt(0)" ::: "memory"); } __syncthreads(); } while (0)
#else
#define SEAM() do {} while (0)
#define LSEAM() do {} while (0)
#error one launch only
#endif
    const int lo = args.ph_lo, hi = args.ph_hi;
#define IN(k) (lo <= (k) && (k) < hi)
#ifndef PHSEL
#define PHSEL 0xffffffffu
#endif
#define PHS(k) ((PHSEL >> (k)) & 1u)
#ifndef REP_PH
#define REP_PH -1
#define REP_N 0
#endif
#define RP(k) for (int rep_ = 0; rep_ < ((REP_PH == (k)) ? 1 + REP_N : 1); ++rep_)
    for (int l = 0; l < DEPTH; ++l) {
        const int pb = l * NPH;
        c0.layer = l;

        if (PHS(0) && IN(pb + 0)) RP(0) { const Ctx c = fresh(c0); phase_cvt(c); SEAM(); }
        if (PHS(1) && IN(pb + 1)) RP(1) {
            const Ctx c = fresh(c0);
            PanelOrder S{(const char*)(c.ws + WS_XB8), (const char*)(c.ws + W_IN), 14, c.G, c.bid, (size_t)256 * D, (size_t)256 * D};
            EpiIn E{(bf16_t*)(c.ws + S_H7), (const unsigned*)(c.ws + WS_COS), c.lds + LDS_EPI};
            gemm_phase<EpiIn, PanelOrder, false, true>(c.lds, c.tid, D, D, S, E); SEAM(); }
        if (PHS(2) && IN(pb + 2)) RP(2) { { const Ctx c = fresh(c0); phase_mix1(c); LSEAM(); }
            { const Ctx c = fresh(c0);
              OwnOrder S{(const char*)(c.ws + S_BR), (const char*)(c.ws + W_SM), 2, c.G, c.bid, (size_t)256 * 1536 * 2, (size_t)256 * 2, (size_t)65536 * 2, 0};
              EpiPool E{(bf16_t*)(c.ws + S_BR), inp(c, I_POOLS, (size_t)c.layer * 512)};
              gemm_phase<EpiPool, OwnOrder, false>(c.lds, c.tid, 256, 1536 * 2, S, E); }
            { const Ctx c = fresh(c0);
              OwnOrder S{(const char*)(c.ws + S_BR) + 1024 * 2, (const char*)(c.ws + W_SM) + (size_t)2 * 65536 * 2, 4, c.G, c.bid, (size_t)256 * 1536 * 2, (size_t)256 * 2, (size_t)65536 * 2, 1};
              EpiRG E{(const bf16_t*)(c.ws + S_BR), (bf16_t*)(c.ws + S_LA), (bf16_t*)(c.ws + S_BB), inp(c, I_BA, (size_t)c.layer * 512), inp(c, I_BX, (size_t)c.layer * 512), (const float*)(c.ws + W_SM + 768 * 1024)};
              gemm_phase<EpiRG, OwnOrder, false>(c.lds, c.tid, 256, 1536 * 2, S, E); }
            LSEAM(); }
        if (PHS(3) && IN(pb + 3)) RP(3) { const Ctx c = fresh(c0); phase_rgscan(c); SEAM(); }
        if (PHS(4) && IN(pb + 4)) RP(4) { const Ctx c = fresh(c0); phase_scan(c); SEAM(); }
        if (PHS(5) && IN(pb + 5)) RP(5) { const Ctx c = fresh(c0); phase_mix2(c); SEAM(); }
        if (PHS(6) && IN(pb + 6)) RP(6) {
            const Ctx c = fresh(c0);
            PanelOrder S{(const char*)(c.ws + WS_XB8), (const char*)(c.ws + W_IN) + (size_t)HW * D, 12, c.G, c.bid, (size_t)256 * D, (size_t)256 * D};
            EpiGates E{(unsigned char*)(c.ws + S_H7), inp(c, I_GATEB, (size_t)c.layer * 3 * D)};
            gemm_phase<EpiGates, PanelOrder, false, true>(c.lds, c.tid, D, D, S, E); SEAM(); }
#if 1
        if (PHS(7) && IN(pb + 7)) RP(7) {
            const Ctx c = fresh(c0);
            MergeOrder S{(const char*)(c.ws + S_BR), (const char*)(c.ws + W_BR), c.G, c.bid, -1};
            EpiMerge E{(bf16_t*)(c.ws + S_MG), (const unsigned char*)(c.ws + S_H7), (unsigned char*)(c.ws + S_KV + 64 * MiB)};
            gemm_phase<EpiMerge, MergeOrder, false, true>(c.lds, c.tid, 512, 3072, S, E, MX_WG); SEAM(); }
#else
        for (int i = 0; i < 3; ++i) if (PHS(7) && IN(pb + 7 + i)) {
            const Ctx c = fresh(c0);
            MergeOrder S{(const char*)(c.ws + S_BR), (const char*)(c.ws + W_BR), c.G, c.bid, i};
            EpiMerge E{(bf16_t*)(c.ws + S_MG), (const unsigned char*)(c.ws + S_H7), (unsigned char*)(c.ws + S_KV + 64 * MiB)};
            gemm_phase<EpiMerge, MergeOrder, false, true>(c.lds, c.tid, 512, 3072, S, E, MX_WG); if (i == 2) SEAM(); }
#endif
        if (PHS(10) && IN(pb + 10)) RP(10) {
            const Ctx c = fresh(c0);
            PanelOrder S{(const char*)(c.ws + S_KV + 64 * MiB), (const char*)(c.ws + W_OUT), 4, c.G, c.bid, (size_t)256 * D, (size_t)256 * D};
            EpiResB E{rep_ > 0 ? (bf16_t*)(c.ws + S_Y) : (bf16_t*)(c.ws + S_PRE), (const bf16_t*)(c.ws + WS_XB), ALPHA};
            gemm_phase<EpiResB, PanelOrder, false, true>(c.lds, c.tid, D, D, S, E); SEAM(); }
        if (PHS(11) && IN(pb + 11)) RP(11) { const Ctx c = fresh(c0); phase_ln1(c, rep_ > 0); SEAM(); }
        if (PHS(12) && IN(pb + 12)) RP(12) {
            const Ctx c = fresh(c0);
            PanelOrder S{(const char*)(c.ws + WS_XB), (const char*)(c.ws + W_SHUP), 3, c.G, c.bid, (size_t)256 * D * 2, (size_t)256 * D * 2};
            EpiGLU E{(unsigned char*)(c.ws + S_HS), (float*)(c.ws + S_LG), false};
            gemm_phase<EpiGLU, PanelOrder, false>(c.lds, c.tid, D, D * 2, S, E); SEAM(); }
        if (PHS(14) && IN(pb + 13)) RP(14) {
            const Ctx c = fresh(c0);
            PanelOrder S{(const char*)(c.ws + S_HS), (const char*)(c.ws + W_SHDN), 4, c.G, c.bid, (size_t)256 * DEXP, (size_t)256 * DEXP};
            EpiExpDown E{(unsigned char*)(c.ws + S_SF)};
            gemm_phase<EpiExpDown, PanelOrder, false, true>(c.lds, c.tid, DEXP, DEXP, S, E); }
        if (PHS(13) && IN(pb + 14)) RP(13) { const Ctx c = fresh(c0); phase_route(c); SEAM(); }
        for (int s = 0; s < NSUB; ++s) {
            if (PHS(15) && IN(pb + 15 + 3 * s)) RP(15) { const Ctx c = fresh(c0); moe_tables(c, c.layer, s, mcnt, mtp);
                const unsigned* list = (const unsigned*)(c.ws + S_LIST) + (size_t)s * NEXP * TSUB;
                MoeOrder S{(const char*)(c.ws + WS_XB8), (const char*)(c.ws + W_E13), 2, c.G, c.bid, (size_t)512 * D, (size_t)256 * D, 0, mtp, mcnt, list, true, c.lane};
                EpiGLU E{(unsigned char*)(c.ws + S_HE), nullptr, true};
                gemm_phase<EpiGLU, MoeOrder, true, true>(c.lds, c.tid, D, D, S, E); SEAM(); }
            if (PHS(16) && IN(pb + 16 + 3 * s)) RP(16) { const Ctx c = fresh(c0); moe_tables(c, c.layer, s, mcnt, mtp);
                const unsigned* list = (const unsigned*)(c.ws + S_LIST) + (size_t)s * NEXP * TSUB;
                MoeOrder S{(const char*)(c.ws + S_HE), (const char*)(c.ws + W_E2), 4, c.G, c.bid, (size_t)D * DEXP, (size_t)256 * DEXP, (size_t)256 * DEXP, mtp, mcnt, list, false, c.lane};
                EpiExpDown E{(unsigned char*)(c.ws + S_Y)};
                gemm_phase<EpiExpDown, MoeOrder, false, true>(c.lds, c.tid, DEXP, DEXP, S, E); SEAM(); }
            if (PHS(17) && IN(pb + 17 + 3 * s)) RP(17) { const Ctx c = fresh(c0); moe_tables(c, c.layer, s, mcnt, mtp); phase_combine(c, s, mtp, c.layer == DEPTH - 1, rep_ > 0); }
        }
    }
#undef IN
#ifdef X7
    asm volatile("s_waitcnt vmcnt(0)" ::: "memory"); __syncthreads(); __builtin_amdgcn_fence(__ATOMIC_RELEASE, "agent"); asm volatile("s_waitcnt vmcnt(0)" ::: "memory");
#endif
}

extern "C" void kernel_launch(void* const* d_in, const int* in_sizes, int n_in, void* d_out, int out_size, void* d_ws, size_t ws_size, hipStream_t stream) {
    static int grid = 0;
    if (grid == 0) {
        if (n_in != 27 || ws_size < WS_END) { fprintf(stderr, "kernel_launch: n_in %d ws %zu (need %zu)\n", n_in, ws_size, (size_t)WS_END); grid = -1; return; }
        if (hipFuncSetAttribute((const void*)mk_fwd, hipFuncAttributeMaxDynamicSharedMemorySize, LDS_BYTES) != hipSuccess) { fprintf(stderr, "kernel_launch: hipFuncSetAttribute failed\n"); grid = -1; return; }
        int dev = 0, cus = 0, per_cu = 0;
        hipGetDevice(&dev); hipDeviceGetAttribute(&cus, hipDeviceAttributeMultiprocessorCount, dev);
        hipOccupancyMaxActiveBlocksPerMultiprocessor(&per_cu, (const void*)mk_fwd, 512, LDS_BYTES);
        (void)hipGetLastError();
        grid = cus > 0 ? cus : 256; if (grid > 256) grid = 256;
        fprintf(stderr, "kernel_launch: grid %d (occupancy query %d per CU)\n", grid, per_cu);
    }
    if (grid < 0) return;
    hipMemsetAsync((char*)d_ws + WS_CTL, 0, 1 * MiB, stream);
    Args a{};
    for (int i = 0; i < 27; ++i) a.in[i] = d_in[i];
    a.out = (float*)d_out; a.ws = (unsigned char*)d_ws;
#if MK_ONE_LAUNCH
#ifndef MAXPH
#define MAXPH (DEPTH * NPH)
#endif
    a.ph_lo = 0; a.ph_hi = MAXPH;
    hipLaunchKernelGGL(mk_fwd, dim3(grid), dim3(512), LDS_BYTES, stream, a);
#else
#ifndef MAXPH
#define MAXPH (DEPTH * NPH)
#endif
    for (int ph = 0; ph < MAXPH; ++ph) { a.ph_lo = ph; a.ph_hi = ph + 1; hipLaunchKernelGGL(mk_fwd, dim3(grid), dim3(512), LDS_BYTES, stream, a); }
#endif
}
```

```cpp
#include <hip/hip_runtime.h>
#include <cstdio>
#include <cstdint>

#ifndef MK_ONE_LAUNCH
#define MK_ONE_LAUNCH 1
#endif
#ifndef SIMPLE_GEMM
#define SIMPLE_GEMM 0
#endif

#define LAS __attribute__((address_space(3)))
#define GAS __attribute__((address_space(1)))
typedef unsigned short bf16_t;
typedef short bf16x8 __attribute__((ext_vector_type(8)));
typedef unsigned short u16x4 __attribute__((ext_vector_type(4)));
typedef float f32x4 __attribute__((ext_vector_type(4)));
typedef float f32x2 __attribute__((ext_vector_type(2)));
typedef unsigned u32x4 __attribute__((ext_vector_type(4)));
typedef unsigned u32x2 __attribute__((ext_vector_type(2)));
typedef LAS unsigned char lds_t;

constexpr int T = 65536, D = 1024, SEQ = 4096, NBATCH = 16, DEPTH = 4;
constexpr int NPANEL = 256;
constexpr int HW = 3584;
constexpr int INW = 6656;
constexpr int NEXP = 64, DEXP = 256;
constexpr int NSUB = 1, TSUB = T / NSUB, PSUB = NPANEL / NSUB;
constexpr int ROWS_MAX = TSUB * 8 + NEXP * 256;
constexpr float ALPHA = 1.681792830507429f;
constexpr float LN_EPS = 1e-5f, GN_EPS = 1e-6f;

constexpr size_t MiB = 1u << 20;
constexpr size_t WS_CTL = 0;
constexpr size_t WS_COS = 1 * MiB, WS_SIN = 2 * MiB;
constexpr size_t WS_W = 3 * MiB;
constexpr size_t W_IN = WS_W, W_BR = WS_W + 7 * MiB, W_OUT = WS_W + 10 * MiB, W_SM = WS_W + 12 * MiB;
constexpr size_t W_SHUP = WS_W + 13 * MiB, W_SHDN = W_SHUP + 3 * MiB / 2, W_E13 = WS_W + 15 * MiB, W_E2 = WS_W + 47 * MiB;
constexpr size_t WS_XB = 82 * MiB;
constexpr size_t WS_XB8 = 210 * MiB;
constexpr size_t WS_S = 274 * MiB;
constexpr size_t S_H7 = WS_S, S_KV = WS_S + 448 * MiB, S_BR = WS_S + 576 * MiB, S_MG = WS_S + 768 * MiB, S_RGC = WS_S + 896 * MiB;
constexpr size_t S_LA = S_MG, S_BB = S_MG + 64 * MiB;
constexpr size_t S_PE = WS_S, S_GW = WS_S + 2 * MiB, S_LIST = WS_S + 4 * MiB, S_SF = WS_S + 20 * MiB;
constexpr size_t S_HE = WS_S + 84 * MiB, S_Y = WS_S + 348 * MiB;
constexpr size_t S_HS = S_HE, S_LG = S_HE + 32 * MiB;
constexpr size_t S_PRE = S_H7;
constexpr size_t WS_END = WS_S + 899 * MiB;
static_assert(S_HE + (size_t)ROWS_MAX * 512 <= S_Y && S_Y + (size_t)ROWS_MAX * 1024 <= WS_END && S_SF + (size_t)T * D <= S_HE, "moe scratch");
constexpr int CW_BAR = 4096;
constexpr int CW_CNT = 16384;

constexpr int LDS_STAGE = 131072;
constexpr int LDS_MISC = 143360;
constexpr int LDS_IDX = 143360 + 1536;
constexpr int LDS_EPI = 147456;
constexpr int LDS_BYTES = 163840;

__device__ __forceinline__ unsigned f2bf(float f) { unsigned u = __builtin_bit_cast(unsigned, f); return (u + 0x7fffu + ((u >> 16) & 1u)) >> 16; }
typedef __bf16 bf16x2_t __attribute__((ext_vector_type(2)));
__device__ __forceinline__ unsigned pk2(float lo, float hi) { const bf16x2_t v = __builtin_convertvector((f32x2){lo, hi}, bf16x2_t); return __builtin_bit_cast(unsigned, v); }
__device__ __forceinline__ float bf2f(unsigned short b) { return __builtin_bit_cast(float, (unsigned)b << 16); }
__device__ __forceinline__ float bflo(unsigned w) { return __builtin_bit_cast(float, w << 16); }
__device__ __forceinline__ float bfhi(unsigned w) { return __builtin_bit_cast(float, w & 0xffff0000u); }
__device__ __forceinline__ float sigmoidf_(float x) { return __builtin_amdgcn_rcpf(1.0f + __expf(-x)); }
__device__ __forceinline__ float siluf_(float x) { return x * __builtin_amdgcn_rcpf(1.0f + __expf(-x)); }
__device__ __forceinline__ float gelu_tanh(float x) { const float u = 0.7978845608028654f * (x + 0.044715f * x * x * x); return x * __builtin_amdgcn_rcpf(1.0f + __expf(-2.0f * u)); }
__device__ __forceinline__ float wave_sum(float v) {
#pragma unroll
    for (int o = 1; o < 64; o <<= 1) v += __shfl_xor(v, o);
    return v;
}
#define LDS_WAIT() asm volatile("s_waitcnt lgkmcnt(0)" ::: "memory")
#define VM_WAIT() asm volatile("s_waitcnt vmcnt(0)" ::: "memory")

typedef int i32x8 __attribute__((ext_vector_type(8)));
typedef int i32x4 __attribute__((ext_vector_type(4)));
constexpr float W8_SCALE = 32.0f;
constexpr int MX_ONE = 0x7f7f7f7f, MX_W = 0x7a7a7a7a, MX_WG = 0x72727272;
__device__ __forceinline__ unsigned pk4_fp8s(float a, float b, float c2, float d, float s) { int w = 0; w = __builtin_amdgcn_cvt_pk_fp8_f32(a * s, b * s, w, false); w = __builtin_amdgcn_cvt_pk_fp8_f32(c2 * s, d * s, w, true); return (unsigned)w; }
__device__ __forceinline__ f32x4 mfma16(bf16x8 a, bf16x8 b, f32x4 c) { return __builtin_amdgcn_mfma_f32_16x16x32_bf16(a, b, c, 0, 0, 0); }
__device__ __forceinline__ bf16x8 frag_row(const lds_t* X, int pitchB, int r0, int k0, int fr, int fq) {
    return *(const LAS bf16x8*)(X + (r0 + fr) * pitchB + (k0 + 8 * fq) * 2);
}
__device__ __forceinline__ bf16x8 frag_col(const lds_t* X, int pitchB, int k0, int c0, int fr, int fq) {
    const int q = fr >> 2, p = fr & 3;
    const unsigned a0 = (unsigned)(size_t)X + (unsigned)((k0 + 8 * fq + q) * pitchB + (c0 + 4 * p) * 2);
    u16x4 lo, hi;
    asm volatile("ds_read_b64_tr_b16 %0, %2\n\tds_read_b64_tr_b16 %1, %3\n\ts_waitcnt lgkmcnt(0)" : "=&v"(lo), "=&v"(hi) : "v"(a0), "v"(a0 + 4u * (unsigned)pitchB) : "memory");
    bf16x8 r; r[0] = (short)lo[0]; r[1] = (short)lo[1]; r[2] = (short)lo[2]; r[3] = (short)lo[3]; r[4] = (short)hi[0]; r[5] = (short)hi[1]; r[6] = (short)hi[2]; r[7] = (short)hi[3];
    return r;
}

#define XB_TMO      128
#define XB_XCNT(j)  (256  + 64 * (j))
#define XB_XSUB(j)  (1280 + 64 * (j))
#define XB_XGEN(j)  (2304 + 64 * (j))
#define XB_TOP      3328
#define XB_TOPGEN   3392
#define XCD_BAR_WORDS 3456
#define XB_SPIN_CAP (1u << 20)
__device__ __forceinline__ unsigned xb_ld(unsigned* p)              { return __hip_atomic_load(p, __ATOMIC_RELAXED, __HIP_MEMORY_SCOPE_AGENT); }
__device__ __forceinline__ unsigned xb_add(unsigned* p, unsigned v) { return __hip_atomic_fetch_add(p, v, __ATOMIC_RELAXED, __HIP_MEMORY_SCOPE_AGENT); }
__device__ __forceinline__ unsigned xb_xcc_id() { return (unsigned)__builtin_amdgcn_s_getreg((3 << 11) | 20) & 0xFu; }
#define XB_SPIN(cond, bar) do { unsigned _sp = 0; while (cond) { __builtin_amdgcn_s_sleep(1); \
    if ((++_sp & 255u) == 0u) { if (xb_ld(&(bar)[XB_TMO])) break; if (_sp > XB_SPIN_CAP) { atomicAdd(&(bar)[XB_TMO], 1u); break; } } } } while (0)
struct XcdBarrier { unsigned* bar; unsigned x; volatile LAS unsigned* st; };
__device__ __forceinline__ XcdBarrier xcd_barrier_post(unsigned* bar, volatile LAS unsigned* st) {
    XcdBarrier b; b.bar = bar; b.x = xb_xcc_id(); b.st = st;
    if (threadIdx.x == 0) (void)xb_add(&bar[XB_XCNT(b.x)], 1u);
    return b;
}
__device__ __forceinline__ void xcd_barrier_complete(unsigned* bar, unsigned x, unsigned& nloc, unsigned& nx) {
    const unsigned G = gridDim.x * gridDim.y * gridDim.z;
    unsigned sum, cnt, mine, sp = 0u;
    for (;;) {
        sum = 0u; cnt = 0u; mine = 0u;
#pragma unroll
        for (unsigned j = 0; j < 16; ++j) { const unsigned c = xb_ld(&bar[XB_XCNT(j)]); sum += c; cnt += (c > 0u) ? 1u : 0u; mine = (j == x) ? c : mine; }
        if (sum == G) break;
        __builtin_amdgcn_s_sleep(1);
        if ((++sp & 255u) == 0u) { if (xb_ld(&bar[XB_TMO])) break; if (sp > XB_SPIN_CAP) { atomicAdd(&bar[XB_TMO], 1u); break; } }
    }
    nloc = mine > 0u ? mine : 1u; nx = cnt > 0u ? cnt : 1u;
}
__device__ __forceinline__ void xcd_barrier(const XcdBarrier& b) {
    asm volatile("s_waitcnt vmcnt(0)" ::: "memory");
    __syncthreads();
    if (threadIdx.x == 0) {
        unsigned* bar = b.bar;
        __builtin_amdgcn_s_waitcnt(0);
        unsigned nloc = b.st[0], nx = b.st[1];
        if (nloc == 0u) { xcd_barrier_complete(bar, b.x, nloc, nx); b.st[0] = nloc; b.st[1] = nx; }
        const unsigned old = xb_add(&bar[XB_XSUB(b.x)], 1u);
        const unsigned gen = old / nloc;
        if (old + 1u == (gen + 1u) * nloc) {
            __builtin_amdgcn_fence(__ATOMIC_RELEASE, "agent");
            asm volatile("s_waitcnt vmcnt(0)" ::: "memory");
            const unsigned og = xb_add(&bar[XB_TOP], 1u);
            const unsigned tg = og / nx;
            if (og + 1u == (tg + 1u) * nx) xb_add(&bar[XB_TOPGEN], 1u);
            else XB_SPIN(xb_ld(&bar[XB_TOPGEN]) == tg, bar);
            __builtin_amdgcn_fence(__ATOMIC_ACQUIRE, "agent");
            xb_add(&bar[XB_XGEN(b.x)], 1u);
            asm volatile("s_waitcnt vmcnt(0)" ::: "memory");
        } else {
            XB_SPIN(xb_ld(&bar[XB_XGEN(b.x)]) == gen, bar);
            __builtin_amdgcn_fence(__ATOMIC_ACQUIRE, "agent");
            asm volatile("s_waitcnt vmcnt(0)" ::: "memory");
        }
    }
    __syncthreads();
}

struct GUnit { const char* A; const char* B; int x, y, z, w; };

constexpr int BK = 64, HALF = 128, HTB = HALF * BK * 2;
__host__ __device__ __forceinline__ int lds_byte(int r, int c) { const int st = (r >> 4) * 2 + (c >> 5), rr = r & 15, cc = c & 31, ob = rr * 64 + cc * 2; return st * 1024 + (ob ^ (((ob >> 9) & 1) << 5)); }
__host__ __device__ __forceinline__ int perm32(int rho) { const int n = rho >> 4, i = rho & 15; return 8 * (i >> 2) + 4 * n + (i & 3); }
__host__ __device__ __forceinline__ void stage_rc(int b, int& R, int& C) { const int st = b / 1024, sb = b % 1024, swz = sb ^ (((sb >> 9) & 1) << 5); R = (st >> 1) * 16 + swz / 64; C = (st & 1) * 32 + (swz % 64) / 2; }

#if SIMPLE_GEMM
template <class Epi, class Sched, bool GATHER, bool F8 = false>
__device__ __forceinline__ void gemm_phase(lds_t* lds, const int tid, const int K, const unsigned ldaB, const Sched& S, const Epi& E) {
    const int wid = __builtin_amdgcn_readfirstlane(tid >> 6), lane = tid & 63, wr = wid >> 2, wc = wid & 3, fr = lane & 15, fq = lane >> 4;
    GUnit cur;
    for (int ui = 0; S.next(ui, cur); ++ui) {
        f32x4 acc[2][2][4][2];
#pragma unroll
        for (int a = 0; a < 2; ++a)
#pragma unroll
            for (int b = 0; b < 2; ++b)
#pragma unroll
                for (int m = 0; m < 4; ++m)
#pragma unroll
                    for (int n = 0; n < 2; ++n) acc[a][b][m][n] = (f32x4){0.f, 0.f, 0.f, 0.f};
        unsigned ao[2][4], bo[2][2];
#pragma unroll
        for (int ai = 0; ai < 2; ++ai)
#pragma unroll
            for (int m = 0; m < 4; ++m) { const int r = ai * HALF + wr * 64 + m * 16 + fr; const unsigned ro = GATHER ? (unsigned)S.gather_row(cur, r) : (unsigned)r; ao[ai][m] = ro * ldaB + fq * 16; }
#pragma unroll
        for (int bj = 0; bj < 2; ++bj)
#pragma unroll
            for (int n = 0; n < 2; ++n) { const int r = bj * HALF + wc * 32 + n * 16 + fr; bo[bj][n] = (unsigned)(r * K * 2 + fq * 16); }
#pragma unroll 1
        for (int k0 = 0; k0 < K; k0 += 32) {
            bf16x8 af[2][4], bfr[2][2];
#pragma unroll
            for (int ai = 0; ai < 2; ++ai)
#pragma unroll
                for (int m = 0; m < 4; ++m) af[ai][m] = *(const bf16x8*)(cur.A + ao[ai][m] + k0 * 2);
#pragma unroll
            for (int bj = 0; bj < 2; ++bj)
#pragma unroll
                for (int n = 0; n < 2; ++n) bfr[bj][n] = *(const bf16x8*)(cur.B + bo[bj][n] + k0 * 2);
#pragma unroll
            for (int ai = 0; ai < 2; ++ai)
#pragma unroll
                for (int bj = 0; bj < 2; ++bj)
#pragma unroll
                    for (int m = 0; m < 4; ++m)
#pragma unroll
                        for (int n = 0; n < 2; ++n) acc[ai][bj][m][n] = mfma16(bfr[bj][n], af[ai][m], acc[ai][bj][m][n]);
        }
        E(acc, cur, wr, wc, fr, fq);
    }
}
#else
template <class Epi, class Sched, bool GATHER, bool F8 = false>
__device__ __forceinline__ void gemm_phase(lds_t* lds, const int tid, const int K, const unsigned ldaB, const Sched& S, const Epi& E, const int mxw = MX_W) {
    const int wid = __builtin_amdgcn_readfirstlane(tid >> 6), lane = tid & 63, wr = wid >> 2, wc = wid & 3, fr = lane & 15, fq = lane >> 4;
    const int KB = F8 ? K : K * 2;
    const int nt = KB / 128;
    unsigned voffB[2], voffA[2][2];
#pragma unroll
    for (int i = 0; i < 2; ++i) { int sR, sC; stage_rc(tid * 16 + i * 8192, sR, sC); int Rb;
        if (Epi::PERM == 2) { const int rho = sR & 31; Rb = 64 * (sR >> 5) + 16 * ((rho & 15) >> 2) + 4 * (rho >> 4) + (rho & 3); }
        else Rb = (Epi::PERM == 1 ? ((sR & ~31) + perm32(sR & 31)) : sR);
        voffB[i] = (unsigned)(Rb * KB + sC * 2); }
    const size_t kstep = (size_t)(BK * 2);
    const size_t hstepB = (size_t)(Epi::PERM == 2 ? 8 : HALF) * KB;
    const size_t hstepA = (size_t)HALF * ldaB;
    const unsigned ldsw = (unsigned)wid * 1024u;
    const int aoff = lds_byte(wr * 64 + fr, fq * 8), boff = lds_byte(wc * 32 + fr, fq * 8);
    constexpr int koffA = 1024, koffB = 1024;
#define PG8_SA(b, h) (((b) * 2 + (h)) * HTB)
#define PG8_SB(b, h) ((4 + (b) * 2 + (h)) * HTB)
#define PG8_STAGE(bufoff, gbase, voff) do { _Pragma("unroll") for (int _i = 0; _i < 2; ++_i) { unsigned _v = (voff)[_i]; asm volatile("" : "+v"(_v));   \
        __builtin_amdgcn_global_load_lds((const unsigned*)((const char*)(gbase) + _v), (LAS unsigned*)(lds + (bufoff) + ldsw + _i * 8192), 16, 0, 0); } } while (0)
#define PG8_STAGEB(b, h, gbase) PG8_STAGE(PG8_SB(b, h), (gbase) + (h) * hstepB, voffB)
#define PG8_STAGEA(b, h, gbase, vo) do { if (GATHER) { PG8_STAGE(PG8_SA(b, h), gbase, (vo)[h]); } else { PG8_STAGE(PG8_SA(b, h), (gbase) + (h) * hstepA, voffA[0]); } } while (0)
#define PG8_STAGEA1(b, gbase) do { if (GATHER) { PG8_STAGE(PG8_SA(b, 1), gbase, va1); } else { PG8_STAGE(PG8_SA(b, 1), (gbase) + hstepA, voffA[0]); } } while (0)
#define PG8_RD16(off) (*(const LAS i32x4*)(lds + (off)))
#define PG8_LDA(dst, b, h) do { _Pragma("unroll") for (int m = 0; m < 4; ++m) { if (F8) { const i32x4 _l = PG8_RD16(PG8_SA(b, h) + aoff + m * 2048), _h = PG8_RD16(PG8_SA(b, h) + aoff + m * 2048 + koffA); dst##8[m] = __builtin_shufflevector(_l, _h, 0, 1, 2, 3, 4, 5, 6, 7); } \
        else { _Pragma("unroll") for (int k = 0; k < 2; ++k) dst[m][k] = *(const LAS bf16x8*)(lds + PG8_SA(b, h) + aoff + m * 2048 + k * 1024); } } } while (0)
#define PG8_LDB(dst, b, h) do { _Pragma("unroll") for (int n = 0; n < 2; ++n) { if (F8) { const i32x4 _l = PG8_RD16(PG8_SB(b, h) + boff + n * 2048), _h = PG8_RD16(PG8_SB(b, h) + boff + n * 2048 + koffB); dst##8[n] = __builtin_shufflevector(_l, _h, 0, 1, 2, 3, 4, 5, 6, 7); } \
        else { _Pragma("unroll") for (int k = 0; k < 2; ++k) dst[n][k] = *(const LAS bf16x8*)(lds + PG8_SB(b, h) + boff + n * 2048 + k * 1024); } } } while (0)
#define PG8_MMA(ai, bj, At, Bt) do { __builtin_amdgcn_s_setprio(1); _Pragma("unroll") for (int m = 0; m < 4; ++m) _Pragma("unroll") for (int n = 0; n < 2; ++n) { \
        if (F8) asm volatile("v_mfma_scale_f32_16x16x128_f8f6f4 %0, %1, %2, %0, %3, %4 op_sel_hi:[0,0,0]" : "+v"(acc[ai][bj][m][n]) : "v"(Bt##8[n]), "v"(At##8[m]), "v"(sc_w), "v"(sc_x)); \
        else { _Pragma("unroll") for (int k = 0; k < 2; ++k) acc[ai][bj][m][n] = __builtin_amdgcn_mfma_f32_16x16x32_bf16(Bt[n][k], At[m][k], acc[ai][bj][m][n], 0, 0, 0); } } \
        __builtin_amdgcn_s_setprio(0); } while (0)
#define PG8_WAIT_V(n) asm volatile("s_waitcnt vmcnt(" #n ")" ::: "memory")
#define PG8_WAIT_V8R do { if (Epi::NST > 0 && relax) asm volatile("s_waitcnt vmcnt(%0)" :: "n"(8 + Epi::NST) : "memory"); else PG8_WAIT_V(8); } while (0)
#define PG8_WAIT_L(n) asm volatile("s_waitcnt lgkmcnt(" #n ")" ::: "memory")
#define PG8_BAR __builtin_amdgcn_s_barrier()
#define PG8_SCHED __builtin_amdgcn_sched_barrier(0)
#define PG8_AOFFS(dst, U) do { int _tz = tid; asm volatile("" : "+v"(_tz)); _Pragma("unroll") for (int _h = 0; _h < 2; ++_h) _Pragma("unroll") for (int _i = 0; _i < 2; ++_i) { int _R, _C; stage_rc(_tz * 16 + _i * 8192, _R, _C); \
        const unsigned _row = GATHER ? (unsigned)S.gather_row(U, _h * HALF + _R) : (unsigned)(_h * HALF + _R); dst[_h][_i] = _row * ldaB + (unsigned)_C * 2u; } } while (0)
    GUnit cur, nxt; int ui = 0;
    if (!S.next(0, cur)) return;
    f32x4 acc[2][2][4][2];
#pragma unroll
    for (int a = 0; a < 2; ++a)
#pragma unroll
        for (int b = 0; b < 2; ++b)
#pragma unroll
            for (int m = 0; m < 4; ++m)
#pragma unroll
                for (int n = 0; n < 2; ++n) acc[a][b][m][n] = (f32x4){0.f, 0.f, 0.f, 0.f};
    int sc_w = mxw, sc_x = MX_ONE; asm volatile("" : "+v"(sc_w), "+v"(sc_x));
    bf16x8 At[4][2], B0[2][2], B1[2][2]; i32x8 At8[4], B08[2], B18[2];
    const char* cA = cur.A; const char* cB = cur.B;
    PG8_AOFFS(voffA, cur);
    PG8_STAGEB(0, 0, cB); PG8_STAGEB(0, 1, cB); PG8_STAGEA(0, 0, cA, voffA); PG8_STAGEA(0, 1, cA, voffA);
    if (wr == 1) PG8_BAR;
    PG8_WAIT_V(2); PG8_BAR;
    PG8_STAGEB(1, 0, cB + kstep); PG8_STAGEA(1, 0, cA + kstep, voffA); PG8_STAGEB(1, 1, cB + kstep);
    PG8_WAIT_V(6); PG8_BAR;
    for (;;) {
        const bool has_next = S.next(ui + 1, nxt);
        const char* nA = has_next ? nxt.A : cA; const char* nB = has_next ? nxt.B : cB;
        if (has_next && GATHER) {
            if (wid < 4) __builtin_amdgcn_global_load_lds(S.idx_ptr(nxt, (wid & 3) * 64 + lane), (LAS unsigned*)(lds + LDS_IDX + ((ui + 1) & 1) * 1024 + (wid & 3) * 256), 4, 0, 0);
        }
#pragma unroll 1
        for (int t = 0; t < nt; t += 2) {
            const bool last = (t == nt - 2);
            const bool relax = (t == 0) && (ui > 0);
            const char* a1 = cA + (size_t)(t + 1) * kstep;
            const char* a2 = last ? nA : cA + (size_t)(t + 2) * kstep; const char* b2 = last ? nB : cB + (size_t)(t + 2) * kstep;
            const char* a3 = a2 + kstep; const char* b3 = b2 + kstep;
            unsigned va1[2] = {voffA[1][0], voffA[1][1]};
            if (GATHER && last && has_next) {
                int _tz = tid; asm volatile("" : "+v"(_tz));
#pragma unroll
                for (int _h = 0; _h < 2; ++_h)
#pragma unroll
                    for (int _i = 0; _i < 2; ++_i) { int _R, _C; stage_rc(_tz * 16 + _i * 8192, _R, _C);
                        const unsigned _a = *(const LAS unsigned*)(lds + LDS_IDX + ((ui + 1) & 1) * 1024 + (_h * HALF + _R) * 4); voffA[_h][_i] = (_a >> 3) * ldaB + (unsigned)_C * 2u; } }
            PG8_LDB(B0, 0, 0); PG8_LDB(B1, 0, 1); PG8_SCHED; PG8_LDA(At, 0, 0); PG8_STAGEA1(1, a1);
            PG8_WAIT_V8R; PG8_WAIT_L(0); PG8_BAR; PG8_MMA(0, 0, At, B0); PG8_MMA(0, 1, At, B1); PG8_BAR; PG8_SCHED;
            PG8_LDA(At, 0, 1); PG8_STAGEB(0, 0, b2); PG8_STAGEB(0, 1, b2); PG8_STAGEA(0, 0, a2, voffA);
            PG8_WAIT_V8R; PG8_WAIT_L(0); PG8_BAR; PG8_MMA(1, 0, At, B0); PG8_MMA(1, 1, At, B1); PG8_BAR; PG8_SCHED;
            PG8_LDB(B0, 1, 0); PG8_LDB(B1, 1, 1); PG8_SCHED; PG8_LDA(At, 1, 0); PG8_STAGEA(0, 1, a2, voffA);
            PG8_WAIT_V(8); PG8_WAIT_L(0); PG8_BAR; PG8_MMA(0, 0, At, B0); PG8_MMA(0, 1, At, B1); PG8_BAR; PG8_SCHED;
            PG8_LDA(At, 1, 1); PG8_STAGEB(1, 0, b3); PG8_STAGEB(1, 1, b3); PG8_STAGEA(1, 0, a3, voffA);
            PG8_WAIT_V(8); PG8_WAIT_L(0); PG8_BAR; PG8_MMA(1, 0, At, B0); PG8_MMA(1, 1, At, B1); PG8_BAR; PG8_SCHED;
        }
        if (wr == 0) PG8_BAR;
        if (F8) asm volatile("s_nop 15\n\ts_nop 15" ::: "memory");
        E(acc, cur, wr, wc, fr, fq);
        if (!has_next) break;
#pragma unroll
        for (int a = 0; a < 2; ++a)
#pragma unroll
            for (int b = 0; b < 2; ++b)
#pragma unroll
                for (int m = 0; m < 4; ++m)
#pragma unroll
                    for (int n = 0; n < 2; ++n) acc[a][b][m][n] = (f32x4){0.f, 0.f, 0.f, 0.f};
        cur = nxt; cA = nA; cB = nB; ++ui;
        if (wr == 1) PG8_BAR;
    }
    PG8_WAIT_V(0);
    PG8_BAR;
#undef PG8_SA
#undef PG8_SB
#undef PG8_STAGE
#undef PG8_LDA
#undef PG8_STAGEB
#undef PG8_STAGEA
#undef PG8_LDB
#undef PG8_MMA
#undef PG8_WAIT_V
#undef PG8_WAIT_L
#undef PG8_BAR
#undef PG8_SCHED
#undef PG8_AOFFS
}
#endif

struct Args { const void* in[27]; float* out; unsigned char* ws; int ph_lo, ph_hi; };
struct Ctx {
    lds_t* lds; int tid, lane, wave; int G, bid, layer;
    unsigned char* ws; float* out;
};
enum { I_X = 0, I_POS = 1, I_WIN = 2, I_GATEB = 3, I_WBR = 4, I_WOUT = 5, I_POOLW = 6, I_POOLS = 7, I_CONVW = 8, I_CONVB = 9, I_WA = 10, I_BA = 11, I_WX = 12, I_BX = 13, I_LAM = 14,
       I_LN1G = 15, I_LN1B = 16, I_RW = 17, I_RB = 18, I_EW1 = 19, I_EW3 = 20, I_EW2 = 21, I_SW1 = 22, I_SW3 = 23, I_SW2 = 24, I_LN2G = 25, I_LN2B = 26 };
constexpr int LDS_PTAB = 143360 + 1024;
__device__ __forceinline__ const float* inp(const Ctx& c, int idx, size_t off) {
    const unsigned long long v = ((const LAS unsigned long long*)(c.lds + LDS_PTAB))[idx];
    const unsigned lo = __builtin_amdgcn_readfirstlane((unsigned)v), hi = __builtin_amdgcn_readfirstlane((unsigned)(v >> 32));
    return (const float*)(const GAS float*)(((unsigned long long)hi << 32) | lo) + off;
}
__device__ __forceinline__ Ctx fresh(const Ctx& c0) {
    Ctx c = c0; int t = c0.tid; asm volatile("" : "+v"(t));
    int g = c0.G, b = c0.bid, l = c0.layer; asm volatile("" : "+s"(g), "+s"(b), "+s"(l));
    unsigned long long w = (unsigned long long)c0.ws, o = (unsigned long long)c0.out; unsigned ld = (unsigned)(size_t)c0.lds; asm volatile("" : "+s"(w), "+s"(o), "+s"(ld));
    c.tid = t; c.lane = t & 63; c.wave = __builtin_amdgcn_readfirstlane(t >> 6); c.G = g; c.bid = b; c.layer = l;
    c.ws = (unsigned char*)(GAS unsigned char*)w; c.out = (float*)(GAS float*)o; c.lds = (lds_t*)ld; return c;
}

struct PanelOrder {
    const char* A; const char* B; int NT, G, bid; size_t a_panel_bytes, b_tile_bytes;
    __device__ __forceinline__ bool next(int i, GUnit& u) const {
        const int L = i * G + bid; if (L >= NPANEL * NT) return false;
        const int wgid = (L & 7) * (NPANEL / 8 * NT) + (L >> 3); const int nig = 8 * NT, gid = wgid / nig, rem = wgid - gid * nig;
        const int p = gid * 8 + (rem & 7), pn = rem >> 3;
        u.A = A + (size_t)p * a_panel_bytes; u.B = B + (size_t)pn * b_tile_bytes; u.x = p; u.y = pn; u.z = 0; u.w = 0; return true;
    }
    __device__ __forceinline__ int gather_row(const GUnit&, int r) const { return r; }
    __device__ __forceinline__ const unsigned* idx_ptr(const GUnit&, int) const { return nullptr; }
};
struct OwnOrder {
    const char* A; const char* B; int NT, G, bid; size_t a_panel_bytes, a_tile_bytes, b_tile_bytes; int a_pair;
    __device__ __forceinline__ bool next(int i, GUnit& u) const {
        const int pi = i / NT, pn = i - pi * NT; const int p = bid + pi * G; if (p >= NPANEL) return false;
        u.A = A + (size_t)p * a_panel_bytes + (size_t)(a_pair ? (pn >> 1) : pn) * a_tile_bytes; u.B = B + (size_t)pn * b_tile_bytes; u.x = p; u.y = pn; u.z = 0; u.w = 0; return true;
    }
    __device__ __forceinline__ int gather_row(const GUnit&, int r) const { return r; }
    __device__ __forceinline__ const unsigned* idx_ptr(const GUnit&, int) const { return nullptr; }
};
struct MergeOrder {
    const char* A; const char* B; int G, bid, fixed_pass;
    __device__ __forceinline__ bool next(int i, GUnit& u) const {
        const int it = fixed_pass < 0 ? i / 3 : i, pass = fixed_pass < 0 ? i - it * 3 : fixed_pass; const int L = it * G + bid; if (L >= NPANEL * 4) return false;
        const int wgid = (L & 7) * (NPANEL / 8 * 4) + (L >> 3); const int gid = wgid >> 5, rem = wgid & 31; const int p = gid * 8 + (rem & 7), pn = rem >> 3;
        u.A = A + (size_t)p * (256 * 3072) + (pass == 0 ? 0 : (pass == 1 ? 1024 : 1536)); u.B = B + (size_t)pass * (D * 512) + (size_t)pn * (256 * 512); u.x = p; u.y = pn; u.z = pass; u.w = 0; return true;
    }
    __device__ __forceinline__ int gather_row(const GUnit&, int r) const { return r; }
    __device__ __forceinline__ const unsigned* idx_ptr(const GUnit&, int) const { return nullptr; }
};
struct MoeOrder {
    const char* A; const char* B; int NT, G, bid; size_t b_exp_bytes, b_tile_bytes, a_tile_bytes; const LAS int* tp; const LAS int* cnt; const unsigned* list; bool gather; int lane;
    __device__ __forceinline__ bool next(int i, GUnit& u) const {
#if 1
        const int lu = (bid >> 3) + (G >> 3) * i; const int tq = lu / NT, pn = lu - tq * NT; const int ti = tq * 8 + (bid & 7); const int ntile = tp[64]; if (ti >= ntile) return false;
#else
        const int g = bid + i * G; const int ti = g / NT, pn = g - ti * NT; const int ntile = tp[64]; if (ti >= ntile) return false;
#endif
        const unsigned long long m = __ballot(tp[lane + 1] > ti);
        const int e = __builtin_amdgcn_readfirstlane((int)__builtin_ctzll(m));
        const int tl = ti - tp[e];
        u.A = gather ? A : A + (size_t)ti * a_tile_bytes; u.B = B + (size_t)e * b_exp_bytes + (size_t)pn * b_tile_bytes; u.x = ti; u.y = pn; u.z = e; u.w = tl; return true;
    }
    __device__ __forceinline__ const unsigned* idx_ptr(const GUnit& u, int r) const { const int c = cnt[u.z]; int j = u.w * 256 + r; j = j < c ? j : c - 1; return list + (size_t)u.z * TSUB + j; }
    __device__ __forceinline__ int gather_row(const GUnit& u, int r) const {
        const int c = cnt[u.z]; int j = u.w * 256 + r; j = j < c ? j : c - 1;
#ifdef X6
        return r;
#endif
        return (int)(list[(size_t)u.z * TSUB + j] >> 3);
    }
};

__device__ __forceinline__ void stage_store16(lds_t* lw, unsigned char* gbase, size_t pitchB, int lane, u32x4 lo, u32x4 hi) {
    const int fr = lane & 15, fq = lane >> 4;
    *(LAS u32x4*)(lw + fr * 128 + fq * 32) = lo; *(LAS u32x4*)(lw + fr * 128 + fq * 32 + 16) = hi;
    const u32x4 a = *(const LAS u32x4*)(lw + (lane >> 3) * 128 + (lane & 7) * 16), b = *(const LAS u32x4*)(lw + (8 + (lane >> 3)) * 128 + (lane & 7) * 16);
    __builtin_nontemporal_store(a, (u32x4*)(gbase + (size_t)(lane >> 3) * pitchB + (lane & 7) * 16)); __builtin_nontemporal_store(b, (u32x4*)(gbase + (size_t)(8 + (lane >> 3)) * pitchB + (lane & 7) * 16));
}
struct EpiIn {
    static constexpr int PERM = 2; static constexpr int NST = 16;
    bf16_t* H; const unsigned* csT; lds_t* lepi;
    __device__ __forceinline__ void operator()(const f32x4 (&acc)[2][2][4][2], const GUnit& u, int wr, int wc, int fr, int fq) const {
        const int seg = u.y >> 1; const int lane = fr + 16 * fq; lds_t* lw = lepi + (wr * 4 + wc) * 2048;
        const int i0 = 32 * (wc & 1) + 8 * fq;
        u32x4 t0 = (u32x4){0u, 0u, 0u, 0u}, t1 = t0;
        if (seg < 2) { const int s0_ = (u.x * 256 + wr * 64 + fr) & (SEQ - 1); t0 = *(const u32x4*)(csT + s0_ * 64 + i0); t1 = *(const u32x4*)(csT + s0_ * 64 + i0 + 4); }
#pragma unroll
        for (int idx = 0; idx < 8; ++idx) { const int ai = idx >> 2, m = idx & 3;
                const int rg = u.x * 256 + ai * HALF + wr * 64 + m * 16;
                u32x4 t0n = t0, t1n = t1;
                if (seg < 2 && idx < 7) { const int sn = (u.x * 256 + ((idx + 1) >> 2) * HALF + wr * 64 + ((idx + 1) & 3) * 16 + fr) & (SEQ - 1); t0n = *(const u32x4*)(csT + sn * 64 + i0); t1n = *(const u32x4*)(csT + sn * 64 + i0 + 4); }
                f32x4 v0 = acc[ai][0][m][0], v1 = acc[ai][0][m][1], v2 = acc[ai][1][m][0], v3 = acc[ai][1][m][1];
#define ROPE4(X, CA, SA, CB, SB) (f32x4){((X)[0] * (CA) - (X)[1] * (SA)) * sc, ((X)[0] * (SA) + (X)[1] * (CA)) * sc, ((X)[2] * (CB) - (X)[3] * (SB)) * sc, ((X)[2] * (SB) + (X)[3] * (CB)) * sc}
#define MAP4(F, X) (f32x4){F((X)[0]), F((X)[1]), F((X)[2]), F((X)[3])}
                if (seg < 2) { const float sc = seg == 1 ? 0.08838834764831845f : 1.0f;
                    v0 = ROPE4(v0, bflo(t0.x), bfhi(t0.x), bflo(t0.y), bfhi(t0.y)); v1 = ROPE4(v1, bflo(t0.z), bfhi(t0.z), bflo(t0.w), bfhi(t0.w)); v2 = ROPE4(v2, bflo(t1.x), bfhi(t1.x), bflo(t1.y), bfhi(t1.y)); v3 = ROPE4(v3, bflo(t1.z), bfhi(t1.z), bflo(t1.w), bfhi(t1.w));
                } else if (seg == 3) { v0 = MAP4(siluf_, v0); v1 = MAP4(siluf_, v1); v2 = MAP4(siluf_, v2); v3 = MAP4(siluf_, v3); }
                else if (seg == 6) { v0 = MAP4(gelu_tanh, v0); v1 = MAP4(gelu_tanh, v1); v2 = MAP4(gelu_tanh, v2); v3 = MAP4(gelu_tanh, v3); }
#undef ROPE4
#undef MAP4
                u32x4 lo, hi; lo.x = pk2(v0[0], v0[1]); lo.y = pk2(v0[2], v0[3]); lo.z = pk2(v1[0], v1[1]); lo.w = pk2(v1[2], v1[3]); hi.x = pk2(v2[0], v2[1]); hi.y = pk2(v2[2], v2[3]); hi.z = pk2(v3[0], v3[1]); hi.w = pk2(v3[2], v3[3]);
                stage_store16(lw, (unsigned char*)(H + (size_t)rg * HW + u.y * 256 + wc * 64), (size_t)HW * 2, lane, lo, hi);
                t0 = t0n; t1 = t1n;
            }
    }
};
__device__ __forceinline__ float ub0(unsigned w) { return (float)(w & 0xffu); }
__device__ __forceinline__ float ub1(unsigned w) { return (float)((w >> 8) & 0xffu); }
__device__ __forceinline__ float ub2(unsigned w) { return (float)((w >> 16) & 0xffu); }
__device__ __forceinline__ float ub3(unsigned w) { return (float)(w >> 24); }
constexpr int GBP = 3 * D;
__device__ __forceinline__ unsigned pk4_u8(float a, float b, float c, float d) { unsigned w = 0; w = __builtin_amdgcn_cvt_pk_u8_f32(a * 255.0f, 0, w); w = __builtin_amdgcn_cvt_pk_u8_f32(b * 255.0f, 1, w); w = __builtin_amdgcn_cvt_pk_u8_f32(c * 255.0f, 2, w); w = __builtin_amdgcn_cvt_pk_u8_f32(d * 255.0f, 3, w); return w; }
struct EpiGates {
    static constexpr int PERM = 2; static constexpr int NST = 8;
    unsigned char* GB; const float* gb;
    __device__ __forceinline__ void operator()(const f32x4 (&acc)[2][2][4][2], const GUnit& u, int wr, int wc, int fr, int fq) const {
        const int colt = u.y * 256 + wc * 64 + 16 * fq;
        f32x4 bv[4];
#pragma unroll
        for (int q = 0; q < 4; ++q) bv[q] = *(const f32x4*)(gb + colt + 4 * q);
#pragma unroll
        for (int ai = 0; ai < 2; ++ai)
#pragma unroll
            for (int m = 0; m < 4; ++m) { const int row = u.x * 256 + ai * HALF + wr * 64 + m * 16 + fr;
                const f32x4 v0 = acc[ai][0][m][0] + bv[0], v1 = acc[ai][0][m][1] + bv[1], v2 = acc[ai][1][m][0] + bv[2], v3 = acc[ai][1][m][1] + bv[3];
                u32x4 w; w.x = pk4_u8(sigmoidf_(v0[0]), sigmoidf_(v0[1]), sigmoidf_(v0[2]), sigmoidf_(v0[3])); w.y = pk4_u8(sigmoidf_(v1[0]), sigmoidf_(v1[1]), sigmoidf_(v1[2]), sigmoidf_(v1[3]));
                w.z = pk4_u8(sigmoidf_(v2[0]), sigmoidf_(v2[1]), sigmoidf_(v2[2]), sigmoidf_(v2[3])); w.w = pk4_u8(sigmoidf_(v3[0]), sigmoidf_(v3[1]), sigmoidf_(v3[2]), sigmoidf_(v3[3]));
                __builtin_nontemporal_store(w, (u32x4*)(GB + (size_t)row * GBP + colt)); }
    }
};
struct EpiMerge {
    static constexpr int PERM = 2; static constexpr int NST = 16;
    bf16_t* MG; const unsigned char* GB; unsigned char* MG8;
    template <int PASS>
    __device__ __forceinline__ void run(const f32x4 (&acc)[2][2][4][2], const GUnit& u, int wr, int wc, int fr, int fq) const {
        const int row0 = u.x * 256 + wr * 64 + fr; const int colt = u.y * 256 + wc * 64 + 16 * fq;
        u32x4 g = *(const u32x4*)(GB + (size_t)row0 * GBP + PASS * D + colt), o0 = (u32x4){0u, 0u, 0u, 0u}, o1 = o0;
        if (PASS > 0) { const bf16_t* mp0 = MG + (size_t)row0 * D + colt; o0 = *(const u32x4*)mp0; o1 = *(const u32x4*)(mp0 + 8); }
#pragma unroll
        for (int idx = 0; idx < 8; ++idx) { const int ai = idx >> 2, m = idx & 3; const int row = row0 + ai * HALF + m * 16; bf16_t* mp = MG + (size_t)row * D + colt;
            u32x4 gn = g, o0n = o0, o1n = o1;
            if (idx < 7) { const int rown = row0 + ((idx + 1) >> 2) * HALF + ((idx + 1) & 3) * 16; gn = *(const u32x4*)(GB + (size_t)rown * GBP + PASS * D + colt);
                if (PASS > 0) { const bf16_t* mpn = MG + (size_t)rown * D + colt; o0n = *(const u32x4*)mpn; o1n = *(const u32x4*)(mpn + 8); } }
            const f32x4 a0 = acc[ai][0][m][0], a1 = acc[ai][0][m][1], a2 = acc[ai][1][m][0], a3 = acc[ai][1][m][1];
            f32x4 v0 = (f32x4){ub0(g.x) * a0[0], ub1(g.x) * a0[1], ub2(g.x) * a0[2], ub3(g.x) * a0[3]}, v1 = (f32x4){ub0(g.y) * a1[0], ub1(g.y) * a1[1], ub2(g.y) * a1[2], ub3(g.y) * a1[3]};
            f32x4 v2 = (f32x4){ub0(g.z) * a2[0], ub1(g.z) * a2[1], ub2(g.z) * a2[2], ub3(g.z) * a2[3]}, v3 = (f32x4){ub0(g.w) * a3[0], ub1(g.w) * a3[1], ub2(g.w) * a3[2], ub3(g.w) * a3[3]};
            if (PASS > 0) {
                v0 = v0 + (f32x4){bflo(o0.x), bfhi(o0.x), bflo(o0.y), bfhi(o0.y)}; v1 = v1 + (f32x4){bflo(o0.z), bfhi(o0.z), bflo(o0.w), bfhi(o0.w)};
                v2 = v2 + (f32x4){bflo(o1.x), bfhi(o1.x), bflo(o1.y), bfhi(o1.y)}; v3 = v3 + (f32x4){bflo(o1.z), bfhi(o1.z), bflo(o1.w), bfhi(o1.w)}; }
            if (PASS == 2) { u32x4 w8; w8.x = pk4_fp8s(v0[0], v0[1], v0[2], v0[3], 1.0f); w8.y = pk4_fp8s(v1[0], v1[1], v1[2], v1[3], 1.0f); w8.z = pk4_fp8s(v2[0], v2[1], v2[2], v2[3], 1.0f); w8.w = pk4_fp8s(v3[0], v3[1], v3[2], v3[3], 1.0f);
                *(u32x4*)(MG8 + (size_t)row * D + colt) = w8; }
            else { u32x4 w0, w1; w0.x = pk2(v0[0], v0[1]); w0.y = pk2(v0[2], v0[3]); w0.z = pk2(v1[0], v1[1]); w0.w = pk2(v1[2], v1[3]); w1.x = pk2(v2[0], v2[1]); w1.y = pk2(v2[2], v2[3]); w1.z = pk2(v3[0], v3[1]); w1.w = pk2(v3[2], v3[3]);
                *(u32x4*)mp = w0; *(u32x4*)(mp + 8) = w1; }
            g = gn; o0 = o0n; o1 = o1n; }
    }
    __device__ __forceinline__ void operator()(const f32x4 (&acc)[2][2][4][2], const GUnit& u, int wr, int wc, int fr, int fq) const {
        if (u.z == 0) run<0>(acc, u, wr, wc, fr, fq); else if (u.z == 1) run<1>(acc, u, wr, wc, fr, fq); else run<2>(acc, u, wr, wc, fr, fq);
    }
};
struct EpiPool {
    static constexpr int PERM = 1; static constexpr int NST = 0;
    bf16_t* BR; const float* scale;
    __device__ __forceinline__ void operator()(const f32x4 (&acc)[2][2][4][2], const GUnit& u, int wr, int wc, int fr, int fq) const {
        const int row0 = u.x * 256 + wr * 64 + fr; const int colt = u.y * 256 + wc * 32 + 8 * fq;
        f32x4 sv[2][2];
#pragma unroll
        for (int bj = 0; bj < 2; ++bj)
#pragma unroll
            for (int n = 0; n < 2; ++n) sv[bj][n] = *(const f32x4*)(scale + colt + bj * HALF + 4 * n);
#pragma unroll
        for (int ai = 0; ai < 2; ++ai)
#pragma unroll
            for (int m = 0; m < 4; ++m) { unsigned char* rowp = (unsigned char*)BR + (size_t)(row0 + ai * HALF + m * 16) * 3072 + 1024 + colt;
#pragma unroll
                for (int bj = 0; bj < 2; ++bj) { const f32x4 v0 = acc[ai][bj][m][0] * sv[bj][0], v1 = acc[ai][bj][m][1] * sv[bj][1];
                    u32x2 w; w.x = pk4_fp8s(v0[0], v0[1], v0[2], v0[3], 1.0f); w.y = pk4_fp8s(v1[0], v1[1], v1[2], v1[3], 1.0f); *(u32x2*)(rowp + bj * HALF) = w; } }
    }
};
struct EpiRG {
    static constexpr int PERM = 1; static constexpr int NST = 0;
    const bf16_t* BR; bf16_t* LA; bf16_t* BBs; const float* ba; const float* bx; const float* ls;
    __device__ __forceinline__ void operator()(const f32x4 (&acc)[2][2][4][2], const GUnit& u, int wr, int wc, int fr, int fq) const {
        const int row0 = u.x * 256 + wr * 64 + fr; const int ch = u.y * 128 + wc * 32 + 8 * fq;
        f32x4 bav[2], bxv[2], lsv[2];
#pragma unroll
        for (int n = 0; n < 2; ++n) { bav[n] = *(const f32x4*)(ba + ch + 4 * n); bxv[n] = *(const f32x4*)(bx + ch + 4 * n); lsv[n] = *(const f32x4*)(ls + ch + 4 * n); }
#pragma unroll
        for (int ai = 0; ai < 2; ++ai)
#pragma unroll
            for (int m = 0; m < 4; ++m) { const size_t row = (size_t)(row0 + ai * HALF + m * 16);
                const u32x4 cw = *(const u32x4*)(BR + row * 1536 + 1024 + ch); const float cv[8] = {bflo(cw.x), bfhi(cw.x), bflo(cw.y), bfhi(cw.y), bflo(cw.z), bfhi(cw.z), bflo(cw.w), bfhi(cw.w)};
                float la[8], bb[8];
#pragma unroll
                for (int n = 0; n < 2; ++n)
#pragma unroll
                    for (int q = 0; q < 4; ++q) { const float rr = sigmoidf_(acc[ai][0][m][n][q] + bav[n][q]), ii = sigmoidf_(acc[ai][1][m][n][q] + bxv[n][q]);
                        const float l = 8.0f * rr * lsv[n][q]; const float x2 = 2.0f * l; const float om = x2 > -0.02f ? -x2 * (1.0f + x2 * (0.5f + x2 * 0.16666667f)) : 1.0f - __expf(x2);
                        la[4 * n + q] = l; bb[4 * n + q] = __builtin_amdgcn_sqrtf(om) * (ii * cv[4 * n + q]); }
                u32x4 w; w.x = pk2(la[0], la[1]); w.y = pk2(la[2], la[3]); w.z = pk2(la[4], la[5]); w.w = pk2(la[6], la[7]); *(u32x4*)(LA + row * 512 + ch) = w;
                w.x = pk2(bb[0], bb[1]); w.y = pk2(bb[2], bb[3]); w.z = pk2(bb[4], bb[5]); w.w = pk2(bb[6], bb[7]); *(u32x4*)(BBs + row * 512 + ch) = w; }
    }
};
struct EpiResB {
    static constexpr int PERM = 1; static constexpr int NST = 16;
    bf16_t* O; const bf16_t* R; float scale;
    __device__ __forceinline__ void operator()(const f32x4 (&acc)[2][2][4][2], const GUnit& u, int wr, int wc, int fr, int fq) const {
        const int row0 = u.x * 256 + wr * 64 + fr; const int colt = u.y * 256 + wc * 32 + 8 * fq;
        u32x4 r0 = (u32x4){0u, 0u, 0u, 0u}, r1 = r0;
        if (R) { const size_t off0 = (size_t)row0 * D + colt; r0 = *(const u32x4*)(R + off0); r1 = *(const u32x4*)(R + off0 + HALF); }
#pragma unroll
        for (int idx = 0; idx < 8; ++idx) { const int ai = idx >> 2, m = idx & 3; const size_t off = (size_t)(row0 + ai * HALF + m * 16) * D + colt;
            u32x4 r0n = r0, r1n = r1;
            if (R && idx < 7) { const size_t offn = (size_t)(row0 + ((idx + 1) >> 2) * HALF + ((idx + 1) & 3) * 16) * D + colt; r0n = *(const u32x4*)(R + offn); r1n = *(const u32x4*)(R + offn + HALF); }
#pragma unroll
            for (int bj = 0; bj < 2; ++bj) { f32x4 v0 = acc[ai][bj][m][0], v1 = acc[ai][bj][m][1]; const u32x4 r = bj ? r1 : r0;
                if (R) { v0 = v0 + (f32x4){bflo(r.x), bfhi(r.x), bflo(r.y), bfhi(r.y)} * scale; v1 = v1 + (f32x4){bflo(r.z), bfhi(r.z), bflo(r.w), bfhi(r.w)} * scale; }
                u32x4 w; w.x = pk2(v0[0], v0[1]); w.y = pk2(v0[2], v0[3]); w.z = pk2(v1[0], v1[1]); w.w = pk2(v1[2], v1[3]); *(u32x4*)(O + off + bj * HALF) = w; }
            r0 = r0n; r1 = r1n; }
    }
};
struct EpiGLU {
    static constexpr int PERM = 1; static constexpr int NST = 0;
    unsigned char* Hout; float* LG; bool moe;
    __device__ __forceinline__ void operator()(const f32x4 (&acc)[2][2][4][2], const GUnit& u, int wr, int wc, int fr, int fq) const {
        const int row0 = u.x * 256 + wr * 64 + fr;
        if (!moe && u.y == 2) {
            if (wc < 2) {
#pragma unroll
                for (int ai = 0; ai < 2; ++ai)
#pragma unroll
                    for (int m = 0; m < 4; ++m) { float* lp = LG + (size_t)(row0 + ai * HALF + m * 16) * 64 + wc * 32 + 8 * fq;
#pragma unroll
                        for (int n = 0; n < 2; ++n) *(f32x4*)(lp + 4 * n) = acc[ai][0][m][n]; }
            }
            return;
        }
        const int colt = u.y * 128 + wc * 32 + 8 * fq;
#pragma unroll
        for (int ai = 0; ai < 2; ++ai)
#pragma unroll
            for (int m = 0; m < 4; ++m) { unsigned char* hp = Hout + (size_t)(row0 + ai * HALF + m * 16) * DEXP + colt;
                const f32x4 a0 = acc[ai][0][m][0], b0 = acc[ai][1][m][0], a1 = acc[ai][0][m][1], b1 = acc[ai][1][m][1];
                u32x2 w; w.x = pk4_fp8s(siluf_(a0[0]) * b0[0], siluf_(a0[1]) * b0[1], siluf_(a0[2]) * b0[2], siluf_(a0[3]) * b0[3], 1.0f); w.y = pk4_fp8s(siluf_(a1[0]) * b1[0], siluf_(a1[1]) * b1[1], siluf_(a1[2]) * b1[2], siluf_(a1[3]) * b1[3], 1.0f);
                *(u32x2*)hp = w; }
    }
};
constexpr float Y_SCALE = 16.0f;
__device__ __forceinline__ unsigned pk4_fp8(f32x4 a) { int w = 0; w = __builtin_amdgcn_cvt_pk_fp8_f32(a[0] * Y_SCALE, a[1] * Y_SCALE, w, false); w = __builtin_amdgcn_cvt_pk_fp8_f32(a[2] * Y_SCALE, a[3] * Y_SCALE, w, true); return (unsigned)w; }
struct EpiExpDown {
    static constexpr int PERM = 2; static constexpr int NST = 8;
    unsigned char* Y;
    __device__ __forceinline__ void operator()(const f32x4 (&acc)[2][2][4][2], const GUnit& u, int wr, int wc, int fr, int fq) const {
        const int colt = u.y * 256 + wc * 64 + 16 * fq;
#pragma unroll
        for (int ai = 0; ai < 2; ++ai)
#pragma unroll
            for (int m = 0; m < 4; ++m) { const int r = ai * HALF + wr * 64 + m * 16 + fr;
                u32x4 w; w.x = pk4_fp8(acc[ai][0][m][0]); w.y = pk4_fp8(acc[ai][0][m][1]); w.z = pk4_fp8(acc[ai][1][m][0]); w.w = pk4_fp8(acc[ai][1][m][1]);
                *(u32x4*)(Y + (size_t)(u.x * 256 + r) * D + colt) = w; }
    }
};

template <class Map>
__device__ __forceinline__ void transpose_item(const f32x4 (&t)[8], int K, int N, bf16_t* WT, const Map& map, LAS float* scr, int item, int lane, int ldo = 0) {
    if (ldo == 0) ldo = K;
    const int nblk = N / 32, kb = item / nblk, nb = item % nblk, k0 = 64 * kb, n0 = 32 * nb;
    {
#pragma unroll
      for (int i = 0; i < 8; ++i) { LAS float* d = scr + (8 * i + (lane >> 3)) * 33 + 4 * (lane & 7); d[0] = t[i][0]; d[1] = t[i][1]; d[2] = t[i][2]; d[3] = t[i][3]; } }
    LDS_WAIT(); asm volatile("" ::: "memory");
    const int c = lane & 7;
#pragma unroll
    for (int j = 0; j < 4; ++j) { const int n = (lane >> 3) + 8 * j; const LAS float* s = scr + (8 * c) * 33 + n;
        u32x4 o; o.x = pk2(s[0 * 33], s[1 * 33]); o.y = pk2(s[2 * 33], s[3 * 33]); o.z = pk2(s[4 * 33], s[5 * 33]); o.w = pk2(s[6 * 33], s[7 * 33]);
        *(u32x4*)(WT + (size_t)map(n0 + n) * ldo + k0 + 8 * c) = o; }
    LDS_WAIT(); asm volatile("" ::: "memory");
}
template <class Map>
__device__ __forceinline__ void transpose_item8(const f32x4 (&t)[8], int K, int N, unsigned char* WT, const Map& map, LAS float* scr, int item, int lane, const float wscale = W8_SCALE) {
    const int nblk = N / 32, kb = item / nblk, nb = item % nblk, k0 = 64 * kb, n0 = 32 * nb;
    {
#pragma unroll
      for (int i = 0; i < 8; ++i) { LAS float* d = scr + (8 * i + (lane >> 3)) * 33 + 4 * (lane & 7); d[0] = t[i][0]; d[1] = t[i][1]; d[2] = t[i][2]; d[3] = t[i][3]; } }
    LDS_WAIT(); asm volatile("" ::: "memory");
    const int c = lane & 7;
#pragma unroll
    for (int j = 0; j < 4; ++j) { const int n = (lane >> 3) + 8 * j; const LAS float* s = scr + (8 * c) * 33 + n;
        u32x2 o; o.x = pk4_fp8s(s[0 * 33], s[1 * 33], s[2 * 33], s[3 * 33], wscale); o.y = pk4_fp8s(s[4 * 33], s[5 * 33], s[6 * 33], s[7 * 33], wscale);
        *(u32x2*)(WT + (size_t)map(n0 + n) * K + k0 + 8 * c) = o; }
    LDS_WAIT(); asm volatile("" ::: "memory");
}
struct MapId { int off; __device__ __forceinline__ int operator()(int n) const { return off + n; } };
struct MapIn { __device__ __forceinline__ int operator()(int n) const { if (n >= 1024) return n; const int d = n & 127; return (n & ~127) + 2 * (d & 63) + (d >> 6); } };
struct MapGlu { int off; __device__ __forceinline__ int operator()(int n) const { return (n >> 7) * 256 + off + (n & 127); } };

__device__ __forceinline__ void cvt_load(const float* W, int N, int item, int lane, f32x4 (&t)[8]) {
    const int nblk = N / 32, kb = item / nblk, nb = item % nblk, k0 = 64 * kb, n0 = 32 * nb;
#pragma unroll
    for (int i = 0; i < 8; ++i) t[i] = *(const f32x4*)(W + (size_t)(k0 + 8 * i + (lane >> 3)) * N + n0 + 4 * (lane & 7));
}
__device__ __forceinline__ void phase_cvt(const Ctx& c) {
    const int layer = c.layer; const size_t L = (size_t)layer;
    LAS float* scr = (LAS float*)(c.lds + c.wave * 16384);
    const int gw = c.bid * 8 + c.wave, NGW = c.G * 8;
    unsigned char* w_in8 = (unsigned char*)(c.ws + W_IN); unsigned char* e13_8 = (unsigned char*)(c.ws + W_E13); bf16_t* w_brT = (bf16_t*)(c.ws + W_BR); bf16_t* w_outT = (bf16_t*)(c.ws + W_OUT); bf16_t* smT = (bf16_t*)(c.ws + W_SM);
    bf16_t* shupT = (bf16_t*)(c.ws + W_SHUP); unsigned char* shdn8 = (unsigned char*)(c.ws + W_SHDN); unsigned char* e2_8 = (unsigned char*)(c.ws + W_E2);
    constexpr int I_IN = (D / 64) * (INW / 32), I_BR = (512 / 64) * (D / 32), I_OUT = (D / 64) * (D / 32), I_SM = (128 / 64) * (128 / 32), I_UP = (D / 64) * (DEXP / 32), I_DN = (DEXP / 64) * (D / 32), I_RT = (D / 64) * (64 / 32);
    constexpr int N0 = I_IN, N1 = N0 + 3 * I_BR, N2 = N1 + I_OUT, N3 = N2 + 12 * I_SM, N4 = N3 + 2 * I_UP, N5 = N4 + I_RT, N6 = N5 + I_DN, N7 = N6 + 2 * NEXP * I_UP, N8 = N7 + NEXP * I_DN;
    auto src = [&](int r, const float*& W, int& N, int& item) {
        if (r < N0) { W = inp(c, I_WIN, L * D * INW); N = INW; item = r; return; }
        if (r < N1) { r -= N0; const int i = r / I_BR; W = inp(c, I_WBR, L * 3 * 512 * D) + (size_t)i * 512 * D; N = D; item = r % I_BR; return; }
        if (r < N2) { r -= N1; W = inp(c, I_WOUT, L * D * D); N = D; item = r; return; }
        if (r < N3) { r -= N2; const int i = r / I_SM, which = i / 4, g = i % 4; W = inp(c, which == 0 ? I_POOLW : (which == 1 ? I_WA : I_WX), L * 4 * 128 * 128) + (size_t)g * 128 * 128; N = 128; item = r % I_SM; return; }
        if (r < N4) { r -= N3; const int i = r / I_UP; W = inp(c, i == 0 ? I_SW1 : I_SW3, L * D * DEXP); N = DEXP; item = r % I_UP; return; }
        if (r < N5) { r -= N4; W = inp(c, I_RW, L * D * 64); N = 64; item = r; return; }
        if (r < N6) { r -= N5; W = inp(c, I_SW2, L * DEXP * D); N = D; item = r; return; }
        if (r < N7) { r -= N6; const int i = r / I_UP, e = i >> 1, which = i & 1; W = inp(c, which ? I_EW3 : I_EW1, L * NEXP * D * DEXP) + (size_t)e * D * DEXP; N = DEXP; item = r % I_UP; return; }
        r -= N7; { const int e = r / I_DN; W = inp(c, I_EW2, L * NEXP * DEXP * D) + (size_t)e * DEXP * D; N = D; item = r % I_DN; }
    };
    f32x4 t[8];
    if (gw < N8) { const float* W; int N, item; src(gw, W, N, item); cvt_load(W, N, item, c.lane, t); }
    for (int it = gw; it < N8; it += NGW) {
        f32x4 tn[8];
        { const int itn = it + NGW < N8 ? it + NGW : it; const float* W; int N, item; src(itn, W, N, item); cvt_load(W, N, item, c.lane, tn); }
        int r = it;
        do {
        if (r < N0) { transpose_item8(t, D, INW, w_in8, MapIn{}, scr, r, c.lane); break; }
        if (r < N1) { r -= N0; const int i = r / I_BR; transpose_item8(t, 512, D, (unsigned char*)w_brT + (size_t)i * D * 512, MapId{0}, scr, r % I_BR, c.lane, W8_SCALE * (256.0f / 255.0f)); break; }
        if (r < N2) { r -= N1; transpose_item8(t, D, D, (unsigned char*)w_outT, MapId{0}, scr, r, c.lane); break; }
        if (r < N3) { r -= N2; const int i = r / I_SM, which = i / 4, g = i % 4;
            bf16_t* dst = which == 0 ? smT + (size_t)(g >> 1) * 65536 + (size_t)(g & 1) * 128 * 256 + (g & 1) * 128 : smT + (size_t)(2 + g) * 65536 + (size_t)(which - 1) * 128 * 256 + (g & 1) * 128;
            transpose_item(t, 128, 128, dst, MapId{0}, scr, r % I_SM, c.lane, 256); break; }
        if (r < N4) { r -= N3; const int i = r / I_UP; transpose_item(t, D, DEXP, shupT, MapGlu{i * 128}, scr, r % I_UP, c.lane); break; }
        if (r < N5) { r -= N4; transpose_item(t, D, 64, shupT, MapId{512}, scr, r, c.lane); break; }
        if (r < N6) { r -= N5; transpose_item8(t, DEXP, D, shdn8, MapId{0}, scr, r, c.lane); break; }
        if (r < N7) { r -= N6; const int i = r / I_UP, e = i >> 1, which = i & 1; transpose_item8(t, D, DEXP, e13_8 + (size_t)e * 512 * D, MapGlu{which * 128}, scr, r % I_UP, c.lane); break; }
        r -= N7; { const int e = r / I_DN; transpose_item8(t, DEXP, D, e2_8 + (size_t)e * D * DEXP, MapId{0}, scr, r % I_DN, c.lane); }
        } while (0);
#pragma unroll
        for (int i = 0; i < 8; ++i) t[i] = tn[i];
    }
    { u32x4* z = (u32x4*)(shupT + (size_t)576 * D); const int nz = 192 * D * 2 / 16; for (int i = c.bid * 512 + c.tid; i < nz; i += c.G * 512) z[i] = (u32x4){0u, 0u, 0u, 0u}; }
    {
        u32x4* z = (u32x4*)smT;
        for (int i = c.bid * 512 + c.tid; i < 6 * 256 * 16; i += c.G * 512) { const int t = i / (256 * 16), rr = (i / 16) % 256, ch = i % 16;
            const int khalf = t < 2 ? ((rr >> 7) ^ 1) : (((t - 2) & 1) ^ 1);
            z[((size_t)t * 65536 + (size_t)rr * 256 + khalf * 128) / 8 + ch] = (u32x4){0u, 0u, 0u, 0u}; }
        float* lsT = (float*)(c.ws + W_SM + 768 * 1024); const float* lam_ = inp(c, I_LAM, L * 512);
        for (int i = c.bid * 512 + c.tid; i < 512; i += c.G * 512) lsT[i] = -log1pf(expf(-lam_[i]));
    }
    if (layer == 0) {
        const f32x4* xs = (const f32x4*)inp(c, I_X, 0); u32x2* xd = (u32x2*)(c.ws + WS_XB); unsigned* xd8 = (unsigned*)(c.ws + WS_XB8);
        for (size_t i = (size_t)c.bid * 512 + c.tid; i < (size_t)T * D / 4; i += (size_t)c.G * 512) { const f32x4 v = xs[i]; u32x2 w; w.x = pk2(v[0], v[1]); w.y = pk2(v[2], v[3]); xd[i] = w; xd8[i] = pk4_fp8s(v[0], v[1], v[2], v[3], 1.0f); }
        unsigned* csT = (unsigned*)(c.ws + WS_COS);
        for (int i = c.bid * 512 + c.tid; i < SEQ * 64; i += c.G * 512) { const int s = i >> 6, j = i & 63; const float inv = powf(10000.0f, -(float)j / 64.0f); const float ang = (float)((const int*)inp(c, I_POS, 0))[s] * inv; csT[i] = pk2(cosf(ang), sinf(ang)); }
    }
}

constexpr int TP = 272;
__device__ __forceinline__ void load_tile128(lds_t* dst, const bf16_t* src, int gp, int rows, int tid) {
    for (int v = tid; v < rows * 16; v += 512) { const int r = v >> 4, cb = v & 15; *(LAS u32x4*)(dst + r * TP + cb * 16) = *(const u32x4*)(src + (size_t)r * gp + cb * 8); }
}
__device__ __forceinline__ float ret_log2g(int h) { return log2f(1.0f - exp2f(-5.0f - (float)h)); }

__device__ __forceinline__ void frag_col8(bf16x8 (&out)[8], const lds_t* X, int pitchB, int k0, int fr, int fq) {
    const int q = fr >> 2, p = fr & 3;
    const unsigned a0 = (unsigned)(size_t)X + (unsigned)((k0 + 8 * fq + q) * pitchB + 4 * p * 2), a1 = a0 + 4u * (unsigned)pitchB;
    u16x4 lo[8], hi[8];
    asm volatile("ds_read_b64_tr_b16 %0, %16\n\tds_read_b64_tr_b16 %1, %16 offset:32\n\tds_read_b64_tr_b16 %2, %16 offset:64\n\tds_read_b64_tr_b16 %3, %16 offset:96\n\t"
                 "ds_read_b64_tr_b16 %4, %16 offset:128\n\tds_read_b64_tr_b16 %5, %16 offset:160\n\tds_read_b64_tr_b16 %6, %16 offset:192\n\tds_read_b64_tr_b16 %7, %16 offset:224\n\t"
                 "ds_read_b64_tr_b16 %8, %17\n\tds_read_b64_tr_b16 %9, %17 offset:32\n\tds_read_b64_tr_b16 %10, %17 offset:64\n\tds_read_b64_tr_b16 %11, %17 offset:96\n\t"
                 "ds_read_b64_tr_b16 %12, %17 offset:128\n\tds_read_b64_tr_b16 %13, %17 offset:160\n\tds_read_b64_tr_b16 %14, %17 offset:192\n\tds_read_b64_tr_b16 %15, %17 offset:224\n\ts_waitcnt lgkmcnt(0)"
                 : "=&v"(lo[0]), "=&v"(lo[1]), "=&v"(lo[2]), "=&v"(lo[3]), "=&v"(lo[4]), "=&v"(lo[5]), "=&v"(lo[6]), "=&v"(lo[7]),
                   "=&v"(hi[0]), "=&v"(hi[1]), "=&v"(hi[2]), "=&v"(hi[3]), "=&v"(hi[4]), "=&v"(hi[5]), "=&v"(hi[6]), "=&v"(hi[7])
                 : "v"(a0), "v"(a1) : "memory");
#pragma unroll
    for (int i = 0; i < 8; ++i) { bf16x8 r; r[0] = (short)lo[i][0]; r[1] = (short)lo[i][1]; r[2] = (short)lo[i][2]; r[3] = (short)lo[i][3]; r[4] = (short)hi[i][0]; r[5] = (short)hi[i][1]; r[6] = (short)hi[i][2]; r[7] = (short)hi[i][3]; out[i] = r; }
}
#define ACC8(S, X, OP) do { S[0] OP bflo((X).x); S[1] OP bfhi((X).x); S[2] OP bflo((X).y); S[3] OP bfhi((X).y); S[4] OP bflo((X).z); S[5] OP bfhi((X).z); S[6] OP bflo((X).w); S[7] OP bfhi((X).w); } while (0)
template <int W>
__device__ __forceinline__ void pool_fill(bf16_t* dst, const bf16_t* Hcol, int r0, int s0) {
#pragma unroll 1
    for (int blk = 0; blk < 2; ++blk) {
        const int rb = r0 + blk * 4 - (W - 1);
        u32x4 lo[3], hi[4]; float sum[8];
#pragma unroll
        for (int e = 0; e < 8; ++e) sum[e] = 0.f;
#pragma unroll
        for (int j = 0; j < W + 3; ++j) { const int rr = rb + j; const int rc = rr < -s0 ? -s0 : rr; u32x4 xv = *(const u32x4*)(Hcol + (ptrdiff_t)rc * HW); if (s0 + rr < 0) xv = (u32x4){0u, 0u, 0u, 0u};
            if (j < W) ACC8(sum, xv, +=);
            if (j < 3) lo[j] = xv;
            if (j >= W - 1) hi[j - (W - 1)] = xv; }
#pragma unroll
        for (int o = 0; o < 4; ++o) {
            if (o > 0) { ACC8(sum, hi[o], +=); ACC8(sum, lo[o - 1], -=); }
            const int rr = r0 + blk * 4 + o; const int s = s0 + rr; const int nn = (s + 1) < W ? (s + 1) : W; const float inv = 1.0f / (float)nn; const u32x4 self = hi[o];
            u32x4 ov; ov.x = pk2(sum[0] * inv - bflo(self.x), sum[1] * inv - bfhi(self.x)); ov.y = pk2(sum[2] * inv - bflo(self.y), sum[3] * inv - bfhi(self.y));
            ov.z = pk2(sum[4] * inv - bflo(self.z), sum[5] * inv - bfhi(self.z)); ov.w = pk2(sum[6] * inv - bflo(self.w), sum[7] * inv - bfhi(self.w));
            *(u32x4*)(dst + (size_t)rr * 1536) = ov;
        }
    }
}
__device__ __forceinline__ void phase_mix1(const Ctx& c) {
    const size_t L = (size_t)c.layer;
    const float* conv_w = inp(c, I_CONVW, L * 4 * 512); const float* conv_b = inp(c, I_CONVB, L * 512); const float* pool_scale = inp(c, I_POOLS, L * 512);
    const float* ba_ = inp(c, I_BA, L * 512); const float* bx_ = inp(c, I_BX, L * 512); const float* lam_ = inp(c, I_LAM, L * 512);
    const int tid = c.tid, lane = c.lane, wave = c.wave, fr = lane & 15, fq = lane >> 4;
    const bf16_t* H = (const bf16_t*)(c.ws + S_H7); bf16_t* KV = (bf16_t*)(c.ws + S_KV); bf16_t* BR = (bf16_t*)(c.ws + S_BR);
    bf16_t* LA = (bf16_t*)(c.ws + S_LA); bf16_t* BBs = (bf16_t*)(c.ws + S_BB);
    const bf16_t* smT = (const bf16_t*)(c.ws + W_SM);
    lds_t* L0 = c.lds; lds_t* L1 = c.lds + 128 * TP;
    for (int p = c.bid; p < NPANEL; p += c.G) {
        const int b = p >> 4, t0 = p * 256;
        u32x4 kraw[4], vraw[4];
#pragma unroll
        for (int it = 0; it < 4; ++it) { const int v = tid + it * 512, r = v >> 4, cb = v & 15; kraw[it] = *(const u32x4*)(H + (size_t)(t0 + r) * HW + 512 + cb * 8); vraw[it] = *(const u32x4*)(H + (size_t)(t0 + r) * HW + 1024 + cb * 8); }
#pragma unroll 1
        for (int u = 0; u < 8; ++u) {
            const int cc = u >> 2, h = u & 3, n = (p & 15) * 2 + cc; const float l2g = ret_log2g(h);
            __syncthreads();
#pragma unroll
            for (int it = 0; it < 4; ++it) { const int v = tid + it * 512, r = v >> 4, cb = v & 15; const float dk = exp2f(l2g * (float)(127 - r)); const u32x4 kv = kraw[it];
                u32x4 ko; ko.x = pk2(bflo(kv.x) * dk, bfhi(kv.x) * dk); ko.y = pk2(bflo(kv.y) * dk, bfhi(kv.y) * dk); ko.z = pk2(bflo(kv.z) * dk, bfhi(kv.z) * dk); ko.w = pk2(bflo(kv.w) * dk, bfhi(kv.w) * dk);
                *(LAS u32x4*)(L0 + r * TP + cb * 16) = ko; *(LAS u32x4*)(L1 + r * TP + cb * 16) = vraw[it]; }
            __syncthreads();
            if (u < 7) { const int u2 = u + 1, cc2 = u2 >> 2, h2 = u2 & 3, tc2 = t0 + cc2 * 128;
#pragma unroll
                for (int it = 0; it < 4; ++it) { const int v = tid + it * 512, r = v >> 4, cb = v & 15; kraw[it] = *(const u32x4*)(H + (size_t)(tc2 + r) * HW + 512 + h2 * 128 + cb * 8); vraw[it] = *(const u32x4*)(H + (size_t)(tc2 + r) * HW + 1024 + h2 * 128 + cb * 8); } }
            f32x4 acc[8];
#pragma unroll
            for (int i = 0; i < 8; ++i) acc[i] = (f32x4){0.f, 0.f, 0.f, 0.f};
#pragma unroll
            for (int j0 = 0; j0 < 128; j0 += 32) {
                const bf16x8 a = frag_col(L1, TP, j0, wave * 16, fr, fq);
                bf16x8 kb[8]; frag_col8(kb, L0, TP, j0, fr, fq);
#pragma unroll
                for (int i = 0; i < 8; ++i) acc[i] = mfma16(kb[i], a, acc[i]);
            }
            bf16_t* kvp = KV + ((size_t)((b * 4 + h) * 32 + n)) * 16384;
#pragma unroll
            for (int i = 0; i < 8; ++i) { u32x2 w; w.x = pk2(acc[i][0], acc[i][1]); w.y = pk2(acc[i][2], acc[i][3]); *(u32x2*)(kvp + (wave * 16 + fr) * 128 + i * 16 + 4 * fq) = w; }
        }
        {
            const int cb = lane & 15, rl = lane >> 4, s0 = t0 & (SEQ - 1), g = wave & 3, r0 = rl * 64;
            if (wave < 4) {
                const int W = 2 << g; const bf16_t* Hcol = H + (size_t)t0 * HW + 2048 + g * 128 + cb * 8; bf16_t* dst = BR + (size_t)t0 * 1536 + g * 128 + cb * 8;
                float sum[8];
#pragma unroll
                for (int e = 0; e < 8; ++e) sum[e] = 0.f;
                for (int r = r0 - W + 1; r < r0; ++r) { const int rc = r < -s0 ? -s0 : r; u32x4 xv = *(const u32x4*)(Hcol + (ptrdiff_t)rc * HW); if (s0 + r < 0) xv = (u32x4){0u, 0u, 0u, 0u}; ACC8(sum, xv, +=); }
#pragma unroll 1
                for (int rb = r0; rb < r0 + 64; rb += 8) {
                    u32x4 xn[8], xo[8];
#pragma unroll
                    for (int i = 0; i < 8; ++i) { const int r = rb + i, ro = r - W; const int rcn = r < -s0 ? -s0 : r, rco = ro < -s0 ? -s0 : ro;
                        xn[i] = *(const u32x4*)(Hcol + (ptrdiff_t)rcn * HW); xo[i] = *(const u32x4*)(Hcol + (ptrdiff_t)rco * HW); if (s0 + ro < 0) xo[i] = (u32x4){0u, 0u, 0u, 0u}; }
#pragma unroll
                    for (int i = 0; i < 8; ++i) { const int r = rb + i; ACC8(sum, xn[i], +=); if (r > r0) ACC8(sum, xo[i], -=);
                        const int s = s0 + r; const int nn = (s + 1) < W ? (s + 1) : W; const float inv = 1.0f / (float)nn; const u32x4 self = xn[i];
                        u32x4 ov; ov.x = pk2(sum[0] * inv - bflo(self.x), sum[1] * inv - bfhi(self.x)); ov.y = pk2(sum[2] * inv - bflo(self.y), sum[3] * inv - bfhi(self.y));
                        ov.z = pk2(sum[4] * inv - bflo(self.z), sum[5] * inv - bfhi(self.z)); ov.w = pk2(sum[6] * inv - bflo(self.w), sum[7] * inv - bfhi(self.w));
                        *(u32x4*)(dst + (size_t)r * 1536) = ov; }
                }
            } else {
                const int ch = g * 128 + cb * 8; const bf16_t* Hcol = H + (size_t)t0 * HW + 2560 + ch; bf16_t* dst = BR + (size_t)t0 * 1536 + 1024 + ch;
                float cwv[4][8], cbv[8];
#pragma unroll
                for (int e = 0; e < 8; ++e) { cbv[e] = conv_b[ch + e];
#pragma unroll
                    for (int k = 0; k < 4; ++k) cwv[k][e] = conv_w[k * 512 + ch + e]; }
                u32x4 p1, p2, p3;
                { const int ra = r0 - 1, rb2 = r0 - 2, rc3 = r0 - 3; p1 = *(const u32x4*)(Hcol + (ptrdiff_t)(ra < -s0 ? -s0 : ra) * HW); p2 = *(const u32x4*)(Hcol + (ptrdiff_t)(rb2 < -s0 ? -s0 : rb2) * HW); p3 = *(const u32x4*)(Hcol + (ptrdiff_t)(rc3 < -s0 ? -s0 : rc3) * HW);
                  if (s0 + ra < 0) p1 = (u32x4){0u, 0u, 0u, 0u}; if (s0 + rb2 < 0) p2 = (u32x4){0u, 0u, 0u, 0u}; if (s0 + rc3 < 0) p3 = (u32x4){0u, 0u, 0u, 0u}; }
#pragma unroll 1
                for (int rb = r0; rb < r0 + 64; rb += 8) {
                    u32x4 xn[8];
#pragma unroll
                    for (int i = 0; i < 8; ++i) xn[i] = *(const u32x4*)(Hcol + (ptrdiff_t)(rb + i) * HW);
#pragma unroll
                    for (int i = 0; i < 8; ++i) { float sum[8];
#pragma unroll
                        for (int e = 0; e < 8; ++e) sum[e] = cbv[e];
                        const u32x4 t0x = xn[i];
#define TAP8(X, K) do { sum[0] += bflo((X).x) * cwv[K][0]; sum[1] += bfhi((X).x) * cwv[K][1]; sum[2] += bflo((X).y) * cwv[K][2]; sum[3] += bfhi((X).y) * cwv[K][3]; sum[4] += bflo((X).z) * cwv[K][4]; sum[5] += bfhi((X).z) * cwv[K][5]; sum[6] += bflo((X).w) * cwv[K][6]; sum[7] += bfhi((X).w) * cwv[K][7]; } while (0)
                        TAP8(t0x, 0); TAP8(p1, 1); TAP8(p2, 2); TAP8(p3, 3);
#undef TAP8
                        u32x4 ov; ov.x = pk2(sum[0], sum[1]); ov.y = pk2(sum[2], sum[3]); ov.z = pk2(sum[4], sum[5]); ov.w = pk2(sum[6], sum[7]);
                        *(u32x4*)(dst + (size_t)(rb + i) * 1536) = ov; p3 = p2; p2 = p1; p1 = t0x; }
                }
            }
        }
    }
}

__device__ __forceinline__ void phase_rgscan(const Ctx& c) {
    bf16_t* LA = (bf16_t*)(c.ws + S_LA); bf16_t* BBs = (bf16_t*)(c.ws + S_BB); float* AE = (float*)(c.ws + S_RGC); float* HE = AE + 262144;
    for (int p = c.bid; p < NPANEL; p += c.G) {
        const int cp = c.tid & 255, ck = p * 2 + (c.tid >> 8); const size_t base = (size_t)ck * 128 * 512 + 2 * cp; float h0 = 0.f, P0 = 1.f, h1 = 0.f, P1 = 1.f;
        unsigned la[8], bb[8];
#pragma unroll
        for (int i = 0; i < 8; ++i) { const size_t o = base + (size_t)i * 512; la[i] = *(const unsigned*)(LA + o); bb[i] = *(const unsigned*)(BBs + o); }
#pragma unroll 1
        for (int j0 = 0; j0 < 128; j0 += 8) {
            unsigned lan[8], bbn[8]; const int jn = j0 + 8 < 128 ? j0 + 8 : j0;
#pragma unroll
            for (int i = 0; i < 8; ++i) { const size_t o = base + (size_t)(jn + i) * 512; lan[i] = *(const unsigned*)(LA + o); bbn[i] = *(const unsigned*)(BBs + o); }
            unsigned ho[8], po[8];
#pragma unroll
            for (int i = 0; i < 8; ++i) { const float a0 = __expf(bflo(la[i])), a1 = __expf(bfhi(la[i]));
                h0 = a0 * h0 + bflo(bb[i]); P0 *= a0; h1 = a1 * h1 + bfhi(bb[i]); P1 *= a1; ho[i] = pk2(h0, h1); po[i] = pk2(P0, P1); }
#pragma unroll
            for (int i = 0; i < 8; ++i) { const size_t o = base + (size_t)(j0 + i) * 512; *(unsigned*)(LA + o) = ho[i]; *(unsigned*)(BBs + o) = po[i]; }
#pragma unroll
            for (int i = 0; i < 8; ++i) { la[i] = lan[i]; bb[i] = bbn[i]; }
        }
        *(f32x2*)(AE + (size_t)ck * 512 + 2 * cp) = (f32x2){P0, P1}; *(f32x2*)(HE + (size_t)ck * 512 + 2 * cp) = (f32x2){h0, h1};
    }
}
__device__ __forceinline__ void phase_scan(const Ctx& c) {
    u32x4* KV = (u32x4*)(c.ws + S_KV);
    for (int i = c.bid * 512 + c.tid; i < 64 * 2048; i += c.G * 512) { const int bh = i >> 11, e = i & 2047; const float cd = exp2f(ret_log2g(bh & 3) * 128.0f);
        float st[8];
#pragma unroll
        for (int q = 0; q < 8; ++q) st[q] = 0.f;
        u32x4* p = KV + (size_t)bh * 32 * 2048 + e;
#pragma unroll 8
        for (int n = 0; n < 32; ++n) { const u32x4 v = p[(size_t)n * 2048]; u32x4 o; o.x = pk2(st[0], st[1]); o.y = pk2(st[2], st[3]); o.z = pk2(st[4], st[5]); o.w = pk2(st[6], st[7]); p[(size_t)n * 2048] = o;
            st[0] = st[0] * cd + bflo(v.x); st[1] = st[1] * cd + bfhi(v.x); st[2] = st[2] * cd + bflo(v.y); st[3] = st[3] * cd + bfhi(v.y); st[4] = st[4] * cd + bflo(v.z); st[5] = st[5] * cd + bfhi(v.z); st[6] = st[6] * cd + bflo(v.w); st[7] = st[7] * cd + bfhi(v.w); } }
    float* AE = (float*)(c.ws + S_RGC); float* HE = AE + 262144; float* CI = HE + 262144;
    for (int i = c.bid * 512 + c.tid; i < NBATCH * 512; i += c.G * 512) { const int b = i >> 9, ch = i & 511; float cr = 0.f;
        for (int n = 0; n < 32; ++n) { const size_t o = (size_t)(b * 32 + n) * 512 + ch; CI[o] = cr; cr = AE[o] * cr + HE[o]; } }
}
__device__ __forceinline__ void frag_tr8(bf16x8 (&out)[8], const lds_t* X, int pitchB, int rbase, int hrows, int fr) {
    const int q = fr >> 2, p = fr & 3;
    const unsigned a0 = (unsigned)(size_t)X + (unsigned)((rbase + q) * pitchB + 4 * p * 2), a1 = a0 + (unsigned)(hrows * pitchB);
    u16x4 lo[8], hi[8];
    asm volatile("ds_read_b64_tr_b16 %0, %16\n\tds_read_b64_tr_b16 %1, %16 offset:32\n\tds_read_b64_tr_b16 %2, %16 offset:64\n\tds_read_b64_tr_b16 %3, %16 offset:96\n\t"
                 "ds_read_b64_tr_b16 %4, %16 offset:128\n\tds_read_b64_tr_b16 %5, %16 offset:160\n\tds_read_b64_tr_b16 %6, %16 offset:192\n\tds_read_b64_tr_b16 %7, %16 offset:224\n\t"
                 "ds_read_b64_tr_b16 %8, %17\n\tds_read_b64_tr_b16 %9, %17 offset:32\n\tds_read_b64_tr_b16 %10, %17 offset:64\n\tds_read_b64_tr_b16 %11, %17 offset:96\n\t"
                 "ds_read_b64_tr_b16 %12, %17 offset:128\n\tds_read_b64_tr_b16 %13, %17 offset:160\n\tds_read_b64_tr_b16 %14, %17 offset:192\n\tds_read_b64_tr_b16 %15, %17 offset:224\n\ts_waitcnt lgkmcnt(0)"
                 : "=&v"(lo[0]), "=&v"(lo[1]), "=&v"(lo[2]), "=&v"(lo[3]), "=&v"(lo[4]), "=&v"(lo[5]), "=&v"(lo[6]), "=&v"(lo[7]),
                   "=&v"(hi[0]), "=&v"(hi[1]), "=&v"(hi[2]), "=&v"(hi[3]), "=&v"(hi[4]), "=&v"(hi[5]), "=&v"(hi[6]), "=&v"(hi[7])
                 : "v"(a0), "v"(a1) : "memory");
#pragma unroll
    for (int i = 0; i < 8; ++i) { bf16x8 r; r[0] = (short)lo[i][0]; r[1] = (short)lo[i][1]; r[2] = (short)lo[i][2]; r[3] = (short)lo[i][3]; r[4] = (short)hi[i][0]; r[5] = (short)hi[i][1]; r[6] = (short)hi[i][2]; r[7] = (short)hi[i][3]; out[i] = r; }
}
__device__ __forceinline__ void phase_mix2(const Ctx& c) {
    const int tid = c.tid, lane = c.lane, wave = c.wave, fr = lane & 15, fq = lane >> 4;
    const bf16_t* H = (const bf16_t*)(c.ws + S_H7); const bf16_t* KV = (const bf16_t*)(c.ws + S_KV); bf16_t* BR = (bf16_t*)(c.ws + S_BR);
    const bf16_t* HL = (const bf16_t*)(c.ws + S_LA); const bf16_t* PP = (const bf16_t*)(c.ws + S_BB); const float* CI = (const float*)(c.ws + S_RGC) + 2 * 262144;
    lds_t* LK = c.lds; lds_t* LV = c.lds + 128 * TP; lds_t* LP = c.lds + 256 * TP;
    for (int p = c.bid; p < NPANEL; p += c.G) {
        const int b = p >> 4, t0 = p * 256;
        u32x4 kraw[4], vraw[4], praw[4];
        {
            const int n0 = (p & 15) * 2;
#pragma unroll
            for (int it = 0; it < 4; ++it) { const int v = tid + it * 512, r = v >> 4, cb = v & 15; kraw[it] = *(const u32x4*)(H + (size_t)(t0 + r) * HW + 512 + cb * 8); vraw[it] = *(const u32x4*)(H + (size_t)(t0 + r) * HW + 1024 + cb * 8); }
            if (n0 > 0) { const bf16_t* kvp = KV + ((size_t)((b * 4 + 0) * 32 + n0)) * 16384;
#pragma unroll
                for (int it = 0; it < 4; ++it) { const int v = tid + it * 512; praw[it] = *(const u32x4*)(kvp + (size_t)v * 8); } }
        }
#pragma unroll 1
        for (int u = 0; u < 8; ++u) {
            const int cc = u >> 2, h = u & 3, n = (p & 15) * 2 + cc, tc = t0 + cc * 128; const float l2g = ret_log2g(h);
            bf16x8 qf[4];
#pragma unroll
            for (int d = 0; d < 4; ++d) qf[d] = *(const bf16x8*)(H + (size_t)(tc + wave * 16 + fr) * HW + h * 128 + d * 32 + 8 * fq);
            u32x2 gv[8];
#pragma unroll
            for (int i = 0; i < 8; ++i) gv[i] = *(const u32x2*)(H + (size_t)(tc + wave * 16 + fr) * HW + 1536 + h * 128 + i * 16 + 4 * fq);
            __syncthreads();
#pragma unroll
            for (int it = 0; it < 4; ++it) { const int v = tid + it * 512, r = v >> 4, cb = v & 15; *(LAS u32x4*)(LK + r * TP + cb * 16) = kraw[it]; *(LAS u32x4*)(LV + r * TP + cb * 16) = vraw[it]; }
            if (n > 0) {
#pragma unroll
                for (int it = 0; it < 4; ++it) { const int v = tid + it * 512, r = v >> 4, cb = v & 15; *(LAS u32x4*)(LP + r * TP + cb * 16) = praw[it]; } }
            __syncthreads();
            if (u < 7) {
                const int u2 = u + 1, cc2 = u2 >> 2, h2 = u2 & 3, tc2 = t0 + cc2 * 128, n2 = (p & 15) * 2 + cc2;
#pragma unroll
                for (int it = 0; it < 4; ++it) { const int v = tid + it * 512, r = v >> 4, cb = v & 15; kraw[it] = *(const u32x4*)(H + (size_t)(tc2 + r) * HW + 512 + h2 * 128 + cb * 8); vraw[it] = *(const u32x4*)(H + (size_t)(tc2 + r) * HW + 1024 + h2 * 128 + cb * 8); }
                if (n2 > 0) { const bf16_t* kvp = KV + ((size_t)((b * 4 + h2) * 32 + n2)) * 16384;
#pragma unroll
                    for (int it = 0; it < 4; ++it) { const int v = tid + it * 512; praw[it] = *(const u32x4*)(kvp + (size_t)v * 8); } }
            }
            const float gc = exp2f(l2g * (float)fr);
            float gj[4];
#pragma unroll
            for (int r = 0; r < 4; ++r) gj[r] = exp2f(-l2g * (float)(4 * fq + r));
            bf16x8 sb[4];
#pragma unroll
            for (int s = 0; s < 4; ++s) {
                u32x2 half[2];
#pragma unroll
                for (int hh = 0; hh < 2; ++hh) { const int jt = 2 * s + hh; f32x4 st = (f32x4){0.f, 0.f, 0.f, 0.f};
                    if (jt <= wave) {
#pragma unroll
                        for (int d = 0; d < 4; ++d) { const bf16x8 a = frag_row(LK, TP, jt * 16, d * 32, fr, fq); st = mfma16(a, qf[d], st); }
                        const float gt = gc * exp2f(l2g * (float)(16 * (wave - jt)));
#pragma unroll
                        for (int r = 0; r < 4; ++r) { const bool ok = (jt < wave) || (4 * fq + r <= fr); st[r] = ok ? st[r] * gt * gj[r] : 0.f; } }
                    half[hh].x = pk2(st[0], st[1]); half[hh].y = pk2(st[2], st[3]); }
                const u32x4 w = (u32x4){half[0].x, half[0].y, half[1].x, half[1].y}; sb[s] = __builtin_bit_cast(bf16x8, w);
            }
            f32x4 o[8];
#pragma unroll
            for (int i = 0; i < 8; ++i) o[i] = (f32x4){0.f, 0.f, 0.f, 0.f};
            if (n > 0) {
#pragma unroll
                for (int d = 0; d < 4; ++d)
#pragma unroll
                    for (int i = 0; i < 8; ++i) { const bf16x8 a = frag_row(LP, TP, i * 16, d * 32, fr, fq); o[i] = mfma16(a, qf[d], o[i]); }
                const float qd = exp2f(l2g * (float)(wave * 16 + fr + 1));
#pragma unroll
                for (int i = 0; i < 8; ++i) o[i] = o[i] * qd;
            }
#pragma unroll
            for (int s = 0; s < 4; ++s) if (2 * s <= wave) { bf16x8 vt[8]; frag_tr8(vt, LV, TP, 32 * s + 4 * fq, 16, fr);
#pragma unroll
                for (int i = 0; i < 8; ++i) o[i] = mfma16(vt[i], sb[s], o[i]); }
            {
                float sm = 0.f;
#pragma unroll
                for (int i = 0; i < 8; ++i) sm += (o[i][0] + o[i][1]) + (o[i][2] + o[i][3]);
                sm += __shfl_xor(sm, 16); sm += __shfl_xor(sm, 32);
                const float mu = sm * (1.0f / 128.0f); float sq = 0.f;
#pragma unroll
                for (int i = 0; i < 8; ++i) { o[i] = o[i] - mu; sq += (o[i][0] * o[i][0] + o[i][1] * o[i][1]) + (o[i][2] * o[i][2] + o[i][3] * o[i][3]); }
                sq += __shfl_xor(sq, 16); sq += __shfl_xor(sq, 32);
                const float rstd = 1.0f / sqrtf(sq * (1.0f / 128.0f) + GN_EPS);
                const size_t row = (size_t)(tc + wave * 16 + fr);
#pragma unroll
                for (int i = 0; i < 8; ++i) { const int col = h * 128 + i * 16 + 4 * fq; const u32x2 g = gv[i];
                    *(unsigned*)((unsigned char*)BR + row * 3072 + col) = pk4_fp8s(bflo(g.x) * o[i][0] * rstd, bfhi(g.x) * o[i][1] * rstd, bflo(g.y) * o[i][2] * rstd, bfhi(g.y) * o[i][3] * rstd, 1.0f); }
            }
        }
#pragma unroll 4
        for (int v = tid; v < 256 * 64; v += 512) { const int r = v >> 6, c8 = v & 63; const size_t row = (size_t)(t0 + r); const int ck = (t0 + r) >> 7;
            const u32x4 hl = *(const u32x4*)(HL + row * 512 + c8 * 8), pp = *(const u32x4*)(PP + row * 512 + c8 * 8), gy = *(const u32x4*)(H + row * HW + 3072 + c8 * 8);
            const f32x4 ci0 = *(const f32x4*)(CI + (size_t)ck * 512 + c8 * 8), ci1 = *(const f32x4*)(CI + (size_t)ck * 512 + c8 * 8 + 4);
            u32x2 o; o.x = pk4_fp8s((bflo(hl.x) + bflo(pp.x) * ci0[0]) * bflo(gy.x), (bfhi(hl.x) + bfhi(pp.x) * ci0[1]) * bfhi(gy.x), (bflo(hl.y) + bflo(pp.y) * ci0[2]) * bflo(gy.y), (bfhi(hl.y) + bfhi(pp.y) * ci0[3]) * bfhi(gy.y), 1.0f);
            o.y = pk4_fp8s((bflo(hl.z) + bflo(pp.z) * ci1[0]) * bflo(gy.z), (bfhi(hl.z) + bfhi(pp.z) * ci1[1]) * bfhi(gy.z), (bflo(hl.w) + bflo(pp.w) * ci1[2]) * bflo(gy.w), (bfhi(hl.w) + bfhi(pp.w) * ci1[3]) * bfhi(gy.w), 1.0f);
            *(u32x2*)((unsigned char*)BR + row * 3072 + 1536 + c8 * 8) = o; }
    }
}

__device__ __forceinline__ void ln16_store(f32x4 (&v)[4], int lane, const f32x4 (&gg)[4], const f32x4 (&bb)[4], float* of, bf16_t* ob, unsigned char* o8 = nullptr) {
    float s = 0.f;
#pragma unroll
    for (int j = 0; j < 4; ++j) s += (v[j][0] + v[j][1]) + (v[j][2] + v[j][3]);
    const float mean = wave_sum(s) * (1.f / D); float s2 = 0.f;
#pragma unroll
    for (int j = 0; j < 4; ++j) { v[j] = v[j] - mean; s2 += (v[j][0] * v[j][0] + v[j][1] * v[j][1]) + (v[j][2] * v[j][2] + v[j][3] * v[j][3]); }
    const float rstd = 1.f / sqrtf(wave_sum(s2) * (1.f / D) + LN_EPS);
    f32x4 o[4];
#pragma unroll
    for (int j = 0; j < 4; ++j) o[j] = v[j] * rstd * gg[j] + bb[j];
    if (of) {
#pragma unroll
        for (int j = 0; j < 4; ++j) *(f32x4*)(of + 16 * lane + 4 * j) = o[j]; }
    if (ob) { u32x4 w0, w1; w0.x = pk2(o[0][0], o[0][1]); w0.y = pk2(o[0][2], o[0][3]); w0.z = pk2(o[1][0], o[1][1]); w0.w = pk2(o[1][2], o[1][3]); w1.x = pk2(o[2][0], o[2][1]); w1.y = pk2(o[2][2], o[2][3]); w1.z = pk2(o[3][0], o[3][1]); w1.w = pk2(o[3][2], o[3][3]);
        *(u32x4*)(ob + 16 * lane) = w0; *(u32x4*)(ob + 16 * lane + 8) = w1; }
    if (o8) { u32x4 w; w.x = pk4_fp8s(o[0][0], o[0][1], o[0][2], o[0][3], 1.0f); w.y = pk4_fp8s(o[1][0], o[1][1], o[1][2], o[1][3], 1.0f); w.z = pk4_fp8s(o[2][0], o[2][1], o[2][2], o[2][3], 1.0f); w.w = pk4_fp8s(o[3][0], o[3][1], o[3][2], o[3][3], 1.0f); *(u32x4*)(o8 + 16 * lane) = w; }
}
__device__ __forceinline__ void ld16_bf16(const bf16_t* row, int lane, f32x4 (&v)[4]) {
    const u32x4 a = *(const u32x4*)(row + 16 * lane), b = *(const u32x4*)(row + 16 * lane + 8);
    v[0] = (f32x4){bflo(a.x), bfhi(a.x), bflo(a.y), bfhi(a.y)}; v[1] = (f32x4){bflo(a.z), bfhi(a.z), bflo(a.w), bfhi(a.w)}; v[2] = (f32x4){bflo(b.x), bfhi(b.x), bflo(b.y), bfhi(b.y)}; v[3] = (f32x4){bflo(b.z), bfhi(b.z), bflo(b.w), bfhi(b.w)};
}
__device__ __forceinline__ void phase_ln1(const Ctx& c, bool dummy) {
    const float* g = inp(c, I_LN1G, (size_t)c.layer * D); const float* bt = inp(c, I_LN1B, (size_t)c.layer * D);
    bf16_t* xb = (bf16_t*)(c.ws + WS_XB); const bf16_t* PRE = (const bf16_t*)(c.ws + S_PRE); const int lane = c.lane;
    f32x4 gg[4], bb[4];
#pragma unroll
    for (int j = 0; j < 4; ++j) { gg[j] = *(const f32x4*)(g + 16 * lane + 4 * j); bb[j] = *(const f32x4*)(bt + 16 * lane + 4 * j); }
    int row = c.bid * 8 + c.wave; const int step = c.G * 8;
    u32x4 a = *(const u32x4*)(PRE + (size_t)row * D + 16 * lane), b = *(const u32x4*)(PRE + (size_t)row * D + 16 * lane + 8);
    for (; row < T; row += step) {
        const int nrow = row + step < T ? row + step : row;
        const u32x4 na = *(const u32x4*)(PRE + (size_t)nrow * D + 16 * lane), nb = *(const u32x4*)(PRE + (size_t)nrow * D + 16 * lane + 8);
        f32x4 v[4]; v[0] = (f32x4){bflo(a.x), bfhi(a.x), bflo(a.y), bfhi(a.y)}; v[1] = (f32x4){bflo(a.z), bfhi(a.z), bflo(a.w), bfhi(a.w)}; v[2] = (f32x4){bflo(b.x), bfhi(b.x), bflo(b.y), bfhi(b.y)}; v[3] = (f32x4){bflo(b.z), bfhi(b.z), bflo(b.w), bfhi(b.w)};
        float s = 0.f;
#pragma unroll
        for (int j = 0; j < 4; ++j) s += (v[j][0] + v[j][1]) + (v[j][2] + v[j][3]);
        const float mean = wave_sum(s) * (1.f / D); float s2 = 0.f;
#pragma unroll
        for (int j = 0; j < 4; ++j) { v[j] = v[j] - mean; s2 += (v[j][0] * v[j][0] + v[j][1] * v[j][1]) + (v[j][2] * v[j][2] + v[j][3] * v[j][3]); }
        const float rstd = 1.f / sqrtf(wave_sum(s2) * (1.f / D) + LN_EPS);
        f32x4 o[4];
#pragma unroll
        for (int j = 0; j < 4; ++j) o[j] = v[j] * rstd * gg[j] + bb[j];
        bf16_t* ob = dummy ? (bf16_t*)(c.ws + S_Y) + (size_t)row * D : xb + (size_t)row * D;
        u32x4 w0, w1; w0.x = pk2(o[0][0], o[0][1]); w0.y = pk2(o[0][2], o[0][3]); w0.z = pk2(o[1][0], o[1][1]); w0.w = pk2(o[1][2], o[1][3]); w1.x = pk2(o[2][0], o[2][1]); w1.y = pk2(o[2][2], o[2][3]); w1.z = pk2(o[3][0], o[3][1]); w1.w = pk2(o[3][2], o[3][3]);
        *(u32x4*)(ob + 16 * lane) = w0; *(u32x4*)(ob + 16 * lane + 8) = w1;
        if (!dummy) { u32x4 w; w.x = pk4_fp8s(o[0][0], o[0][1], o[0][2], o[0][3], 1.0f); w.y = pk4_fp8s(o[1][0], o[1][1], o[1][2], o[1][3], 1.0f); w.z = pk4_fp8s(o[2][0], o[2][1], o[2][2], o[2][3], 1.0f); w.w = pk4_fp8s(o[3][0], o[3][1], o[3][2], o[3][3], 1.0f);
            *(u32x4*)((unsigned char*)(c.ws + WS_XB8) + (size_t)row * D + 16 * lane) = w; }
        a = na; b = nb;
    }
}

__device__ __forceinline__ void phase_route(const Ctx& c) {
    const int layer = c.layer;
    const int lane = c.lane, wave = c.wave;
    const float* LG = (const float*)(c.ws + S_LG); unsigned* PE = (unsigned*)(c.ws + S_PE); float* GW = (float*)(c.ws + S_GW); unsigned* LIST = (unsigned*)(c.ws + S_LIST);
    LAS int* lcnt = (LAS int*)(c.lds); LAS int* lbase = lcnt + 64; LAS unsigned* ent = (LAS unsigned*)(lcnt + 128);
    const float rb = inp(c, I_RB, (size_t)layer * 64)[lane];
    for (int p = c.bid; p < NPANEL; p += c.G) {
        const int sub = p / PSUB; unsigned* gcnt = (unsigned*)(c.ws + WS_CTL) + CW_CNT + (layer * NSUB + sub) * 64;
        __syncthreads();
        if (c.tid < 64) lcnt[c.tid] = 0;
        __syncthreads();
        float lgn = LG[(size_t)(p * 256 + wave * 32) * 64 + lane];
        for (int ti = 0; ti < 32; ++ti) {
            const int tl = wave * 32 + ti, t = p * 256 + tl;
            const float lg = lgn; if (ti < 31) lgn = LG[(size_t)(t + 1) * 64 + lane]; const float sc = 1.0f / (1.0f + expf(-lg)); const float bs = sc + rb;
            float m1 = bs; int i1 = lane;
#pragma unroll
            for (int o = 1; o < 8; o <<= 1) { const float om = __shfl_xor(m1, o); const int oi = __shfl_xor(i1, o); if (om > m1 || (om == m1 && oi < i1)) { m1 = om; i1 = oi; } }
            float m2 = (lane == i1) ? -INFINITY : bs;
#pragma unroll
            for (int o = 1; o < 8; o <<= 1) m2 = fmaxf(m2, __shfl_xor(m2, o));
            const float gs = m1 + m2; const int g = lane >> 3; int grank = 0;
#pragma unroll
            for (int gg = 0; gg < 8; ++gg) { const float og = __shfl(gs, gg * 8); grank += (og > gs || (og == gs && gg < g)) ? 1 : 0; }
            unsigned key = __builtin_bit_cast(unsigned, bs); key = (key & 0x80000000u) ? ~key : (key | 0x80000000u); key = (key & ~63u) | (unsigned)(63 - lane); if (grank >= 4) key = (unsigned)(63 - lane);
            unsigned thr = 0u;
#pragma unroll 1
            for (int bit = 31; bit >= 0; --bit) { const unsigned cand = thr | (1u << bit); const int cntb = __builtin_popcountll(__ballot(key >= cand)); if (cntb >= 8) thr = cand; }
            const unsigned long long selm = __ballot(key >= thr);
            const int rank = (key >= thr) ? __builtin_popcountll(selm & ((1ull << lane) - 1ull)) : 8;
            const bool sel = rank < 8; const float ssum = wave_sum(sel ? sc : 0.f);
            if (sel) { const int ls = __hip_atomic_fetch_add(lcnt + lane, 1, __ATOMIC_RELAXED, __HIP_MEMORY_SCOPE_WORKGROUP); ent[tl * 8 + rank] = ((unsigned)lane << 16) | (unsigned)ls; GW[(size_t)t * 8 + rank] = sc / ssum * 2.5f; }
        }
        __syncthreads();
        if (c.tid < 64) lbase[c.tid] = (int)atomicAdd(gcnt + c.tid, (unsigned)lcnt[c.tid]);
        __syncthreads();
        for (int i = c.tid; i < 2048; i += 512) { const unsigned en = ent[i]; const int e = en >> 16, slot = lbase[e] + (int)(en & 0xffffu); const unsigned a = (unsigned)(p * 256) * 8u + (unsigned)i;
            __hip_atomic_store(LIST + ((size_t)sub * NEXP + e) * TSUB + slot, a, __ATOMIC_RELAXED, __HIP_MEMORY_SCOPE_AGENT);
            PE[a] = ((unsigned)e << 20) | (unsigned)slot; }
    }
}
__device__ __forceinline__ void moe_tables(const Ctx& c, int layer, int sub, LAS int* cnt, LAS int* tp) {
    const unsigned* gcnt = (const unsigned*)(c.ws + WS_CTL) + CW_CNT + (layer * NSUB + sub) * 64;
    __syncthreads();
    if (c.tid < 64) { const int n = (int)gcnt[c.tid]; cnt[c.tid] = n; int v = (n + 255) >> 8;
#pragma unroll
        for (int o = 1; o < 64; o <<= 1) { const int t = __shfl_up(v, o); if (c.tid >= o) v += t; }
        tp[c.tid + 1] = v; if (c.tid == 0) tp[0] = 0; }
    __syncthreads();
}
__device__ __forceinline__ void phase_combine(const Ctx& c, int sub, const LAS int* tp, bool last_layer, bool dummy) {
    const float* g2 = inp(c, I_LN2G, (size_t)c.layer * D); const float* b2 = inp(c, I_LN2B, (size_t)c.layer * D);
    const unsigned char* Y = (const unsigned char*)(c.ws + S_Y); const unsigned* PE = (const unsigned*)(c.ws + S_PE); const float* GWp = (const float*)(c.ws + S_GW); bf16_t* xb = (bf16_t*)(c.ws + WS_XB);
    const unsigned char* SF = (const unsigned char*)(c.ws + S_SF);
    const int lane = c.lane;
    f32x4 gg[4], bb[4];
#pragma unroll
    for (int j = 0; j < 4; ++j) { gg[j] = *(const f32x4*)(g2 + 16 * lane + 4 * j); bb[j] = *(const f32x4*)(b2 + 16 * lane + 4 * j); }
    for (int t = sub * TSUB + c.bid * 8 + c.wave; t < (sub + 1) * TSUB; t += c.G * 8) {
        f32x4 v[4]; ld16_bf16(xb + (size_t)t * D, lane, v); const u32x4 sfw = *(const u32x4*)(SF + (size_t)t * D + 16 * lane);
        unsigned pe[8]; float gw[8];
#pragma unroll
        for (int k = 0; k < 8; ++k) { pe[k] = 0; gw[k] = 0.f; }
        { const u32x4 p0 = *(const u32x4*)(PE + (size_t)t * 8), p1 = *(const u32x4*)(PE + (size_t)t * 8 + 4); const f32x4 w0 = *(const f32x4*)(GWp + (size_t)t * 8) * (1.0f / Y_SCALE), w1 = *(const f32x4*)(GWp + (size_t)t * 8 + 4) * (1.0f / Y_SCALE);
          pe[0] = p0.x; pe[1] = p0.y; pe[2] = p0.z; pe[3] = p0.w; pe[4] = p1.x; pe[5] = p1.y; pe[6] = p1.z; pe[7] = p1.w; gw[0] = w0[0]; gw[1] = w0[1]; gw[2] = w0[2]; gw[3] = w0[3]; gw[4] = w1[0]; gw[5] = w1[1]; gw[6] = w1[2]; gw[7] = w1[3]; }
        u32x4 y[8];
#pragma unroll
        for (int k = 0; k < 8; ++k) { const int e = pe[k] >> 20, slot = pe[k] & 0xfffffu; const size_t R = (size_t)tp[e] * 256 + slot; y[k] = *(const u32x4*)(Y + R * D + 16 * lane); }
#pragma unroll
        for (int j = 0; j < 4; ++j) { const unsigned w = j == 0 ? sfw.x : (j == 1 ? sfw.y : (j == 2 ? sfw.z : sfw.w)); const f32x2 lo = __builtin_amdgcn_cvt_pk_f32_fp8((int)w, false), hi = __builtin_amdgcn_cvt_pk_f32_fp8((int)w, true);
            v[j] = v[j] * ALPHA + (f32x4){lo.x, lo.y, hi.x, hi.y} * (1.0f / Y_SCALE); }
#pragma unroll
        for (int k = 0; k < 8; ++k) { const unsigned yw[4] = {y[k].x, y[k].y, y[k].z, y[k].w};
#pragma unroll
            for (int j = 0; j < 4; ++j) { const f32x2 lo = __builtin_amdgcn_cvt_pk_f32_fp8((int)yw[j], false), hi = __builtin_amdgcn_cvt_pk_f32_fp8((int)yw[j], true); v[j] = v[j] + (f32x4){lo.x, lo.y, hi.x, hi.y} * gw[k]; } }
        if (dummy) ln16_store(v, lane, gg, bb, nullptr, (bf16_t*)(c.ws + S_H7 + 876 * MiB) );
        else ln16_store(v, lane, gg, bb, last_layer ? c.out + (size_t)t * D : (float*)nullptr, last_layer ? (bf16_t*)nullptr : xb + (size_t)t * D, last_layer ? (unsigned char*)nullptr : (unsigned char*)(c.ws + WS_XB8) + (size_t)t * D);
    }
}

constexpr int NPH = 21;
__global__ void __launch_bounds__(512, 2) mk_fwd(Args args) {
    extern __shared__ __attribute__((aligned(16))) unsigned char lds_raw[];
    Ctx c0; c0.lds = (lds_t*)lds_raw; c0.tid = threadIdx.x; c0.lane = c0.tid & 63; c0.wave = __builtin_amdgcn_readfirstlane(c0.tid >> 6); c0.G = gridDim.x; c0.bid = blockIdx.x;
    c0.ws = args.ws; c0.out = args.out; c0.layer = 0;
    volatile LAS unsigned* MISC = (volatile LAS unsigned*)(c0.lds + LDS_MISC);
    LAS int* mcnt = (LAS int*)(c0.lds + LDS_MISC + 256); LAS int* mtp = mcnt + 64;
    if (c0.tid < 16) MISC[c0.tid] = 0u;
    if (c0.tid == 0) { LAS unsigned long long* pt = (LAS unsigned long long*)(c0.lds + LDS_PTAB);
#pragma unroll
        for (int i = 0; i < 27; ++i) pt[i] = (unsigned long long)args.in[i]; }
    __syncthreads();
#ifdef X7
    __builtin_amdgcn_fence(__ATOMIC_ACQUIRE, ""); asm volatile("s_waitcnt vmcnt(0)" ::: "memory"); __syncthreads();
#endif
#if MK_ONE_LAUNCH
    XcdBarrier bar = xcd_barrier_post((unsigned*)(c0.ws + WS_CTL) + CW_BAR, MISC + 8);
#define SEAM() xcd_barrier(bar)
#define LSEAM() do { asm volatile("s_waitcnt vmcnt(0)" ::: "memory"); __syncthreads(); if (c0.wave == 0) { __builtin_amdgcn_fence(__ATOMIC_ACQUIRE, "agent"); asm volatile("s_waitcnt vmcnt(0)" ::: "memory"); } __syncthreads(); } while (0)
#else
#define SEAM() do {} while (0)
#define LSEAM() do {} while (0)
#error one launch only
#endif
    const int lo = args.ph_lo, hi = args.ph_hi;
#define IN(k) (lo <= (k) && (k) < hi)
#ifndef PHSEL
#define PHSEL 0xffffffffu
#endif
#define PHS(k) ((PHSEL >> (k)) & 1u)
#ifndef REP_PH
#define REP_PH -1
#define REP_N 0
#endif
#define RP(k) for (int rep_ = 0; rep_ < ((REP_PH == (k)) ? 1 + REP_N : 1); ++rep_)
    for (int l = 0; l < DEPTH; ++l) {
        const int pb = l * NPH;
        c0.layer = l;

        if (PHS(0) && IN(pb + 0)) RP(0) { const Ctx c = fresh(c0); phase_cvt(c); SEAM(); }
        if (PHS(1) && IN(pb + 1)) RP(1) {
            const Ctx c = fresh(c0);
            PanelOrder S{(const char*)(c.ws + WS_XB8), (const char*)(c.ws + W_IN), 14, c.G, c.bid, (size_t)256 * D, (size_t)256 * D};
            EpiIn E{(bf16_t*)(c.ws + S_H7), (const unsigned*)(c.ws + WS_COS), c.lds + LDS_EPI};
            gemm_phase<EpiIn, PanelOrder, false, true>(c.lds, c.tid, D, D, S, E); SEAM(); }
        if (PHS(2) && IN(pb + 2)) RP(2) { { const Ctx c = fresh(c0); phase_mix1(c); LSEAM(); }
            { const Ctx c = fresh(c0);
              OwnOrder S{(const char*)(c.ws + S_BR), (const char*)(c.ws + W_SM), 2, c.G, c.bid, (size_t)256 * 1536 * 2, (size_t)256 * 2, (size_t)65536 * 2, 0};
              EpiPool E{(bf16_t*)(c.ws + S_BR), inp(c, I_POOLS, (size_t)c.layer * 512)};
              gemm_phase<EpiPool, OwnOrder, false>(c.lds, c.tid, 256, 1536 * 2, S, E); }
            { const Ctx c = fresh(c0);
              OwnOrder S{(const char*)(c.ws + S_BR) + 1024 * 2, (const char*)(c.ws + W_SM) + (size_t)2 * 65536 * 2, 4, c.G, c.bid, (size_t)256 * 1536 * 2, (size_t)256 * 2, (size_t)65536 * 2, 1};
              EpiRG E{(const bf16_t*)(c.ws + S_BR), (bf16_t*)(c.ws + S_LA), (bf16_t*)(c.ws + S_BB), inp(c, I_BA, (size_t)c.layer * 512), inp(c, I_BX, (size_t)c.layer * 512), (const float*)(c.ws + W_SM + 768 * 1024)};
              gemm_phase<EpiRG, OwnOrder, false>(c.lds, c.tid, 256, 1536 * 2, S, E); }
            LSEAM(); }
        if (PHS(3) && IN(pb + 3)) RP(3) { const Ctx c = fresh(c0); phase_rgscan(c); SEAM(); }
        if (PHS(4) && IN(pb + 4)) RP(4) { const Ctx c = fresh(c0); phase_scan(c); SEAM(); }
        if (PHS(5) && IN(pb + 5)) RP(5) { const Ctx c = fresh(c0); phase_mix2(c); SEAM(); }
        if (PHS(6) && IN(pb + 6)) RP(6) {
            const Ctx c = fresh(c0);
            PanelOrder S{(const char*)(c.ws + WS_XB8), (const char*)(c.ws + W_IN) + (size_t)HW * D, 12, c.G, c.bid, (size_t)256 * D, (size_t)256 * D};
            EpiGates E{(unsigned char*)(c.ws + S_H7), inp(c, I_GATEB, (size_t)c.layer * 3 * D)};
            gemm_phase<EpiGates, PanelOrder, false, true>(c.lds, c.tid, D, D, S, E); SEAM(); }
#if 1
        if (PHS(7) && IN(pb + 7)) RP(7) {
            const Ctx c = fresh(c0);
            MergeOrder S{(const char*)(c.ws + S_BR), (const char*)(c.ws + W_BR), c.G, c.bid, -1};
            EpiMerge E{(bf16_t*)(c.ws + S_MG), (const unsigned char*)(c.ws + S_H7), (unsigned char*)(c.ws + S_KV + 64 * MiB)};
            gemm_phase<EpiMerge, MergeOrder, false, true>(c.lds, c.tid, 512, 3072, S, E, MX_WG); SEAM(); }
#else
        for (int i = 0; i < 3; ++i) if (PHS(7) && IN(pb + 7 + i)) {
            const Ctx c = fresh(c0);
            MergeOrder S{(const char*)(c.ws + S_BR), (const char*)(c.ws + W_BR), c.G, c.bid, i};
            EpiMerge E{(bf16_t*)(c.ws + S_MG), (const unsigned char*)(c.ws + S_H7), (unsigned char*)(c.ws + S_KV + 64 * MiB)};
            gemm_phase<EpiMerge, MergeOrder, false, true>(c.lds, c.tid, 512, 3072, S, E, MX_WG); if (i == 2) SEAM(); }
#endif
        if (PHS(10) && IN(pb + 10)) RP(10) {
            const Ctx c = fresh(c0);
            PanelOrder S{(const char*)(c.ws + S_KV + 64 * MiB), (const char*)(c.ws + W_OUT), 4, c.G, c.bid, (size_t)256 * D, (size_t)256 * D};
            EpiResB E{rep_ > 0 ? (bf16_t*)(c.ws + S_Y) : (bf16_t*)(c.ws + S_PRE), (const bf16_t*)(c.ws + WS_XB), ALPHA};
            gemm_phase<EpiResB, PanelOrder, false, true>(c.lds, c.tid, D, D, S, E); SEAM(); }
        if (PHS(11) && IN(pb + 11)) RP(11) { const Ctx c = fresh(c0); phase_ln1(c, rep_ > 0); SEAM(); }
        if (PHS(12) && IN(pb + 12)) RP(12) {
            const Ctx c = fresh(c0);
            PanelOrder S{(const char*)(c.ws + WS_XB), (const char*)(c.ws + W_SHUP), 3, c.G, c.bid, (size_t)256 * D * 2, (size_t)256 * D * 2};
            EpiGLU E{(unsigned char*)(c.ws + S_HS), (float*)(c.ws + S_LG), false};
            gemm_phase<EpiGLU, PanelOrder, false>(c.lds, c.tid, D, D * 2, S, E); SEAM(); }
        if (PHS(14) && IN(pb + 13)) RP(14) {
            const Ctx c = fresh(c0);
            PanelOrder S{(const char*)(c.ws + S_HS), (const char*)(c.ws + W_SHDN), 4, c.G, c.bid, (size_t)256 * DEXP, (size_t)256 * DEXP};
            EpiExpDown E{(unsigned char*)(c.ws + S_SF)};
            gemm_phase<EpiExpDown, PanelOrder, false, true>(c.lds, c.tid, DEXP, DEXP, S, E); }
        if (PHS(13) && IN(pb + 14)) RP(13) { const Ctx c = fresh(c0); phase_route(c); SEAM(); }
        for (int s = 0; s < NSUB; ++s) {
            if (PHS(15) && IN(pb + 15 + 3 * s)) RP(15) { const Ctx c = fresh(c0); moe_tables(c, c.layer, s, mcnt, mtp);
                const unsigned* list = (const unsigned*)(c.ws + S_LIST) + (size_t)s * NEXP * TSUB;
                MoeOrder S{(const char*)(c.ws + WS_XB8), (const char*)(c.ws + W_E13), 2, c.G, c.bid, (size_t)512 * D, (size_t)256 * D, 0, mtp, mcnt, list, true, c.lane};
                EpiGLU E{(unsigned char*)(c.ws + S_HE), nullptr, true};
                gemm_phase<EpiGLU, MoeOrder, true, true>(c.lds, c.tid, D, D, S, E); SEAM(); }
            if (PHS(16) && IN(pb + 16 + 3 * s)) RP(16) { const Ctx c = fresh(c0); moe_tables(c, c.layer, s, mcnt, mtp);
                const unsigned* list = (const unsigned*)(c.ws + S_LIST) + (size_t)s * NEXP * TSUB;
                MoeOrder S{(const char*)(c.ws + S_HE), (const char*)(c.ws + W_E2), 4, c.G, c.bid, (size_t)D * DEXP, (size_t)256 * DEXP, (size_t)256 * DEXP, mtp, mcnt, list, false, c.lane};
                EpiExpDown E{(unsigned char*)(c.ws + S_Y)};
                gemm_phase<EpiExpDown, MoeOrder, false, true>(c.lds, c.tid, DEXP, DEXP, S, E); SEAM(); }
            if (PHS(17) && IN(pb + 17 + 3 * s)) RP(17) { const Ctx c = fresh(c0); moe_tables(c, c.layer, s, mcnt, mtp); phase_combine(c, s, mtp, c.layer == DEPTH - 1, rep_ > 0); }
        }
    }
#undef IN
#ifdef X7
    asm volatile("s_waitcnt vmcnt(0)" ::: "memory"); __syncthreads(); __builtin_amdgcn_fence(__ATOMIC_RELEASE, "agent"); asm volatile("s_waitcnt vmcnt(0)" ::: "memory");
#endif
}

extern "C" void kernel_launch(void* const* d_in, const int* in_sizes, int n_in, void* d_out, int out_size, void* d_ws, size_t ws_size, hipStream_t stream) {
    static int grid = 0;
    if (grid == 0) {
        if (n_in != 27 || ws_size < WS_END) { fprintf(stderr, "kernel_launch: n_in %d ws %zu (need %zu)\n", n_in, ws_size, (size_t)WS_END); grid = -1; return; }
        if (hipFuncSetAttribute((const void*)mk_fwd, hipFuncAttributeMaxDynamicSharedMemorySize, LDS_BYTES) != hipSuccess) { fprintf(stderr, "kernel_launch: hipFuncSetAttribute failed\n"); grid = -1; return; }
        int dev = 0, cus = 0, per_cu = 0;
        hipGetDevice(&dev); hipDeviceGetAttribute(&cus, hipDeviceAttributeMultiprocessorCount, dev);
        hipOccupancyMaxActiveBlocksPerMultiprocessor(&per_cu, (const void*)mk_fwd, 512, LDS_BYTES);
        (void)hipGetLastError();
        grid = cus > 0 ? cus : 256; if (grid > 256) grid = 256;
        fprintf(stderr, "kernel_launch: grid %d (occupancy query %d per CU)\n", grid, per_cu);
    }
    if (grid < 0) return;
    hipMemsetAsync((char*)d_ws + WS_CTL, 0, 1 * MiB, stream);
    Args a{};
    for (int i = 0; i < 27; ++i) a.in[i] = d_in[i];
    a.out = (float*)d_out; a.ws = (unsigned char*)d_ws;
#if MK_ONE_LAUNCH
#ifndef MAXPH
#define MAXPH (DEPTH * NPH)
#endif
    a.ph_lo = 0; a.ph_hi = MAXPH;
    hipLaunchKernelGGL(mk_fwd, dim3(grid), dim3(512), LDS_BYTES, stream, a);
#else
#ifndef MAXPH
#define MAXPH (DEPTH * NPH)
#endif
    for (int ph = 0; ph < MAXPH; ++ph) { a.ph_lo = ph; a.ph_hi = ph + 1; hipLaunchKernelGGL(mk_fwd, dim3(grid), dim3(512), LDS_BYTES, stream, a); }
#endif
}
```

```cpp
#include <hip/hip_runtime.h>
#include <cstdio>
#include <cstdint>

#ifndef MK_ONE_LAUNCH
#define MK_ONE_LAUNCH 1
#endif
#ifndef SIMPLE_GEMM
#define SIMPLE_GEMM 0
#endif

#define LAS __attribute__((address_space(3)))
#define GAS __attribute__((address_space(1)))
typedef unsigned short bf16_t;
typedef short bf16x8 __attribute__((ext_vector_type(8)));
typedef unsigned short u16x4 __attribute__((ext_vector_type(4)));
typedef float f32x4 __attribute__((ext_vector_type(4)));
typedef float f32x2 __attribute__((ext_vector_type(2)));
typedef unsigned u32x4 __attribute__((ext_vector_type(4)));
typedef unsigned u32x2 __attribute__((ext_vector_type(2)));
typedef LAS unsigned char lds_t;

constexpr int T = 65536, D = 1024, SEQ = 4096, NBATCH = 16, DEPTH = 4;
constexpr int NPANEL = 256;
constexpr int HW = 3584;
constexpr int INW = 6656;
constexpr int NEXP = 64, DEXP = 256;
constexpr int NSUB = 1, TSUB = T / NSUB, PSUB = NPANEL / NSUB;
constexpr int ROWS_MAX = TSUB * 8 + NEXP * 256;
constexpr float ALPHA = 1.681792830507429f;
constexpr float LN_EPS = 1e-5f, GN_EPS = 1e-6f;

constexpr size_t MiB = 1u << 20;
constexpr size_t WS_CTL = 0;
constexpr size_t WS_COS = 1 * MiB, WS_SIN = 2 * MiB;
constexpr size_t WS_W = 3 * MiB;
constexpr size_t W_IN = WS_W, W_BR = WS_W + 7 * MiB, W_OUT = WS_W + 10 * MiB, W_SM = WS_W + 12 * MiB;
constexpr size_t W_SHUP = WS_W + 13 * MiB, W_SHDN = W_SHUP + 3 * MiB / 2, W_E13 = WS_W + 15 * MiB, W_E2 = WS_W + 47 * MiB;
constexpr size_t WS_XB = 82 * MiB;
constexpr size_t WS_XB8 = 210 * MiB;
constexpr size_t WS_S = 274 * MiB;
constexpr size_t S_H7 = WS_S, S_KV = WS_S + 448 * MiB, S_BR = WS_S + 576 * MiB, S_MG = WS_S + 768 * MiB, S_RGC = WS_S + 896 * MiB;
constexpr size_t S_LA = S_MG, S_BB = S_MG + 64 * MiB;
constexpr size_t S_PE = WS_S, S_GW = WS_S + 2 * MiB, S_LIST = WS_S + 4 * MiB, S_SF = WS_S + 20 * MiB;
constexpr size_t S_HE = WS_S + 84 * MiB, S_Y = WS_S + 348 * MiB;
constexpr size_t S_HS = S_HE, S_LG = S_HE + 32 * MiB;
constexpr size_t S_PRE = S_H7;
constexpr size_t WS_END = WS_S + 899 * MiB;
static_assert(S_HE + (size_t)ROWS_MAX * 512 <= S_Y && S_Y + (size_t)ROWS_MAX * 1024 <= WS_END && S_SF + (size_t)T * D <= S_HE, "moe scratch");
constexpr int CW_BAR = 4096;
constexpr int CW_CNT = 16384;

constexpr int LDS_STAGE = 131072;
constexpr int LDS_MISC = 143360;
constexpr int LDS_IDX = 143360 + 1536;
constexpr int LDS_EPI = 147456;
constexpr int LDS_BYTES = 163840;

__device__ __forceinline__ unsigned f2bf(float f) { unsigned u = __builtin_bit_cast(unsigned, f); return (u + 0x7fffu + ((u >> 16) & 1u)) >> 16; }
typedef __bf16 bf16x2_t __attribute__((ext_vector_type(2)));
__device__ __forceinline__ unsigned pk2(float lo, float hi) { const bf16x2_t v = __builtin_convertvector((f32x2){lo, hi}, bf16x2_t); return __builtin_bit_cast(unsigned, v); }
__device__ __forceinline__ float bf2f(unsigned short b) { return __builtin_bit_cast(float, (unsigned)b << 16); }
__device__ __forceinline__ float bflo(unsigned w) { return __builtin_bit_cast(float, w << 16); }
__device__ __forceinline__ float bfhi(unsigned w) { return __builtin_bit_cast(float, w & 0xffff0000u); }
__device__ __forceinline__ float sigmoidf_(float x) { return __builtin_amdgcn_rcpf(1.0f + __expf(-x)); }
__device__ __forceinline__ float siluf_(float x) { return x * __builtin_amdgcn_rcpf(1.0f + __expf(-x)); }
__device__ __forceinline__ float gelu_tanh(float x) { const float u = 0.7978845608028654f * (x + 0.044715f * x * x * x); return x * __builtin_amdgcn_rcpf(1.0f + __expf(-2.0f * u)); }
__device__ __forceinline__ float wave_sum(float v) {
#pragma unroll
    for (int o = 1; o < 64; o <<= 1) v += __shfl_xor(v, o);
    return v;
}
#define LDS_WAIT() asm volatile("s_waitcnt lgkmcnt(0)" ::: "memory")
#define VM_WAIT() asm volatile("s_waitcnt vmcnt(0)" ::: "memory")

typedef int i32x8 __attribute__((ext_vector_type(8)));
typedef int i32x4 __attribute__((ext_vector_type(4)));
constexpr float W8_SCALE = 32.0f;
constexpr int MX_ONE = 0x7f7f7f7f, MX_W = 0x7a7a7a7a, MX_WG = 0x72727272;
__device__ __forceinline__ unsigned pk4_fp8s(float a, float b, float c2, float d, float s) { int w = 0; w = __builtin_amdgcn_cvt_pk_fp8_f32(a * s, b * s, w, false); w = __builtin_amdgcn_cvt_pk_fp8_f32(c2 * s, d * s, w, true); return (unsigned)w; }
__device__ __forceinline__ f32x4 mfma16(bf16x8 a, bf16x8 b, f32x4 c) { return __builtin_amdgcn_mfma_f32_16x16x32_bf16(a, b, c, 0, 0, 0); }
__device__ __forceinline__ bf16x8 frag_row(const lds_t* X, int pitchB, int r0, int k0, int fr, int fq) {
    return *(const LAS bf16x8*)(X + (r0 + fr) * pitchB + (k0 + 8 * fq) * 2);
}
__device__ __forceinline__ bf16x8 frag_col(const lds_t* X, int pitchB, int k0, int c0, int fr, int fq) {
    const int q = fr >> 2, p = fr & 3;
    const unsigned a0 = (unsigned)(size_t)X + (unsigned)((k0 + 8 * fq + q) * pitchB + (c0 + 4 * p) * 2);
    u16x4 lo, hi;
    asm volatile("ds_read_b64_tr_b16 %0, %2\n\tds_read_b64_tr_b16 %1, %3\n\ts_waitcnt lgkmcnt(0)" : "=&v"(lo), "=&v"(hi) : "v"(a0), "v"(a0 + 4u * (unsigned)pitchB) : "memory");
    bf16x8 r; r[0] = (short)lo[0]; r[1] = (short)lo[1]; r[2] = (short)lo[2]; r[3] = (short)lo[3]; r[4] = (short)hi[0]; r[5] = (short)hi[1]; r[6] = (short)hi[2]; r[7] = (short)hi[3];
    return r;
}

#define XB_TMO      128
#define XB_XCNT(j)  (256  + 64 * (j))
#define XB_XSUB(j)  (1280 + 64 * (j))
#define XB_XGEN(j)  (2304 + 64 * (j))
#define XB_TOP      3328
#define XB_TOPGEN   3392
#define XCD_BAR_WORDS 3456
#define XB_SPIN_CAP (1u << 20)
__device__ __forceinline__ unsigned xb_ld(unsigned* p)              { return __hip_atomic_load(p, __ATOMIC_RELAXED, __HIP_MEMORY_SCOPE_AGENT); }
__device__ __forceinline__ unsigned xb_add(unsigned* p, unsigned v) { return __hip_atomic_fetch_add(p, v, __ATOMIC_RELAXED, __HIP_MEMORY_SCOPE_AGENT); }
__device__ __forceinline__ unsigned xb_xcc_id() { return (unsigned)__builtin_amdgcn_s_getreg((3 << 11) | 20) & 0xFu; }
#define XB_SPIN(cond, bar) do { unsigned _sp = 0; while (cond) { __builtin_amdgcn_s_sleep(1); \
    if ((++_sp & 255u) == 0u) { if (xb_ld(&(bar)[XB_TMO])) break; if (_sp > XB_SPIN_CAP) { atomicAdd(&(bar)[XB_TMO], 1u); break; } } } } while (0)
struct XcdBarrier { unsigned* bar; unsigned x; volatile LAS unsigned* st; };
__device__ __forceinline__ XcdBarrier xcd_barrier_post(unsigned* bar, volatile LAS unsigned* st) {
    XcdBarrier b; b.bar = bar; b.x = xb_xcc_id(); b.st = st;
    if (threadIdx.x == 0) (void)xb_add(&bar[XB_XCNT(b.x)], 1u);
    return b;
}
__device__ __forceinline__ void xcd_barrier_complete(unsigned* bar, unsigned x, unsigned& nloc, unsigned& nx) {
    const unsigned G = gridDim.x * gridDim.y * gridDim.z;
    unsigned sum, cnt, mine, sp = 0u;
    for (;;) {
        sum = 0u; cnt = 0u; mine = 0u;
#pragma unroll
        for (unsigned j = 0; j < 16; ++j) { const unsigned c = xb_ld(&bar[XB_XCNT(j)]); sum += c; cnt += (c > 0u) ? 1u : 0u; mine = (j == x) ? c : mine; }
        if (sum == G) break;
        __builtin_amdgcn_s_sleep(1);
        if ((++sp & 255u) == 0u) { if (xb_ld(&bar[XB_TMO])) break; if (sp > XB_SPIN_CAP) { atomicAdd(&bar[XB_TMO], 1u); break; } }
    }
    nloc = mine > 0u ? mine : 1u; nx = cnt > 0u ? cnt : 1u;
}
__device__ __forceinline__ void xcd_barrier(const XcdBarrier& b) {
    asm volatile("s_waitcnt vmcnt(0)" ::: "memory");
    __syncthreads();
    if (threadIdx.x == 0) {
        unsigned* bar = b.bar;
        __builtin_amdgcn_s_waitcnt(0);
        unsigned nloc = b.st[0], nx = b.st[1];
        if (nloc == 0u) { xcd_barrier_complete(bar, b.x, nloc, nx); b.st[0] = nloc; b.st[1] = nx; }
        const unsigned old = xb_add(&bar[XB_XSUB(b.x)], 1u);
        const unsigned gen = old / nloc;
        if (old + 1u == (gen + 1u) * nloc) {
            __builtin_amdgcn_fence(__ATOMIC_RELEASE, "agent");
            asm volatile("s_waitcnt vmcnt(0)" ::: "memory");
            const unsigned og = xb_add(&bar[XB_TOP], 1u);
            const unsigned tg = og / nx;
            if (og + 1u == (tg + 1u) * nx) xb_add(&bar[XB_TOPGEN], 1u);
            else XB_SPIN(xb_ld(&bar[XB_TOPGEN]) == tg, bar);
            __builtin_amdgcn_fence(__ATOMIC_ACQUIRE, "agent");
            xb_add(&bar[XB_XGEN(b.x)], 1u);
            asm volatile("s_waitcnt vmcnt(0)" ::: "memory");
        } else {
            XB_SPIN(xb_ld(&bar[XB_XGEN(b.x)]) == gen, bar);
            __builtin_amdgcn_fence(__ATOMIC_ACQUIRE, "agent");
            asm volatile("s_waitcnt vmcnt(0)" ::: "memory");
        }
    }
    __syncthreads();
}

struct GUnit { const char* A; const char* B; int x, y, z, w; };

constexpr int BK = 64, HALF = 128, HTB = HALF * BK * 2;
__host__ __device__ __forceinline__ int lds_byte(int r, int c) { const int st = (r >> 4) * 2 + (c >> 5), rr = r & 15, cc = c & 31, ob = rr * 64 + cc * 2; return st * 1024 + (ob ^ (((ob >> 9) & 1) << 5)); }
__host__ __device__ __forceinline__ int perm32(int rho) { const int n = rho >> 4, i = rho & 15; return 8 * (i >> 2) + 4 * n + (i & 3); }
__host__ __device__ __forceinline__ void stage_rc(int b, int& R, int& C) { const int st = b / 1024, sb = b % 1024, swz = sb ^ (((sb >> 9) & 1) << 5); R = (st >> 1) * 16 + swz / 64; C = (st & 1) * 32 + (swz % 64) / 2; }

#if SIMPLE_GEMM
template <class Epi, class Sched, bool GATHER, bool F8 = false>
__device__ __forceinline__ void gemm_phase(lds_t* lds, const int tid, const int K, const unsigned ldaB, const Sched& S, const Epi& E) {
    const int wid = __builtin_amdgcn_readfirstlane(tid >> 6), lane = tid & 63, wr = wid >> 2, wc = wid & 3, fr = lane & 15, fq = lane >> 4;
    GUnit cur;
    for (int ui = 0; S.next(ui, cur); ++ui) {
        f32x4 acc[2][2][4][2];
#pragma unroll
        for (int a = 0; a < 2; ++a)
#pragma unroll
            for (int b = 0; b < 2; ++b)
#pragma unroll
                for (int m = 0; m < 4; ++m)
#pragma unroll
                    for (int n = 0; n < 2; ++n) acc[a][b][m][n] = (f32x4){0.f, 0.f, 0.f, 0.f};
        unsigned ao[2][4], bo[2][2];
#pragma unroll
        for (int ai = 0; ai < 2; ++ai)
#pragma unroll
            for (int m = 0; m < 4; ++m) { const int r = ai * HALF + wr * 64 + m * 16 + fr; const unsigned ro = GATHER ? (unsigned)S.gather_row(cur, r) : (unsigned)r; ao[ai][m] = ro * ldaB + fq * 16; }
#pragma unroll
        for (int bj = 0; bj < 2; ++bj)
#pragma unroll
            for (int n = 0; n < 2; ++n) { const int r = bj * HALF + wc * 32 + n * 16 + fr; bo[bj][n] = (unsigned)(r * K * 2 + fq * 16); }
#pragma unroll 1
        for (int k0 = 0; k0 < K; k0 += 32) {
            bf16x8 af[2][4], bfr[2][2];
#pragma unroll
            for (int ai = 0; ai < 2; ++ai)
#pragma unroll
                for (int m = 0; m < 4; ++m) af[ai][m] = *(const bf16x8*)(cur.A + ao[ai][m] + k0 * 2);
#pragma unroll
            for (int bj = 0; bj < 2; ++bj)
#pragma unroll
                for (int n = 0; n < 2; ++n) bfr[bj][n] = *(const bf16x8*)(cur.B + bo[bj][n] + k0 * 2);
#pragma unroll
            for (int ai = 0; ai < 2; ++ai)
#pragma unroll
                for (int bj = 0; bj < 2; ++bj)
#pragma unroll
                    for (int m = 0; m < 4; ++m)
#pragma unroll
                        for (int n = 0; n < 2; ++n) acc[ai][bj][m][n] = mfma16(bfr[bj][n], af[ai][m], acc[ai][bj][m][n]);
        }
        E(acc, cur, wr, wc, fr, fq);
    }
}
#else
template <class Epi, class Sched, bool GATHER, bool F8 = false>
__device__ __forceinline__ void gemm_phase(lds_t* lds, const int tid, const int K, const unsigned ldaB, const Sched& S, const Epi& E, const int mxw = MX_W) {
    const int wid = __builtin_amdgcn_readfirstlane(tid >> 6), lane = tid & 63, wr = wid >> 2, wc = wid & 3, fr = lane & 15, fq = lane >> 4;
    const int KB = F8 ? K : K * 2;
    const int nt = KB / 128;
    unsigned voffB[2], voffA[2][2];
#pragma unroll
    for (int i = 0; i < 2; ++i) { int sR, sC; stage_rc(tid * 16 + i * 8192, sR, sC); int Rb;
        if (Epi::PERM == 2) { const int rho = sR & 31; Rb = 64 * (sR >> 5) + 16 * ((rho & 15) >> 2) + 4 * (rho >> 4) + (rho & 3); }
        else Rb = (Epi::PERM == 1 ? ((sR & ~31) + perm32(sR & 31)) : sR);
        voffB[i] = (unsigned)(Rb * KB + sC * 2); }
    const size_t kstep = (size_t)(BK * 2);
    const size_t hstepB = (size_t)(Epi::PERM == 2 ? 8 : HALF) * KB;
    const size_t hstepA = (size_t)HALF * ldaB;
    const unsigned ldsw = (unsigned)wid * 1024u;
    const int aoff = lds_byte(wr * 64 + fr, fq * 8), boff = lds_byte(wc * 32 + fr, fq * 8);
    constexpr int koffA = 1024, koffB = 1024;
#define PG8_SA(b, h) (((b) * 2 + (h)) * HTB)
#define PG8_SB(b, h) ((4 + (b) * 2 + (h)) * HTB)
#define PG8_STAGE(bufoff, gbase, voff) do { _Pragma("unroll") for (int _i = 0; _i < 2; ++_i) { unsigned _v = (voff)[_i]; asm volatile("" : "+v"(_v));   \
        __builtin_amdgcn_global_load_lds((const unsigned*)((const char*)(gbase) + _v), (LAS unsigned*)(lds + (bufoff) + ldsw + _i * 8192), 16, 0, 0); } } while (0)
#define PG8_STAGEB(b, h, gbase) PG8_STAGE(PG8_SB(b, h), (gbase) + (h) * hstepB, voffB)
#define PG8_STAGEA(b, h, gbase, vo) do { if (GATHER) { PG8_STAGE(PG8_SA(b, h), gbase, (vo)[h]); } else { PG8_STAGE(PG8_SA(b, h), (gbase) + (h) * hstepA, voffA[0]); } } while (0)
#define PG8_STAGEA1(b, gbase) do { if (GATHER) { PG8_STAGE(PG8_SA(b, 1), gbase, va1); } else { PG8_STAGE(PG8_SA(b, 1), (gbase) + hstepA, voffA[0]); } } while (0)
#define PG8_RD16(off) (*(const LAS i32x4*)(lds + (off)))
#define PG8_LDA(dst, b, h) do { _Pragma("unroll") for (int m = 0; m < 4; ++m) { if (F8) { const i32x4 _l = PG8_RD16(PG8_SA(b, h) + aoff + m * 2048), _h = PG8_RD16(PG8_SA(b, h) + aoff + m * 2048 + koffA); dst##8[m] = __builtin_shufflevector(_l, _h, 0, 1, 2, 3, 4, 5, 6, 7); } \
        else { _Pragma("unroll") for (int k = 0; k < 2; ++k) dst[m][k] = *(const LAS bf16x8*)(lds + PG8_SA(b, h) + aoff + m * 2048 + k * 1024); } } } while (0)
#define PG8_LDB(dst, b, h) do { _Pragma("unroll") for (int n = 0; n < 2; ++n) { if (F8) { const i32x4 _l = PG8_RD16(PG8_SB(b, h) + boff + n * 2048), _h = PG8_RD16(PG8_SB(b, h) + boff + n * 2048 + koffB); dst##8[n] = __builtin_shufflevector(_l, _h, 0, 1, 2, 3, 4, 5, 6, 7); } \
        else { _Pragma("unroll") for (int k = 0; k < 2; ++k) dst[n][k] = *(const LAS bf16x8*)(lds + PG8_SB(b, h) + boff + n * 2048 + k * 1024); } } } while (0)
#define PG8_MMA(ai, bj, At, Bt) do { __builtin_amdgcn_s_setprio(1); _Pragma("unroll") for (int m = 0; m < 4; ++m) _Pragma("unroll") for (int n = 0; n < 2; ++n) { \
        if (F8) asm volatile("v_mfma_scale_f32_16x16x128_f8f6f4 %0, %1, %2, %0, %3, %4 op_sel_hi:[0,0,0]" : "+v"(acc[ai][bj][m][n]) : "v"(Bt##8[n]), "v"(At##8[m]), "v"(sc_w), "v"(sc_x)); \
        else { _Pragma("unroll") for (int k = 0; k < 2; ++k) acc[ai][bj][m][n] = __builtin_amdgcn_mfma_f32_16x16x32_bf16(Bt[n][k], At[m][k], acc[ai][bj][m][n], 0, 0, 0); } } \
        __builtin_amdgcn_s_setprio(0); } while (0)
#define PG8_WAIT_V(n) asm volatile("s_waitcnt vmcnt(" #n ")" ::: "memory")
#define PG8_WAIT_V8R do { if (Epi::NST > 0 && relax) asm volatile("s_waitcnt vmcnt(%0)" :: "n"(8 + Epi::NST) : "memory"); else PG8_WAIT_V(8); } while (0)
#define PG8_WAIT_L(n) asm volatile("s_waitcnt lgkmcnt(" #n ")" ::: "memory")
#define PG8_BAR __builtin_amdgcn_s_barrier()
#define PG8_SCHED __builtin_amdgcn_sched_barrier(0)
#define PG8_AOFFS(dst, U) do { int _tz = tid; asm volatile("" : "+v"(_tz)); _Pragma("unroll") for (int _h = 0; _h < 2; ++_h) _Pragma("unroll") for (int _i = 0; _i < 2; ++_i) { int _R, _C; stage_rc(_tz * 16 + _i * 8192, _R, _C); \
        const unsigned _row = GATHER ? (unsigned)S.gather_row(U, _h * HALF + _R) : (unsigned)(_h * HALF + _R); dst[_h][_i] = _row * ldaB + (unsigned)_C * 2u; } } while (0)
    GUnit cur, nxt; int ui = 0;
    if (!S.next(0, cur)) return;
    f32x4 acc[2][2][4][2];
#pragma unroll
    for (int a = 0; a < 2; ++a)
#pragma unroll
        for (int b = 0; b < 2; ++b)
#pragma unroll
            for (int m = 0; m < 4; ++m)
#pragma unroll
                for (int n = 0; n < 2; ++n) acc[a][b][m][n] = (f32x4){0.f, 0.f, 0.f, 0.f};
    int sc_w = mxw, sc_x = MX_ONE; asm volatile("" : "+v"(sc_w), "+v"(sc_x));
    bf16x8 At[4][2], B0[2][2], B1[2][2]; i32x8 At8[4], B08[2], B18[2];
    const char* cA = cur.A; const char* cB = cur.B;
    PG8_AOFFS(voffA, cur);
    PG8_STAGEB(0, 0, cB); PG8_STAGEB(0, 1, cB); PG8_STAGEA(0, 0, cA, voffA); PG8_STAGEA(0, 1, cA, voffA);
    if (wr == 1) PG8_BAR;
    PG8_WAIT_V(2); PG8_BAR;
    PG8_STAGEB(1, 0, cB + kstep); PG8_STAGEA(1, 0, cA + kstep, voffA); PG8_STAGEB(1, 1, cB + kstep);
    PG8_WAIT_V(6); PG8_BAR;
    for (;;) {
        const bool has_next = S.next(ui + 1, nxt);
        const char* nA = has_next ? nxt.A : cA; const char* nB = has_next ? nxt.B : cB;
        if (has_next && GATHER) {
            if (wid < 4) __builtin_amdgcn_global_load_lds(S.idx_ptr(nxt, (wid & 3) * 64 + lane), (LAS unsigned*)(lds + LDS_IDX + ((ui + 1) & 1) * 1024 + (wid & 3) * 256), 4, 0, 0);
        }
#pragma unroll 1
        for (int t = 0; t < nt; t += 2) {
            const bool last = (t == nt - 2);
            const bool relax = (t == 0) && (ui > 0);
            const char* a1 = cA + (size_t)(t + 1) * kstep;
            const char* a2 = last ? nA : cA + (size_t)(t + 2) * kstep; const char* b2 = last ? nB : cB + (size_t)(t + 2) * kstep;
            const char* a3 = a2 + kstep; const char* b3 = b2 + kstep;
            unsigned va1[2] = {voffA[1][0], voffA[1][1]};
            if (GATHER && last && has_next) {
                int _tz = tid; asm volatile("" : "+v"(_tz));
#pragma unroll
                for (int _h = 0; _h < 2; ++_h)
#pragma unroll
                    for (int _i = 0; _i < 2; ++_i) { int _R, _C; stage_rc(_tz * 16 + _i * 8192, _R, _C);
                        const unsigned _a = *(const LAS unsigned*)(lds + LDS_IDX + ((ui + 1) & 1) * 1024 + (_h * HALF + _R) * 4); voffA[_h][_i] = (_a >> 3) * ldaB + (unsigned)_C * 2u; } }
            PG8_LDB(B0, 0, 0); PG8_LDB(B1, 0, 1); PG8_SCHED; PG8_LDA(At, 0, 0); PG8_STAGEA1(1, a1);
            PG8_WAIT_V8R; PG8_WAIT_L(0); PG8_BAR; PG8_MMA(0, 0, At, B0); PG8_MMA(0, 1, At, B1); PG8_BAR; PG8_SCHED;
            PG8_LDA(At, 0, 1); PG8_STAGEB(0, 0, b2); PG8_STAGEB(0, 1, b2); PG8_STAGEA(0, 0, a2, voffA);
            PG8_WAIT_V8R; PG8_WAIT_L(0); PG8_BAR; PG8_MMA(1, 0, At, B0); PG8_MMA(1, 1, At, B1); PG8_BAR; PG8_SCHED;
            PG8_LDB(B0, 1, 0); PG8_LDB(B1, 1, 1); PG8_SCHED; PG8_LDA(At, 1, 0); PG8_STAGEA(0, 1, a2, voffA);
            PG8_WAIT_V(8); PG8_WAIT_L(0); PG8_BAR; PG8_MMA(0, 0, At, B0); PG8_MMA(0, 1, At, B1); PG8_BAR; PG8_SCHED;
            PG8_LDA(At, 1, 1); PG8_STAGEB(1, 0, b3); PG8_STAGEB(1, 1, b3); PG8_STAGEA(1, 0, a3, voffA);
            PG8_WAIT_V(8); PG8_WAIT_L(0); PG8_BAR; PG8_MMA(1, 0, At, B0); PG8_MMA(1, 1, At, B1); PG8_BAR; PG8_SCHED;
        }
        if (wr == 0) PG8_BAR;
        if (F8) asm volatile("s_nop 15\n\ts_nop 15" ::: "memory");
        E(acc, cur, wr, wc, fr, fq);
        if (!has_next) break;
#pragma unroll
        for (int a = 0; a < 2; ++a)
#pragma unroll
            for (int b = 0; b < 2; ++b)
#pragma unroll
                for (int m = 0; m < 4; ++m)
#pragma unroll
                    for (int n = 0; n < 2; ++n) acc[a][b][m][n] = (f32x4){0.f, 0.f, 0.f, 0.f};
        cur = nxt; cA = nA; cB = nB; ++ui;
        if (wr == 1) PG8_BAR;
    }
    PG8_WAIT_V(0);
    PG8_BAR;
#undef PG8_SA
#undef PG8_SB
#undef PG8_STAGE
#undef PG8_LDA
#undef PG8_STAGEB
#undef PG8_STAGEA
#undef PG8_LDB
#undef PG8_MMA
#undef PG8_WAIT_V
#undef PG8_WAIT_L
#undef PG8_BAR
#undef PG8_SCHED
#undef PG8_AOFFS
}
#endif

struct Args { const void* in[27]; float* out; unsigned char* ws; int ph_lo, ph_hi; };
struct Ctx {
    lds_t* lds; int tid, lane, wave; int G, bid, layer;
    unsigned char* ws; float* out;
};
enum { I_X = 0, I_POS = 1, I_WIN = 2, I_GATEB = 3, I_WBR = 4, I_WOUT = 5, I_POOLW = 6, I_POOLS = 7, I_CONVW = 8, I_CONVB = 9, I_WA = 10, I_BA = 11, I_WX = 12, I_BX = 13, I_LAM = 14,
       I_LN1G = 15, I_LN1B = 16, I_RW = 17, I_RB = 18, I_EW1 = 19, I_EW3 = 20, I_EW2 = 21, I_SW1 = 22, I_SW3 = 23, I_SW2 = 24, I_LN2G = 25, I_LN2B = 26 };
constexpr int LDS_PTAB = 143360 + 1024;
__device__ __forceinline__ const float* inp(const Ctx& c, int idx, size_t off) {
    const unsigned long long v = ((const LAS unsigned long long*)(c.lds + LDS_PTAB))[idx];
    const unsigned lo = __builtin_amdgcn_readfirstlane((unsigned)v), hi = __builtin_amdgcn_readfirstlane((unsigned)(v >> 32));
    return (const float*)(const GAS float*)(((unsigned long long)hi << 32) | lo) + off;
}
__device__ __forceinline__ Ctx fresh(const Ctx& c0) {
    Ctx c = c0; int t = c0.tid; asm volatile("" : "+v"(t));
    int g = c0.G, b = c0.bid, l = c0.layer; asm volatile("" : "+s"(g), "+s"(b), "+s"(l));
    unsigned long long w = (unsigned long long)c0.ws, o = (unsigned long long)c0.out; unsigned ld = (unsigned)(size_t)c0.lds; asm volatile("" : "+s"(w), "+s"(o), "+s"(ld));
    c.tid = t; c.lane = t & 63; c.wave = __builtin_amdgcn_readfirstlane(t >> 6); c.G = g; c.bid = b; c.layer = l;
    c.ws = (unsigned char*)(GAS unsigned char*)w; c.out = (float*)(GAS float*)o; c.lds = (lds_t*)ld; return c;
}

struct PanelOrder {
    const char* A; const char* B; int NT, G, bid; size_t a_panel_bytes, b_tile_bytes;
    __device__ __forceinline__ bool next(int i, GUnit& u) const {
        const int L = i * G + bid; if (L >= NPANEL * NT) return false;
        const int wgid = (L & 7) * (NPANEL / 8 * NT) + (L >> 3); const int nig = 8 * NT, gid = wgid / nig, rem = wgid - gid * nig;
        const int p = gid * 8 + (rem & 7), pn = rem >> 3;
        u.A = A + (size_t)p * a_panel_bytes; u.B = B + (size_t)pn * b_tile_bytes; u.x = p; u.y = pn; u.z = 0; u.w = 0; return true;
    }
    __device__ __forceinline__ int gather_row(const GUnit&, int r) const { return r; }
    __device__ __forceinline__ const unsigned* idx_ptr(const GUnit&, int) const { return nullptr; }
};
struct OwnOrder {
    const char* A; const char* B; int NT, G, bid; size_t a_panel_bytes, a_tile_bytes, b_tile_bytes; int a_pair;
    __device__ __forceinline__ bool next(int i, GUnit& u) const {
        const int pi = i / NT, pn = i - pi * NT; const int p = bid + pi * G; if (p >= NPANEL) return false;
        u.A = A + (size_t)p * a_panel_bytes + (size_t)(a_pair ? (pn >> 1) : pn) * a_tile_bytes; u.B = B + (size_t)pn * b_tile_bytes; u.x = p; u.y = pn; u.z = 0; u.w = 0; return true;
    }
    __device__ __forceinline__ int gather_row(const GUnit&, int r) const { return r; }
    __device__ __forceinline__ const unsigned* idx_ptr(const GUnit&, int) const { return nullptr; }
};
struct MergeOrder {
    const char* A; const char* B; int G, bid, fixed_pass;
    __device__ __forceinline__ bool next(int i, GUnit& u) const {
        const int it = fixed_pass < 0 ? i / 3 : i, pass = fixed_pass < 0 ? i - it * 3 : fixed_pass; const int L = it * G + bid; if (L >= NPANEL * 4) return false;
        const int wgid = (L & 7) * (NPANEL / 8 * 4) + (L >> 3); const int gid = wgid >> 5, rem = wgid & 31; const int p = gid * 8 + (rem & 7), pn = rem >> 3;
        u.A = A + (size_t)p * (256 * 3072) + (pass == 0 ? 0 : (pass == 1 ? 1024 : 1536)); u.B = B + (size_t)pass * (D * 512) + (size_t)pn * (256 * 512); u.x = p; u.y = pn; u.z = pass; u.w = 0; return true;
    }
    __device__ __forceinline__ int gather_row(const GUnit&, int r) const { return r; }
    __device__ __forceinline__ const unsigned* idx_ptr(const GUnit&, int) const { return nullptr; }
};
struct MoeOrder {
    const char* A; const char* B; int NT, G, bid; size_t b_exp_bytes, b_tile_bytes, a_tile_bytes; const LAS int* tp; const LAS int* cnt; const unsigned* list; bool gather; int lane;
    __device__ __forceinline__ bool next(int i, GUnit& u) const {
#if 1
        const int lu = (bid >> 3) + (G >> 3) * i; const int tq = lu / NT, pn = lu - tq * NT; const int ti = tq * 8 + (bid & 7); const int ntile = tp[64]; if (ti >= ntile) return false;
#else
        const int g = bid + i * G; const int ti = g / NT, pn = g - ti * NT; const int ntile = tp[64]; if (ti >= ntile) return false;
#endif
        const unsigned long long m = __ballot(tp[lane + 1] > ti);
        const int e = __builtin_amdgcn_readfirstlane((int)__builtin_ctzll(m));
        const int tl = ti - tp[e];
        u.A = gather ? A : A + (size_t)ti * a_tile_bytes; u.B = B + (size_t)e * b_exp_bytes + (size_t)pn * b_tile_bytes; u.x = ti; u.y = pn; u.z = e; u.w = tl; return true;
    }
    __device__ __forceinline__ const unsigned* idx_ptr(const GUnit& u, int r) const { const int c = cnt[u.z]; int j = u.w * 256 + r; j = j < c ? j : c - 1; return list + (size_t)u.z * TSUB + j; }
    __device__ __forceinline__ int gather_row(const GUnit& u, int r) const {
        const int c = cnt[u.z]; int j = u.w * 256 + r; j = j < c ? j : c - 1;
#ifdef X6
        return r;
#endif
        return (int)(list[(size_t)u.z * TSUB + j] >> 3);
    }
};

__device__ __forceinline__ void stage_store16(lds_t* lw, unsigned char* gbase, size_t pitchB, int lane, u32x4 lo, u32x4 hi) {
    const int fr = lane & 15, fq = lane >> 4;
    *(LAS u32x4*)(lw + fr * 128 + fq * 32) = lo; *(LAS u32x4*)(lw + fr * 128 + fq * 32 + 16) = hi;
    const u32x4 a = *(const LAS u32x4*)(lw + (lane >> 3) * 128 + (lane & 7) * 16), b = *(const LAS u32x4*)(lw + (8 + (lane >> 3)) * 128 + (lane & 7) * 16);
    __builtin_nontemporal_store(a, (u32x4*)(gbase + (size_t)(lane >> 3) * pitchB + (lane & 7) * 16)); __builtin_nontemporal_store(b, (u32x4*)(gbase + (size_t)(8 + (lane >> 3)) * pitchB + (lane & 7) * 16));
}
struct EpiIn {
    static constexpr int PERM = 2; static constexpr int NST = 16;
    bf16_t* H; const unsigned* csT; lds_t* lepi;
    __device__ __forceinline__ void operator()(const f32x4 (&acc)[2][2][4][2], const GUnit& u, int wr, int wc, int fr, int fq) const {
        const int seg = u.y >> 1; const int lane = fr + 16 * fq; lds_t* lw = lepi + (wr * 4 + wc) * 2048;
        const int i0 = 32 * (wc & 1) + 8 * fq;
        u32x4 t0 = (u32x4){0u, 0u, 0u, 0u}, t1 = t0;
        if (seg < 2) { const int s0_ = (u.x * 256 + wr * 64 + fr) & (SEQ - 1); t0 = *(const u32x4*)(csT + s0_ * 64 + i0); t1 = *(const u32x4*)(csT + s0_ * 64 + i0 + 4); }
#pragma unroll
        for (int idx = 0; idx < 8; ++idx) { const int ai = idx >> 2, m = idx & 3;
                const int rg = u.x * 256 + ai * HALF + wr * 64 + m * 16;
                u32x4 t0n = t0, t1n = t1;
                if (seg < 2 && idx < 7) { const int sn = (u.x * 256 + ((idx + 1) >> 2) * HALF + wr * 64 + ((idx + 1) & 3) * 16 + fr) & (SEQ - 1); t0n = *(const u32x4*)(csT + sn * 64 + i0); t1n = *(const u32x4*)(csT + sn * 64 + i0 + 4); }
                f32x4 v0 = acc[ai][0][m][0], v1 = acc[ai][0][m][1], v2 = acc[ai][1][m][0], v3 = acc[ai][1][m][1];
#define ROPE4(X, CA, SA, CB, SB) (f32x4){((X)[0] * (CA) - (X)[1] * (SA)) * sc, ((X)[0] * (SA) + (X)[1] * (CA)) * sc, ((X)[2] * (CB) - (X)[3] * (SB)) * sc, ((X)[2] * (SB) + (X)[3] * (CB)) * sc}
#define MAP4(F, X) (f32x4){F((X)[0]), F((X)[1]), F((X)[2]), F((X)[3])}
                if (seg < 2) { const float sc = seg == 1 ? 0.08838834764831845f : 1.0f;
                    v0 = ROPE4(v0, bflo(t0.x), bfhi(t0.x), bflo(t0.y), bfhi(t0.y)); v1 = ROPE4(v1, bflo(t0.z), bfhi(t0.z), bflo(t0.w), bfhi(t0.w)); v2 = ROPE4(v2, bflo(t1.x), bfhi(t1.x), bflo(t1.y), bfhi(t1.y)); v3 = ROPE4(v3, bflo(t1.z), bfhi(t1.z), bflo(t1.w), bfhi(t1.w));
                } else if (seg == 3) { v0 = MAP4(siluf_, v0); v1 = MAP4(siluf_, v1); v2 = MAP4(siluf_, v2); v3 = MAP4(siluf_, v3); }
                else if (seg == 6) { v0 = MAP4(gelu_tanh, v0); v1 = MAP4(gelu_tanh, v1); v2 = MAP4(gelu_tanh, v2); v3 = MAP4(gelu_tanh, v3); }
#undef ROPE4
#undef MAP4
                u32x4 lo, hi; lo.x = pk2(v0[0], v0[1]); lo.y = pk2(v0[2], v0[3]); lo.z = pk2(v1[0], v1[1]); lo.w = pk2(v1[2], v1[3]); hi.x = pk2(v2[0], v2[1]); hi.y = pk2(v2[2], v2[3]); hi.z = pk2(v3[0], v3[1]); hi.w = pk2(v3[2], v3[3]);
                stage_store16(lw, (unsigned char*)(H + (size_t)rg * HW + u.y * 256 + wc * 64), (size_t)HW * 2, lane, lo, hi);
                t0 = t0n; t1 = t1n;
            }
    }
};
__device__ __forceinline__ float ub0(unsigned w) { return (float)(w & 0xffu); }
__device__ __forceinline__ float ub1(unsigned w) { return (float)((w >> 8) & 0xffu); }
__device__ __forceinline__ float ub2(unsigned w) { return (float)((w >> 16) & 0xffu); }
__device__ __forceinline__ float ub3(unsigned w) { return (float)(w >> 24); }
constexpr int GBP = 3 * D;
__device__ __forceinline__ unsigned pk4_u8(float a, float b, float c, float d) { unsigned w = 0; w = __builtin_amdgcn_cvt_pk_u8_f32(a * 255.0f, 0, w); w = __builtin_amdgcn_cvt_pk_u8_f32(b * 255.0f, 1, w); w = __builtin_amdgcn_cvt_pk_u8_f32(c * 255.0f, 2, w); w = __builtin_amdgcn_cvt_pk_u8_f32(d * 255.0f, 3, w); return w; }
struct EpiGates {
    static constexpr int PERM = 2; static constexpr int NST = 8;
    unsigned char* GB; const float* gb;
    __device__ __forceinline__ void operator()(const f32x4 (&acc)[2][2][4][2], const GUnit& u, int wr, int wc, int fr, int fq) const {
        const int colt = u.y * 256 + wc * 64 + 16 * fq;
        f32x4 bv[4];
#pragma unroll
        for (int q = 0; q < 4; ++q) bv[q] = *(const f32x4*)(gb + colt + 4 * q);
#pragma unroll
        for (int ai = 0; ai < 2; ++ai)
#pragma unroll
            for (int m = 0; m < 4; ++m) { const int row = u.x * 256 + ai * HALF + wr * 64 + m * 16 + fr;
                const f32x4 v0 = acc[ai][0][m][0] + bv[0], v1 = acc[ai][0][m][1] + bv[1], v2 = acc[ai][1][m][0] + bv[2], v3 = acc[ai][1][m][1] + bv[3];
                u32x4 w; w.x = pk4_u8(sigmoidf_(v0[0]), sigmoidf_(v0[1]), sigmoidf_(v0[2]), sigmoidf_(v0[3])); w.y = pk4_u8(sigmoidf_(v1[0]), sigmoidf_(v1[1]), sigmoidf_(v1[2]), sigmoidf_(v1[3]));
                w.z = pk4_u8(sigmoidf_(v2[0]), sigmoidf_(v2[1]), sigmoidf_(v2[2]), sigmoidf_(v2[3])); w.w = pk4_u8(sigmoidf_(v3[0]), sigmoidf_(v3[1]), sigmoidf_(v3[2]), sigmoidf_(v3[3]));
                __builtin_nontemporal_store(w, (u32x4*)(GB + (size_t)row * GBP + colt)); }
    }
};
struct EpiMerge {
    static constexpr int PERM = 2; static constexpr int NST = 16;
    bf16_t* MG; const unsigned char* GB; unsigned char* MG8;
    template <int PASS>
    __device__ __forceinline__ void run(const f32x4 (&acc)[2][2][4][2], const GUnit& u, int wr, int wc, int fr, int fq) const {
        const int row0 = u.x * 256 + wr * 64 + fr; const int colt = u.y * 256 + wc * 64 + 16 * fq;
        u32x4 g = *(const u32x4*)(GB + (size_t)row0 * GBP + PASS * D + colt), o0 = (u32x4){0u, 0u, 0u, 0u}, o1 = o0;
        if (PASS > 0) { const bf16_t* mp0 = MG + (size_t)row0 * D + colt; o0 = *(const u32x4*)mp0; o1 = *(const u32x4*)(mp0 + 8); }
#pragma unroll
        for (int idx = 0; idx < 8; ++idx) { const int ai = idx >> 2, m = idx & 3; const int row = row0 + ai * HALF + m * 16; bf16_t* mp = MG + (size_t)row * D + colt;
            u32x4 gn = g, o0n = o0, o1n = o1;
            if (idx < 7) { const int rown = row0 + ((idx + 1) >> 2) * HALF + ((idx + 1) & 3) * 16; gn = *(const u32x4*)(GB + (size_t)rown * GBP + PASS * D + colt);
                if (PASS > 0) { const bf16_t* mpn = MG + (size_t)rown * D + colt; o0n = *(const u32x4*)mpn; o1n = *(const u32x4*)(mpn + 8); } }
            const f32x4 a0 = acc[ai][0][m][0], a1 = acc[ai][0][m][1], a2 = acc[ai][1][m][0], a3 = acc[ai][1][m][1];
            f32x4 v0 = (f32x4){ub0(g.x) * a0[0], ub1(g.x) * a0[1], ub2(g.x) * a0[2], ub3(g.x) * a0[3]}, v1 = (f32x4){ub0(g.y) * a1[0], ub1(g.y) * a1[1], ub2(g.y) * a1[2], ub3(g.y) * a1[3]};
            f32x4 v2 = (f32x4){ub0(g.z) * a2[0], ub1(g.z) * a2[1], ub2(g.z) * a2[2], ub3(g.z) * a2[3]}, v3 = (f32x4){ub0(g.w) * a3[0], ub1(g.w) * a3[1], ub2(g.w) * a3[2], ub3(g.w) * a3[3]};
            if (PASS > 0) {
                v0 = v0 + (f32x4){bflo(o0.x), bfhi(o0.x), bflo(o0.y), bfhi(o0.y)}; v1 = v1 + (f32x4){bflo(o0.z), bfhi(o0.z), bflo(o0.w), bfhi(o0.w)};
                v2 = v2 + (f32x4){bflo(o1.x), bfhi(o1.x), bflo(o1.y), bfhi(o1.y)}; v3 = v3 + (f32x4){bflo(o1.z), bfhi(o1.z), bflo(o1.w), bfhi(o1.w)}; }
            if (PASS == 2) { u32x4 w8; w8.x = pk4_fp8s(v0[0], v0[1], v0[2], v0[3], 1.0f); w8.y = pk4_fp8s(v1[0], v1[1], v1[2], v1[3], 1.0f); w8.z = pk4_fp8s(v2[0], v2[1], v2[2], v2[3], 1.0f); w8.w = pk4_fp8s(v3[0], v3[1], v3[2], v3[3], 1.0f);
                *(u32x4*)(MG8 + (size_t)row * D + colt) = w8; }
            else { u32x4 w0, w1; w0.x = pk2(v0[0], v0[1]); w0.y = pk2(v0[2], v0[3]); w0.z = pk2(v1[0], v1[1]); w0.w = pk2(v1[2], v1[3]); w1.x = pk2(v2[0], v2[1]); w1.y = pk2(v2[2], v2[3]); w1.z = pk2(v3[0], v3[1]); w1.w = pk2(v3[2], v3[3]);
                *(u32x4*)mp = w0; *(u32x4*)(mp + 8) = w1; }
            g = gn; o0 = o0n; o1 = o1n; }
    }
    __device__ __forceinline__ void operator()(const f32x4 (&acc)[2][2][4][2], const GUnit& u, int wr, int wc, int fr, int fq) const {
        if (u.z == 0) run<0>(acc, u, wr, wc, fr, fq); else if (u.z == 1) run<1>(acc, u, wr, wc, fr, fq); else run<2>(acc, u, wr, wc, fr, fq);
    }
};
struct EpiPool {
    static constexpr int PERM = 1; static constexpr int NST = 0;
    bf16_t* BR; const float* scale;
    __device__ __forceinline__ void operator()(const f32x4 (&acc)[2][2][4][2], const GUnit& u, int wr, int wc, int fr, int fq) const {
        const int row0 = u.x * 256 + wr * 64 + fr; const int colt = u.y * 256 + wc * 32 + 8 * fq;
        f32x4 sv[2][2];
#pragma unroll
        for (int bj = 0; bj < 2; ++bj)
#pragma unroll
            for (int n = 0; n < 2; ++n) sv[bj][n] = *(const f32x4*)(scale + colt + bj * HALF + 4 * n);
#pragma unroll
        for (int ai = 0; ai < 2; ++ai)
#pragma unroll
            for (int m = 0; m < 4; ++m) { unsigned char* rowp = (unsigned char*)BR + (size_t)(row0 + ai * HALF + m * 16) * 3072 + 1024 + colt;
#pragma unroll
                for (int bj = 0; bj < 2; ++bj) { const f32x4 v0 = acc[ai][bj][m][0] * sv[bj][0], v1 = acc[ai][bj][m][1] * sv[bj][1];
                    u32x2 w; w.x = pk4_fp8s(v0[0], v0[1], v0[2], v0[3], 1.0f); w.y = pk4_fp8s(v1[0], v1[1], v1[2], v1[3], 1.0f); *(u32x2*)(rowp + bj * HALF) = w; } }
    }
};
struct EpiRG {
    static constexpr int PERM = 1; static constexpr int NST = 0;
    const bf16_t* BR; bf16_t* LA; bf16_t* BBs; const float* ba; const float* bx; const float* ls;
    __device__ __forceinline__ void operator()(const f32x4 (&acc)[2][2][4][2], const GUnit& u, int wr, int wc, int fr, int fq) const {
        const int row0 = u.x * 256 + wr * 64 + fr; const int ch = u.y * 128 + wc * 32 + 8 * fq;
        f32x4 bav[2], bxv[2], lsv[2];
#pragma unroll
        for (int n = 0; n < 2; ++n) { bav[n] = *(const f32x4*)(ba + ch + 4 * n); bxv[n] = *(const f32x4*)(bx + ch + 4 * n); lsv[n] = *(const f32x4*)(ls + ch + 4 * n); }
        u32x4 cw = *(const u32x4*)(BR + (size_t)row0 * 1536 + 1024 + ch);
#pragma unroll
        for (int idx = 0; idx < 8; ++idx) { const int ai = idx >> 2, m = idx & 3; const size_t row = (size_t)(row0 + ai * HALF + m * 16);
                u32x4 cwn = cw; if (idx < 7) cwn = *(const u32x4*)(BR + (size_t)(row0 + ((idx + 1) >> 2) * HALF + ((idx + 1) & 3) * 16) * 1536 + 1024 + ch);
                const float cv[8] = {bflo(cw.x), bfhi(cw.x), bflo(cw.y), bfhi(cw.y), bflo(cw.z), bfhi(cw.z), bflo(cw.w), bfhi(cw.w)};
                float la[8], bb[8];
#pragma unroll
                for (int n = 0; n < 2; ++n)
#pragma unroll
                    for (int q = 0; q < 4; ++q) { const float rr = sigmoidf_(acc[ai][0][m][n][q] + bav[n][q]), ii = sigmoidf_(acc[ai][1][m][n][q] + bxv[n][q]);
                        const float l = 8.0f * rr * lsv[n][q]; const float x2 = 2.0f * l; const float om = x2 > -0.02f ? -x2 * (1.0f + x2 * (0.5f + x2 * 0.16666667f)) : 1.0f - __expf(x2);
                        la[4 * n + q] = l; bb[4 * n + q] = __builtin_amdgcn_sqrtf(om) * (ii * cv[4 * n + q]); }
                u32x4 w; w.x = pk2(la[0], la[1]); w.y = pk2(la[2], la[3]); w.z = pk2(la[4], la[5]); w.w = pk2(la[6], la[7]); *(u32x4*)(LA + row * 512 + ch) = w;
                w.x = pk2(bb[0], bb[1]); w.y = pk2(bb[2], bb[3]); w.z = pk2(bb[4], bb[5]); w.w = pk2(bb[6], bb[7]); *(u32x4*)(BBs + row * 512 + ch) = w; cw = cwn; }
    }
};
struct EpiResB {
    static constexpr int PERM = 1; static constexpr int NST = 16;
    bf16_t* O; const bf16_t* R; float scale;
    __device__ __forceinline__ void operator()(const f32x4 (&acc)[2][2][4][2], const GUnit& u, int wr, int wc, int fr, int fq) const {
        const int row0 = u.x * 256 + wr * 64 + fr; const int colt = u.y * 256 + wc * 32 + 8 * fq;
        u32x4 r0 = (u32x4){0u, 0u, 0u, 0u}, r1 = r0;
        if (R) { const size_t off0 = (size_t)row0 * D + colt; r0 = *(const u32x4*)(R + off0); r1 = *(const u32x4*)(R + off0 + HALF); }
#pragma unroll
        for (int idx = 0; idx < 8; ++idx) { const int ai = idx >> 2, m = idx & 3; const size_t off = (size_t)(row0 + ai * HALF + m * 16) * D + colt;
            u32x4 r0n = r0, r1n = r1;
            if (R && idx < 7) { const size_t offn = (size_t)(row0 + ((idx + 1) >> 2) * HALF + ((idx + 1) & 3) * 16) * D + colt; r0n = *(const u32x4*)(R + offn); r1n = *(const u32x4*)(R + offn + HALF); }
#pragma unroll
            for (int bj = 0; bj < 2; ++bj) { f32x4 v0 = acc[ai][bj][m][0], v1 = acc[ai][bj][m][1]; const u32x4 r = bj ? r1 : r0;
                if (R) { v0 = v0 + (f32x4){bflo(r.x), bfhi(r.x), bflo(r.y), bfhi(r.y)} * scale; v1 = v1 + (f32x4){bflo(r.z), bfhi(r.z), bflo(r.w), bfhi(r.w)} * scale; }
                u32x4 w; w.x = pk2(v0[0], v0[1]); w.y = pk2(v0[2], v0[3]); w.z = pk2(v1[0], v1[1]); w.w = pk2(v1[2], v1[3]); *(u32x4*)(O + off + bj * HALF) = w; }
            r0 = r0n; r1 = r1n; }
    }
};
struct EpiGLU {
    static constexpr int PERM = 1; static constexpr int NST = 0;
    unsigned char* Hout; float* LG; bool moe;
    __device__ __forceinline__ void operator()(const f32x4 (&acc)[2][2][4][2], const GUnit& u, int wr, int wc, int fr, int fq) const {
        const int row0 = u.x * 256 + wr * 64 + fr;
        if (!moe && u.y == 2) {
            if (wc < 2) {
#pragma unroll
                for (int ai = 0; ai < 2; ++ai)
#pragma unroll
                    for (int m = 0; m < 4; ++m) { float* lp = LG + (size_t)(row0 + ai * HALF + m * 16) * 64 + wc * 32 + 8 * fq;
#pragma unroll
                        for (int n = 0; n < 2; ++n) *(f32x4*)(lp + 4 * n) = acc[ai][0][m][n]; }
            }
            return;
        }
        const int colt = u.y * 128 + wc * 32 + 8 * fq;
#pragma unroll
        for (int ai = 0; ai < 2; ++ai)
#pragma unroll
            for (int m = 0; m < 4; ++m) { unsigned char* hp = Hout + (size_t)(row0 + ai * HALF + m * 16) * DEXP + colt;
                const f32x4 a0 = acc[ai][0][m][0], b0 = acc[ai][1][m][0], a1 = acc[ai][0][m][1], b1 = acc[ai][1][m][1];
                u32x2 w; w.x = pk4_fp8s(siluf_(a0[0]) * b0[0], siluf_(a0[1]) * b0[1], siluf_(a0[2]) * b0[2], siluf_(a0[3]) * b0[3], 1.0f); w.y = pk4_fp8s(siluf_(a1[0]) * b1[0], siluf_(a1[1]) * b1[1], siluf_(a1[2]) * b1[2], siluf_(a1[3]) * b1[3], 1.0f);
                *(u32x2*)hp = w; }
    }
};
constexpr float Y_SCALE = 16.0f;
__device__ __forceinline__ unsigned pk4_fp8(f32x4 a) { int w = 0; w = __builtin_amdgcn_cvt_pk_fp8_f32(a[0] * Y_SCALE, a[1] * Y_SCALE, w, false); w = __builtin_amdgcn_cvt_pk_fp8_f32(a[2] * Y_SCALE, a[3] * Y_SCALE, w, true); return (unsigned)w; }
struct EpiExpDown {
    static constexpr int PERM = 2; static constexpr int NST = 8;
    unsigned char* Y;
    __device__ __forceinline__ void operator()(const f32x4 (&acc)[2][2][4][2], const GUnit& u, int wr, int wc, int fr, int fq) const {
        const int colt = u.y * 256 + wc * 64 + 16 * fq;
#pragma unroll
        for (int ai = 0; ai < 2; ++ai)
#pragma unroll
            for (int m = 0; m < 4; ++m) { const int r = ai * HALF + wr * 64 + m * 16 + fr;
                u32x4 w; w.x = pk4_fp8(acc[ai][0][m][0]); w.y = pk4_fp8(acc[ai][0][m][1]); w.z = pk4_fp8(acc[ai][1][m][0]); w.w = pk4_fp8(acc[ai][1][m][1]);
                *(u32x4*)(Y + (size_t)(u.x * 256 + r) * D + colt) = w; }
    }
};

template <class Map>
__device__ __forceinline__ void transpose_item(const f32x4 (&t)[8], int K, int N, bf16_t* WT, const Map& map, LAS float* scr, int item, int lane, int ldo = 0) {
    if (ldo == 0) ldo = K;
    const int nblk = N / 32, kb = item / nblk, nb = item % nblk, k0 = 64 * kb, n0 = 32 * nb;
    {
#pragma unroll
      for (int i = 0; i < 8; ++i) { LAS float* d = scr + (8 * i + (lane >> 3)) * 33 + 4 * (lane & 7); d[0] = t[i][0]; d[1] = t[i][1]; d[2] = t[i][2]; d[3] = t[i][3]; } }
    LDS_WAIT(); asm volatile("" ::: "memory");
    const int c = lane & 7;
#pragma unroll
    for (int j = 0; j < 4; ++j) { const int n = (lane >> 3) + 8 * j; const LAS float* s = scr + (8 * c) * 33 + n;
        u32x4 o; o.x = pk2(s[0 * 33], s[1 * 33]); o.y = pk2(s[2 * 33], s[3 * 33]); o.z = pk2(s[4 * 33], s[5 * 33]); o.w = pk2(s[6 * 33], s[7 * 33]);
        *(u32x4*)(WT + (size_t)map(n0 + n) * ldo + k0 + 8 * c) = o; }
    LDS_WAIT(); asm volatile("" ::: "memory");
}
template <class Map>
__device__ __forceinline__ void transpose_item8(const f32x4 (&t)[8], int K, int N, unsigned char* WT, const Map& map, LAS float* scr, int item, int lane, const float wscale = W8_SCALE) {
    const int nblk = N / 32, kb = item / nblk, nb = item % nblk, k0 = 64 * kb, n0 = 32 * nb;
    {
#pragma unroll
      for (int i = 0; i < 8; ++i) { LAS float* d = scr + (8 * i + (lane >> 3)) * 33 + 4 * (lane & 7); d[0] = t[i][0]; d[1] = t[i][1]; d[2] = t[i][2]; d[3] = t[i][3]; } }
    LDS_WAIT(); asm volatile("" ::: "memory");
    const int c = lane & 7;
#pragma unroll
    for (int j = 0; j < 4; ++j) { const int n = (lane >> 3) + 8 * j; const LAS float* s = scr + (8 * c) * 33 + n;
        u32x2 o; o.x = pk4_fp8s(s[0 * 33], s[1 * 33], s[2 * 33], s[3 * 33], wscale); o.y = pk4_fp8s(s[4 * 33], s[5 * 33], s[6 * 33], s[7 * 33], wscale);
        *(u32x2*)(WT + (size_t)map(n0 + n) * K + k0 + 8 * c) = o; }
    LDS_WAIT(); asm volatile("" ::: "memory");
}
struct MapId { int off; __device__ __forceinline__ int operator()(int n) const { return off + n; } };
struct MapIn { __device__ __forceinline__ int operator()(int n) const { if (n >= 1024) return n; const int d = n & 127; return (n & ~127) + 2 * (d & 63) + (d >> 6); } };
struct MapGlu { int off; __device__ __forceinline__ int operator()(int n) const { return (n >> 7) * 256 + off + (n & 127); } };

__device__ __forceinline__ void cvt_load(const float* W, int N, int item, int lane, f32x4 (&t)[8]) {
    const int nblk = N / 32, kb = item / nblk, nb = item % nblk, k0 = 64 * kb, n0 = 32 * nb;
#pragma unroll
    for (int i = 0; i < 8; ++i) t[i] = *(const f32x4*)(W + (size_t)(k0 + 8 * i + (lane >> 3)) * N + n0 + 4 * (lane & 7));
}
__device__ __forceinline__ void phase_cvt(const Ctx& c) {
    const int layer = c.layer; const size_t L = (size_t)layer;
    LAS float* scr = (LAS float*)(c.lds + c.wave * 16384);
    const int gw = c.bid * 8 + c.wave, NGW = c.G * 8;
    unsigned char* w_in8 = (unsigned char*)(c.ws + W_IN); unsigned char* e13_8 = (unsigned char*)(c.ws + W_E13); bf16_t* w_brT = (bf16_t*)(c.ws + W_BR); bf16_t* w_outT = (bf16_t*)(c.ws + W_OUT); bf16_t* smT = (bf16_t*)(c.ws + W_SM);
    bf16_t* shupT = (bf16_t*)(c.ws + W_SHUP); unsigned char* shdn8 = (unsigned char*)(c.ws + W_SHDN); unsigned char* e2_8 = (unsigned char*)(c.ws + W_E2);
    constexpr int I_IN = (D / 64) * (INW / 32), I_BR = (512 / 64) * (D / 32), I_OUT = (D / 64) * (D / 32), I_SM = (128 / 64) * (128 / 32), I_UP = (D / 64) * (DEXP / 32), I_DN = (DEXP / 64) * (D / 32), I_RT = (D / 64) * (64 / 32);
    constexpr int N0 = I_IN, N1 = N0 + 3 * I_BR, N2 = N1 + I_OUT, N3 = N2 + 12 * I_SM, N4 = N3 + 2 * I_UP, N5 = N4 + I_RT, N6 = N5 + I_DN, N7 = N6 + 2 * NEXP * I_UP, N8 = N7 + NEXP * I_DN;
    auto src = [&](int r, const float*& W, int& N, int& item) {
        if (r < N0) { W = inp(c, I_WIN, L * D * INW); N = INW; item = r; return; }
        if (r < N1) { r -= N0; const int i = r / I_BR; W = inp(c, I_WBR, L * 3 * 512 * D) + (size_t)i * 512 * D; N = D; item = r % I_BR; return; }
        if (r < N2) { r -= N1; W = inp(c, I_WOUT, L * D * D); N = D; item = r; return; }
        if (r < N3) { r -= N2; const int i = r / I_SM, which = i / 4, g = i % 4; W = inp(c, which == 0 ? I_POOLW : (which == 1 ? I_WA : I_WX), L * 4 * 128 * 128) + (size_t)g * 128 * 128; N = 128; item = r % I_SM; return; }
        if (r < N4) { r -= N3; const int i = r / I_UP; W = inp(c, i == 0 ? I_SW1 : I_SW3, L * D * DEXP); N = DEXP; item = r % I_UP; return; }
        if (r < N5) { r -= N4; W = inp(c, I_RW, L * D * 64); N = 64; item = r; return; }
        if (r < N6) { r -= N5; W = inp(c, I_SW2, L * DEXP * D); N = D; item = r; return; }
        if (r < N7) { r -= N6; const int i = r / I_UP, e = i >> 1, which = i & 1; W = inp(c, which ? I_EW3 : I_EW1, L * NEXP * D * DEXP) + (size_t)e * D * DEXP; N = DEXP; item = r % I_UP; return; }
        r -= N7; { const int e = r / I_DN; W = inp(c, I_EW2, L * NEXP * DEXP * D) + (size_t)e * DEXP * D; N = D; item = r % I_DN; }
    };
    f32x4 t[8];
    if (gw < N8) { const float* W; int N, item; src(gw, W, N, item); cvt_load(W, N, item, c.lane, t); }
    for (int it = gw; it < N8; it += NGW) {
        f32x4 tn[8];
        { const int itn = it + NGW < N8 ? it + NGW : it; const float* W; int N, item; src(itn, W, N, item); cvt_load(W, N, item, c.lane, tn); }
        int r = it;
        do {
        if (r < N0) { transpose_item8(t, D, INW, w_in8, MapIn{}, scr, r, c.lane); break; }
        if (r < N1) { r -= N0; const int i = r / I_BR; transpose_item8(t, 512, D, (unsigned char*)w_brT + (size_t)i * D * 512, MapId{0}, scr, r % I_BR, c.lane, W8_SCALE * (256.0f / 255.0f)); break; }
        if (r < N2) { r -= N1; transpose_item8(t, D, D, (unsigned char*)w_outT, MapId{0}, scr, r, c.lane); break; }
        if (r < N3) { r -= N2; const int i = r / I_SM, which = i / 4, g = i % 4;
            bf16_t* dst = which == 0 ? smT + (size_t)(g >> 1) * 65536 + (size_t)(g & 1) * 128 * 256 + (g & 1) * 128 : smT + (size_t)(2 + g) * 65536 + (size_t)(which - 1) * 128 * 256 + (g & 1) * 128;
            transpose_item(t, 128, 128, dst, MapId{0}, scr, r % I_SM, c.lane, 256); break; }
        if (r < N4) { r -= N3; const int i = r / I_UP; transpose_item(t, D, DEXP, shupT, MapGlu{i * 128}, scr, r % I_UP, c.lane); break; }
        if (r < N5) { r -= N4; transpose_item(t, D, 64, shupT, MapId{512}, scr, r, c.lane); break; }
        if (r < N6) { r -= N5; transpose_item8(t, DEXP, D, shdn8, MapId{0}, scr, r, c.lane); break; }
        if (r < N7) { r -= N6; const int i = r / I_UP, e = i >> 1, which = i & 1; transpose_item8(t, D, DEXP, e13_8 + (size_t)e * 512 * D, MapGlu{which * 128}, scr, r % I_UP, c.lane); break; }
        r -= N7; { const int e = r / I_DN; transpose_item8(t, DEXP, D, e2_8 + (size_t)e * D * DEXP, MapId{0}, scr, r % I_DN, c.lane); }
        } while (0);
#pragma unroll
        for (int i = 0; i < 8; ++i) t[i] = tn[i];
    }
    { u32x4* z = (u32x4*)(shupT + (size_t)576 * D); const int nz = 192 * D * 2 / 16; for (int i = c.bid * 512 + c.tid; i < nz; i += c.G * 512) z[i] = (u32x4){0u, 0u, 0u, 0u}; }
    {
        u32x4* z = (u32x4*)smT;
        for (int i = c.bid * 512 + c.tid; i < 6 * 256 * 16; i += c.G * 512) { const int t = i / (256 * 16), rr = (i / 16) % 256, ch = i % 16;
            const int khalf = t < 2 ? ((rr >> 7) ^ 1) : (((t - 2) & 1) ^ 1);
            z[((size_t)t * 65536 + (size_t)rr * 256 + khalf * 128) / 8 + ch] = (u32x4){0u, 0u, 0u, 0u}; }
        float* lsT = (float*)(c.ws + W_SM + 768 * 1024); const float* lam_ = inp(c, I_LAM, L * 512);
        for (int i = c.bid * 512 + c.tid; i < 512; i += c.G * 512) lsT[i] = -log1pf(expf(-lam_[i]));
    }
    if (layer == 0) {
        const f32x4* xs = (const f32x4*)inp(c, I_X, 0); u32x2* xd = (u32x2*)(c.ws + WS_XB); unsigned* xd8 = (unsigned*)(c.ws + WS_XB8);
        for (size_t i = (size_t)c.bid * 512 + c.tid; i < (size_t)T * D / 4; i += (size_t)c.G * 512) { const f32x4 v = xs[i]; u32x2 w; w.x = pk2(v[0], v[1]); w.y = pk2(v[2], v[3]); xd[i] = w; xd8[i] = pk4_fp8s(v[0], v[1], v[2], v[3], 1.0f); }
        unsigned* csT = (unsigned*)(c.ws + WS_COS);
        for (int i = c.bid * 512 + c.tid; i < SEQ * 64; i += c.G * 512) { const int s = i >> 6, j = i & 63; const float inv = powf(10000.0f, -(float)j / 64.0f); const float ang = (float)((const int*)inp(c, I_POS, 0))[s] * inv; csT[i] = pk2(cosf(ang), sinf(ang)); }
    }
}

constexpr int TP = 272;
__device__ __forceinline__ void load_tile128(lds_t* dst, const bf16_t* src, int gp, int rows, int tid) {
    for (int v = tid; v < rows * 16; v += 512) { const int r = v >> 4, cb = v & 15; *(LAS u32x4*)(dst + r * TP + cb * 16) = *(const u32x4*)(src + (size_t)r * gp + cb * 8); }
}
__device__ __forceinline__ float ret_log2g(int h) { return log2f(1.0f - exp2f(-5.0f - (float)h)); }

__device__ __forceinline__ void frag_col8(bf16x8 (&out)[8], const lds_t* X, int pitchB, int k0, int fr, int fq) {
    const int q = fr >> 2, p = fr & 3;
    const unsigned a0 = (unsigned)(size_t)X + (unsigned)((k0 + 8 * fq + q) * pitchB + 4 * p * 2), a1 = a0 + 4u * (unsigned)pitchB;
    u16x4 lo[8], hi[8];
    asm volatile("ds_read_b64_tr_b16 %0, %16\n\tds_read_b64_tr_b16 %1, %16 offset:32\n\tds_read_b64_tr_b16 %2, %16 offset:64\n\tds_read_b64_tr_b16 %3, %16 offset:96\n\t"
                 "ds_read_b64_tr_b16 %4, %16 offset:128\n\tds_read_b64_tr_b16 %5, %16 offset:160\n\tds_read_b64_tr_b16 %6, %16 offset:192\n\tds_read_b64_tr_b16 %7, %16 offset:224\n\t"
                 "ds_read_b64_tr_b16 %8, %17\n\tds_read_b64_tr_b16 %9, %17 offset:32\n\tds_read_b64_tr_b16 %10, %17 offset:64\n\tds_read_b64_tr_b16 %11, %17 offset:96\n\t"
                 "ds_read_b64_tr_b16 %12, %17 offset:128\n\tds_read_b64_tr_b16 %13, %17 offset:160\n\tds_read_b64_tr_b16 %14, %17 offset:192\n\tds_read_b64_tr_b16 %15, %17 offset:224\n\ts_waitcnt lgkmcnt(0)"
                 : "=&v"(lo[0]), "=&v"(lo[1]), "=&v"(lo[2]), "=&v"(lo[3]), "=&v"(lo[4]), "=&v"(lo[5]), "=&v"(lo[6]), "=&v"(lo[7]),
                   "=&v"(hi[0]), "=&v"(hi[1]), "=&v"(hi[2]), "=&v"(hi[3]), "=&v"(hi[4]), "=&v"(hi[5]), "=&v"(hi[6]), "=&v"(hi[7])
                 : "v"(a0), "v"(a1) : "memory");
#pragma unroll
    for (int i = 0; i < 8; ++i) { bf16x8 r; r[0] = (short)lo[i][0]; r[1] = (short)lo[i][1]; r[2] = (short)lo[i][2]; r[3] = (short)lo[i][3]; r[4] = (short)hi[i][0]; r[5] = (short)hi[i][1]; r[6] = (short)hi[i][2]; r[7] = (short)hi[i][3]; out[i] = r; }
}
#define ACC8(S, X, OP) do { S[0] OP bflo((X).x); S[1] OP bfhi((X).x); S[2] OP bflo((X).y); S[3] OP bfhi((X).y); S[4] OP bflo((X).z); S[5] OP bfhi((X).z); S[6] OP bflo((X).w); S[7] OP bfhi((X).w); } while (0)
template <int W>
__device__ __forceinline__ void pool_fill(bf16_t* dst, const bf16_t* Hcol, int r0, int s0) {
#pragma unroll 1
    for (int blk = 0; blk < 2; ++blk) {
        const int rb = r0 + blk * 4 - (W - 1);
        u32x4 lo[3], hi[4]; float sum[8];
#pragma unroll
        for (int e = 0; e < 8; ++e) sum[e] = 0.f;
#pragma unroll
        for (int j = 0; j < W + 3; ++j) { const int rr = rb + j; const int rc = rr < -s0 ? -s0 : rr; u32x4 xv = *(const u32x4*)(Hcol + (ptrdiff_t)rc * HW); if (s0 + rr < 0) xv = (u32x4){0u, 0u, 0u, 0u};
            if (j < W) ACC8(sum, xv, +=);
            if (j < 3) lo[j] = xv;
            if (j >= W - 1) hi[j - (W - 1)] = xv; }
#pragma unroll
        for (int o = 0; o < 4; ++o) {
            if (o > 0) { ACC8(sum, hi[o], +=); ACC8(sum, lo[o - 1], -=); }
            const int rr = r0 + blk * 4 + o; const int s = s0 + rr; const int nn = (s + 1) < W ? (s + 1) : W; const float inv = 1.0f / (float)nn; const u32x4 self = hi[o];
            u32x4 ov; ov.x = pk2(sum[0] * inv - bflo(self.x), sum[1] * inv - bfhi(self.x)); ov.y = pk2(sum[2] * inv - bflo(self.y), sum[3] * inv - bfhi(self.y));
            ov.z = pk2(sum[4] * inv - bflo(self.z), sum[5] * inv - bfhi(self.z)); ov.w = pk2(sum[6] * inv - bflo(self.w), sum[7] * inv - bfhi(self.w));
            *(u32x4*)(dst + (size_t)rr * 1536) = ov;
        }
    }
}
__device__ __forceinline__ void phase_mix1(const Ctx& c) {
    const size_t L = (size_t)c.layer;
    const float* conv_w = inp(c, I_CONVW, L * 4 * 512); const float* conv_b = inp(c, I_CONVB, L * 512); const float* pool_scale = inp(c, I_POOLS, L * 512);
    const float* ba_ = inp(c, I_BA, L * 512); const float* bx_ = inp(c, I_BX, L * 512); const float* lam_ = inp(c, I_LAM, L * 512);
    const int tid = c.tid, lane = c.lane, wave = c.wave, fr = lane & 15, fq = lane >> 4;
    const bf16_t* H = (const bf16_t*)(c.ws + S_H7); bf16_t* KV = (bf16_t*)(c.ws + S_KV); bf16_t* BR = (bf16_t*)(c.ws + S_BR);
    bf16_t* LA = (bf16_t*)(c.ws + S_LA); bf16_t* BBs = (bf16_t*)(c.ws + S_BB);
    const bf16_t* smT = (const bf16_t*)(c.ws + W_SM);
    lds_t* L0 = c.lds; lds_t* L1 = c.lds + 128 * TP;
    for (int p = c.bid; p < NPANEL; p += c.G) {
        const int b = p >> 4, t0 = p * 256;
        u32x4 kraw[4], vraw[4];
#pragma unroll
        for (int it = 0; it < 4; ++it) { const int v = tid + it * 512, r = v >> 4, cb = v & 15; kraw[it] = *(const u32x4*)(H + (size_t)(t0 + r) * HW + 512 + cb * 8); vraw[it] = *(const u32x4*)(H + (size_t)(t0 + r) * HW + 1024 + cb * 8); }
#pragma unroll 1
        for (int u = 0; u < 8; ++u) {
            const int cc = u >> 2, h = u & 3, n = (p & 15) * 2 + cc; const float l2g = ret_log2g(h);
            __syncthreads();
#pragma unroll
            for (int it = 0; it < 4; ++it) { const int v = tid + it * 512, r = v >> 4, cb = v & 15; const float dk = exp2f(l2g * (float)(127 - r)); const u32x4 kv = kraw[it];
                u32x4 ko; ko.x = pk2(bflo(kv.x) * dk, bfhi(kv.x) * dk); ko.y = pk2(bflo(kv.y) * dk, bfhi(kv.y) * dk); ko.z = pk2(bflo(kv.z) * dk, bfhi(kv.z) * dk); ko.w = pk2(bflo(kv.w) * dk, bfhi(kv.w) * dk);
                *(LAS u32x4*)(L0 + r * TP + cb * 16) = ko; *(LAS u32x4*)(L1 + r * TP + cb * 16) = vraw[it]; }
            __syncthreads();
            if (u < 7) { const int u2 = u + 1, cc2 = u2 >> 2, h2 = u2 & 3, tc2 = t0 + cc2 * 128;
#pragma unroll
                for (int it = 0; it < 4; ++it) { const int v = tid + it * 512, r = v >> 4, cb = v & 15; kraw[it] = *(const u32x4*)(H + (size_t)(tc2 + r) * HW + 512 + h2 * 128 + cb * 8); vraw[it] = *(const u32x4*)(H + (size_t)(tc2 + r) * HW + 1024 + h2 * 128 + cb * 8); } }
            f32x4 acc[8];
#pragma unroll
            for (int i = 0; i < 8; ++i) acc[i] = (f32x4){0.f, 0.f, 0.f, 0.f};
#pragma unroll
            for (int j0 = 0; j0 < 128; j0 += 32) {
                const bf16x8 a = frag_col(L1, TP, j0, wave * 16, fr, fq);
                bf16x8 kb[8]; frag_col8(kb, L0, TP, j0, fr, fq);
#pragma unroll
                for (int i = 0; i < 8; ++i) acc[i] = mfma16(kb[i], a, acc[i]);
            }
            bf16_t* kvp = KV + ((size_t)((b * 4 + h) * 32 + n)) * 16384;
#pragma unroll
            for (int i = 0; i < 8; ++i) { u32x2 w; w.x = pk2(acc[i][0], acc[i][1]); w.y = pk2(acc[i][2], acc[i][3]); *(u32x2*)(kvp + (wave * 16 + fr) * 128 + i * 16 + 4 * fq) = w; }
        }
        {
            const int cb = lane & 15, rl = lane >> 4, s0 = t0 & (SEQ - 1), g = wave & 3, r0 = rl * 64;
            if (wave < 4) {
                const int W = 2 << g; const bf16_t* Hcol = H + (size_t)t0 * HW + 2048 + g * 128 + cb * 8; bf16_t* dst = BR + (size_t)t0 * 1536 + g * 128 + cb * 8;
                float sum[8];
#pragma unroll
                for (int e = 0; e < 8; ++e) sum[e] = 0.f;
                for (int r = r0 - W + 1; r < r0; ++r) { const int rc = r < -s0 ? -s0 : r; u32x4 xv = *(const u32x4*)(Hcol + (ptrdiff_t)rc * HW); if (s0 + r < 0) xv = (u32x4){0u, 0u, 0u, 0u}; ACC8(sum, xv, +=); }
#pragma unroll 1
                for (int rb = r0; rb < r0 + 64; rb += 8) {
                    u32x4 xn[8], xo[8];
#pragma unroll
                    for (int i = 0; i < 8; ++i) { const int r = rb + i, ro = r - W; const int rcn = r < -s0 ? -s0 : r, rco = ro < -s0 ? -s0 : ro;
                        xn[i] = *(const u32x4*)(Hcol + (ptrdiff_t)rcn * HW); xo[i] = *(const u32x4*)(Hcol + (ptrdiff_t)rco * HW); if (s0 + ro < 0) xo[i] = (u32x4){0u, 0u, 0u, 0u}; }
#pragma unroll
                    for (int i = 0; i < 8; ++i) { const int r = rb + i; ACC8(sum, xn[i], +=); if (r > r0) ACC8(sum, xo[i], -=);
                        const int s = s0 + r; const int nn = (s + 1) < W ? (s + 1) : W; const float inv = 1.0f / (float)nn; const u32x4 self = xn[i];
                        u32x4 ov; ov.x = pk2(sum[0] * inv - bflo(self.x), sum[1] * inv - bfhi(self.x)); ov.y = pk2(sum[2] * inv - bflo(self.y), sum[3] * inv - bfhi(self.y));
                        ov.z = pk2(sum[4] * inv - bflo(self.z), sum[5] * inv - bfhi(self.z)); ov.w = pk2(sum[6] * inv - bflo(self.w), sum[7] * inv - bfhi(self.w));
                        *(u32x4*)(dst + (size_t)r * 1536) = ov; }
                }
            } else {
                const int ch = g * 128 + cb * 8; const bf16_t* Hcol = H + (size_t)t0 * HW + 2560 + ch; bf16_t* dst = BR + (size_t)t0 * 1536 + 1024 + ch;
                float cwv[4][8], cbv[8];
#pragma unroll
                for (int e = 0; e < 8; ++e) { cbv[e] = conv_b[ch + e];
#pragma unroll
                    for (int k = 0; k < 4; ++k) cwv[k][e] = conv_w[k * 512 + ch + e]; }
                u32x4 p1, p2, p3;
                { const int ra = r0 - 1, rb2 = r0 - 2, rc3 = r0 - 3; p1 = *(const u32x4*)(Hcol + (ptrdiff_t)(ra < -s0 ? -s0 : ra) * HW); p2 = *(const u32x4*)(Hcol + (ptrdiff_t)(rb2 < -s0 ? -s0 : rb2) * HW); p3 = *(const u32x4*)(Hcol + (ptrdiff_t)(rc3 < -s0 ? -s0 : rc3) * HW);
                  if (s0 + ra < 0) p1 = (u32x4){0u, 0u, 0u, 0u}; if (s0 + rb2 < 0) p2 = (u32x4){0u, 0u, 0u, 0u}; if (s0 + rc3 < 0) p3 = (u32x4){0u, 0u, 0u, 0u}; }
#pragma unroll 1
                for (int rb = r0; rb < r0 + 64; rb += 8) {
                    u32x4 xn[8];
#pragma unroll
                    for (int i = 0; i < 8; ++i) xn[i] = *(const u32x4*)(Hcol + (ptrdiff_t)(rb + i) * HW);
#pragma unroll
                    for (int i = 0; i < 8; ++i) { float sum[8];
#pragma unroll
                        for (int e = 0; e < 8; ++e) sum[e] = cbv[e];
                        const u32x4 t0x = xn[i];
#define TAP8(X, K) do { sum[0] += bflo((X).x) * cwv[K][0]; sum[1] += bfhi((X).x) * cwv[K][1]; sum[2] += bflo((X).y) * cwv[K][2]; sum[3] += bfhi((X).y) * cwv[K][3]; sum[4] += bflo((X).z) * cwv[K][4]; sum[5] += bfhi((X).z) * cwv[K][5]; sum[6] += bflo((X).w) * cwv[K][6]; sum[7] += bfhi((X).w) * cwv[K][7]; } while (0)
                        TAP8(t0x, 0); TAP8(p1, 1); TAP8(p2, 2); TAP8(p3, 3);
#undef TAP8
                        u32x4 ov; ov.x = pk2(sum[0], sum[1]); ov.y = pk2(sum[2], sum[3]); ov.z = pk2(sum[4], sum[5]); ov.w = pk2(sum[6], sum[7]);
                        *(u32x4*)(dst + (size_t)(rb + i) * 1536) = ov; p3 = p2; p2 = p1; p1 = t0x; }
                }
            }
        }
    }
}

__device__ __forceinline__ void phase_rgscan(const Ctx& c) {
    bf16_t* LA = (bf16_t*)(c.ws + S_LA); bf16_t* BBs = (bf16_t*)(c.ws + S_BB); float* AE = (float*)(c.ws + S_RGC); float* HE = AE + 262144;
    for (int p = c.bid; p < NPANEL; p += c.G) {
        const int cp = c.tid & 255, ck = p * 2 + (c.tid >> 8); const size_t base = (size_t)ck * 128 * 512 + 2 * cp; float h0 = 0.f, P0 = 1.f, h1 = 0.f, P1 = 1.f;
        unsigned la[8], bb[8];
#pragma unroll
        for (int i = 0; i < 8; ++i) { const size_t o = base + (size_t)i * 512; la[i] = *(const unsigned*)(LA + o); bb[i] = *(const unsigned*)(BBs + o); }
#pragma unroll 1
        for (int j0 = 0; j0 < 128; j0 += 8) {
            unsigned lan[8], bbn[8]; const int jn = j0 + 8 < 128 ? j0 + 8 : j0;
#pragma unroll
            for (int i = 0; i < 8; ++i) { const size_t o = base + (size_t)(jn + i) * 512; lan[i] = *(const unsigned*)(LA + o); bbn[i] = *(const unsigned*)(BBs + o); }
            unsigned ho[8], po[8];
#pragma unroll
            for (int i = 0; i < 8; ++i) { const float a0 = __expf(bflo(la[i])), a1 = __expf(bfhi(la[i]));
                h0 = a0 * h0 + bflo(bb[i]); P0 *= a0; h1 = a1 * h1 + bfhi(bb[i]); P1 *= a1; ho[i] = pk2(h0, h1); po[i] = pk2(P0, P1); }
#pragma unroll
            for (int i = 0; i < 8; ++i) { const size_t o = base + (size_t)(j0 + i) * 512; *(unsigned*)(LA + o) = ho[i]; *(unsigned*)(BBs + o) = po[i]; }
#pragma unroll
            for (int i = 0; i < 8; ++i) { la[i] = lan[i]; bb[i] = bbn[i]; }
        }
        *(f32x2*)(AE + (size_t)ck * 512 + 2 * cp) = (f32x2){P0, P1}; *(f32x2*)(HE + (size_t)ck * 512 + 2 * cp) = (f32x2){h0, h1};
    }
}
__device__ __forceinline__ void phase_scan(const Ctx& c) {
    u32x4* KV = (u32x4*)(c.ws + S_KV);
    for (int i = c.bid * 512 + c.tid; i < 64 * 2048; i += c.G * 512) { const int bh = i >> 11, e = i & 2047; const float cd = exp2f(ret_log2g(bh & 3) * 128.0f);
        float st[8];
#pragma unroll
        for (int q = 0; q < 8; ++q) st[q] = 0.f;
        u32x4* p = KV + (size_t)bh * 32 * 2048 + e;
#pragma unroll 8
        for (int n = 0; n < 32; ++n) { const u32x4 v = p[(size_t)n * 2048]; u32x4 o; o.x = pk2(st[0], st[1]); o.y = pk2(st[2], st[3]); o.z = pk2(st[4], st[5]); o.w = pk2(st[6], st[7]); p[(size_t)n * 2048] = o;
            st[0] = st[0] * cd + bflo(v.x); st[1] = st[1] * cd + bfhi(v.x); st[2] = st[2] * cd + bflo(v.y); st[3] = st[3] * cd + bfhi(v.y); st[4] = st[4] * cd + bflo(v.z); st[5] = st[5] * cd + bfhi(v.z); st[6] = st[6] * cd + bflo(v.w); st[7] = st[7] * cd + bfhi(v.w); } }
    float* AE = (float*)(c.ws + S_RGC); float* HE = AE + 262144; float* CI = HE + 262144;
    for (int i = c.bid * 512 + c.tid; i < NBATCH * 512; i += c.G * 512) { const int b = i >> 9, ch = i & 511; float cr = 0.f;
        for (int n = 0; n < 32; ++n) { const size_t o = (size_t)(b * 32 + n) * 512 + ch; CI[o] = cr; cr = AE[o] * cr + HE[o]; } }
}
__device__ __forceinline__ void frag_tr8(bf16x8 (&out)[8], const lds_t* X, int pitchB, int rbase, int hrows, int fr) {
    const int q = fr >> 2, p = fr & 3;
    const unsigned a0 = (unsigned)(size_t)X + (unsigned)((rbase + q) * pitchB + 4 * p * 2), a1 = a0 + (unsigned)(hrows * pitchB);
    u16x4 lo[8], hi[8];
    asm volatile("ds_read_b64_tr_b16 %0, %16\n\tds_read_b64_tr_b16 %1, %16 offset:32\n\tds_read_b64_tr_b16 %2, %16 offset:64\n\tds_read_b64_tr_b16 %3, %16 offset:96\n\t"
                 "ds_read_b64_tr_b16 %4, %16 offset:128\n\tds_read_b64_tr_b16 %5, %16 offset:160\n\tds_read_b64_tr_b16 %6, %16 offset:192\n\tds_read_b64_tr_b16 %7, %16 offset:224\n\t"
                 "ds_read_b64_tr_b16 %8, %17\n\tds_read_b64_tr_b16 %9, %17 offset:32\n\tds_read_b64_tr_b16 %10, %17 offset:64\n\tds_read_b64_tr_b16 %11, %17 offset:96\n\t"
                 "ds_read_b64_tr_b16 %12, %17 offset:128\n\tds_read_b64_tr_b16 %13, %17 offset:160\n\tds_read_b64_tr_b16 %14, %17 offset:192\n\tds_read_b64_tr_b16 %15, %17 offset:224\n\ts_waitcnt lgkmcnt(0)"
                 : "=&v"(lo[0]), "=&v"(lo[1]), "=&v"(lo[2]), "=&v"(lo[3]), "=&v"(lo[4]), "=&v"(lo[5]), "=&v"(lo[6]), "=&v"(lo[7]),
                   "=&v"(hi[0]), "=&v"(hi[1]), "=&v"(hi[2]), "=&v"(hi[3]), "=&v"(hi[4]), "=&v"(hi[5]), "=&v"(hi[6]), "=&v"(hi[7])
                 : "v"(a0), "v"(a1) : "memory");
#pragma unroll
    for (int i = 0; i < 8; ++i) { bf16x8 r; r[0] = (short)lo[i][0]; r[1] = (short)lo[i][1]; r[2] = (short)lo[i][2]; r[3] = (short)lo[i][3]; r[4] = (short)hi[i][0]; r[5] = (short)hi[i][1]; r[6] = (short)hi[i][2]; r[7] = (short)hi[i][3]; out[i] = r; }
}
__device__ __forceinline__ void phase_mix2(const Ctx& c) {
    const int tid = c.tid, lane = c.lane, wave = c.wave, fr = lane & 15, fq = lane >> 4;
    const bf16_t* H = (const bf16_t*)(c.ws + S_H7); const bf16_t* KV = (const bf16_t*)(c.ws + S_KV); bf16_t* BR = (bf16_t*)(c.ws + S_BR);
    const bf16_t* HL = (const bf16_t*)(c.ws + S_LA); const bf16_t* PP = (const bf16_t*)(c.ws + S_BB); const float* CI = (const float*)(c.ws + S_RGC) + 2 * 262144;
    lds_t* LK = c.lds; lds_t* LV = c.lds + 128 * TP; lds_t* LP = c.lds + 256 * TP;
    for (int p = c.bid; p < NPANEL; p += c.G) {
        const int b = p >> 4, t0 = p * 256;
        u32x4 kraw[4], vraw[4], praw[4];
        {
            const int n0 = (p & 15) * 2;
#pragma unroll
            for (int it = 0; it < 4; ++it) { const int v = tid + it * 512, r = v >> 4, cb = v & 15; kraw[it] = *(const u32x4*)(H + (size_t)(t0 + r) * HW + 512 + cb * 8); vraw[it] = *(const u32x4*)(H + (size_t)(t0 + r) * HW + 1024 + cb * 8); }
            if (n0 > 0) { const bf16_t* kvp = KV + ((size_t)((b * 4 + 0) * 32 + n0)) * 16384;
#pragma unroll
                for (int it = 0; it < 4; ++it) { const int v = tid + it * 512; praw[it] = *(const u32x4*)(kvp + (size_t)v * 8); } }
        }
        bf16x8 qf[4];
#pragma unroll
        for (int d = 0; d < 4; ++d) qf[d] = *(const bf16x8*)(H + (size_t)(t0 + wave * 16 + fr) * HW + d * 32 + 8 * fq);
#pragma unroll 1
        for (int u = 0; u < 8; ++u) {
            const int cc = u >> 2, h = u & 3, n = (p & 15) * 2 + cc, tc = t0 + cc * 128; const float l2g = ret_log2g(h);
            u32x2 gv[8];
#pragma unroll
            for (int i = 0; i < 8; ++i) gv[i] = *(const u32x2*)(H + (size_t)(tc + wave * 16 + fr) * HW + 1536 + h * 128 + i * 16 + 4 * fq);
            __syncthreads();
#pragma unroll
            for (int it = 0; it < 4; ++it) { const int v = tid + it * 512, r = v >> 4, cb = v & 15; *(LAS u32x4*)(LK + r * TP + cb * 16) = kraw[it]; *(LAS u32x4*)(LV + r * TP + cb * 16) = vraw[it]; }
            if (n > 0) {
#pragma unroll
                for (int it = 0; it < 4; ++it) { const int v = tid + it * 512, r = v >> 4, cb = v & 15; *(LAS u32x4*)(LP + r * TP + cb * 16) = praw[it]; } }
            __syncthreads();
            if (u < 7) {
                const int u2 = u + 1, cc2 = u2 >> 2, h2 = u2 & 3, tc2 = t0 + cc2 * 128, n2 = (p & 15) * 2 + cc2;
#pragma unroll
                for (int it = 0; it < 4; ++it) { const int v = tid + it * 512, r = v >> 4, cb = v & 15; kraw[it] = *(const u32x4*)(H + (size_t)(tc2 + r) * HW + 512 + h2 * 128 + cb * 8); vraw[it] = *(const u32x4*)(H + (size_t)(tc2 + r) * HW + 1024 + h2 * 128 + cb * 8); }
                if (n2 > 0) { const bf16_t* kvp = KV + ((size_t)((b * 4 + h2) * 32 + n2)) * 16384;
#pragma unroll
                    for (int it = 0; it < 4; ++it) { const int v = tid + it * 512; praw[it] = *(const u32x4*)(kvp + (size_t)v * 8); } }
            }
            const float gc = exp2f(l2g * (float)fr);
            float gj[4];
#pragma unroll
            for (int r = 0; r < 4; ++r) gj[r] = exp2f(-l2g * (float)(4 * fq + r));
            bf16x8 sb[4];
#pragma unroll
            for (int s = 0; s < 4; ++s) {
                u32x2 half[2];
#pragma unroll
                for (int hh = 0; hh < 2; ++hh) { const int jt = 2 * s + hh; f32x4 st = (f32x4){0.f, 0.f, 0.f, 0.f};
                    if (jt <= wave) {
#pragma unroll
                        for (int d = 0; d < 4; ++d) { const bf16x8 a = frag_row(LK, TP, jt * 16, d * 32, fr, fq); st = mfma16(a, qf[d], st); }
                        const float gt = gc * exp2f(l2g * (float)(16 * (wave - jt)));
#pragma unroll
                        for (int r = 0; r < 4; ++r) { const bool ok = (jt < wave) || (4 * fq + r <= fr); st[r] = ok ? st[r] * gt * gj[r] : 0.f; } }
                    half[hh].x = pk2(st[0], st[1]); half[hh].y = pk2(st[2], st[3]); }
                const u32x4 w = (u32x4){half[0].x, half[0].y, half[1].x, half[1].y}; sb[s] = __builtin_bit_cast(bf16x8, w);
            }
            f32x4 o[8];
#pragma unroll
            for (int i = 0; i < 8; ++i) o[i] = (f32x4){0.f, 0.f, 0.f, 0.f};
            if (n > 0) {
#pragma unroll
                for (int d = 0; d < 4; ++d)
#pragma unroll
                    for (int i = 0; i < 8; ++i) { const bf16x8 a = frag_row(LP, TP, i * 16, d * 32, fr, fq); o[i] = mfma16(a, qf[d], o[i]); }
                const float qd = exp2f(l2g * (float)(wave * 16 + fr + 1));
#pragma unroll
                for (int i = 0; i < 8; ++i) o[i] = o[i] * qd;
            }
#pragma unroll
            for (int s = 0; s < 4; ++s) if (2 * s <= wave) { bf16x8 vt[8]; frag_tr8(vt, LV, TP, 32 * s + 4 * fq, 16, fr);
#pragma unroll
                for (int i = 0; i < 8; ++i) o[i] = mfma16(vt[i], sb[s], o[i]); }
            if (u < 7) { const int u2 = u + 1, tq = t0 + (u2 >> 2) * 128, hq = u2 & 3;
#pragma unroll
                for (int d = 0; d < 4; ++d) qf[d] = *(const bf16x8*)(H + (size_t)(tq + wave * 16 + fr) * HW + hq * 128 + d * 32 + 8 * fq); }
            {
                float sm = 0.f;
#pragma unroll
                for (int i = 0; i < 8; ++i) sm += (o[i][0] + o[i][1]) + (o[i][2] + o[i][3]);
                sm += __shfl_xor(sm, 16); sm += __shfl_xor(sm, 32);
                const float mu = sm * (1.0f / 128.0f); float sq = 0.f;
#pragma unroll
                for (int i = 0; i < 8; ++i) { o[i] = o[i] - mu; sq += (o[i][0] * o[i][0] + o[i][1] * o[i][1]) + (o[i][2] * o[i][2] + o[i][3] * o[i][3]); }
                sq += __shfl_xor(sq, 16); sq += __shfl_xor(sq, 32);
                const float rstd = 1.0f / sqrtf(sq * (1.0f / 128.0f) + GN_EPS);
                const size_t row = (size_t)(tc + wave * 16 + fr);
#pragma unroll
                for (int i = 0; i < 8; ++i) { const int col = h * 128 + i * 16 + 4 * fq; const u32x2 g = gv[i];
                    *(unsigned*)((unsigned char*)BR + row * 3072 + col) = pk4_fp8s(bflo(g.x) * o[i][0] * rstd, bfhi(g.x) * o[i][1] * rstd, bflo(g.y) * o[i][2] * rstd, bfhi(g.y) * o[i][3] * rstd, 1.0f); }
            }
        }
#pragma unroll 4
        for (int v = tid; v < 256 * 64; v += 512) { const int r = v >> 6, c8 = v & 63; const size_t row = (size_t)(t0 + r); const int ck = (t0 + r) >> 7;
            const u32x4 hl = *(const u32x4*)(HL + row * 512 + c8 * 8), pp = *(const u32x4*)(PP + row * 512 + c8 * 8), gy = *(const u32x4*)(H + row * HW + 3072 + c8 * 8);
            const f32x4 ci0 = *(const f32x4*)(CI + (size_t)ck * 512 + c8 * 8), ci1 = *(const f32x4*)(CI + (size_t)ck * 512 + c8 * 8 + 4);
            u32x2 o; o.x = pk4_fp8s((bflo(hl.x) + bflo(pp.x) * ci0[0]) * bflo(gy.x), (bfhi(hl.x) + bfhi(pp.x) * ci0[1]) * bfhi(gy.x), (bflo(hl.y) + bflo(pp.y) * ci0[2]) * bflo(gy.y), (bfhi(hl.y) + bfhi(pp.y) * ci0[3]) * bfhi(gy.y), 1.0f);
            o.y = pk4_fp8s((bflo(hl.z) + bflo(pp.z) * ci1[0]) * bflo(gy.z), (bfhi(hl.z) + bfhi(pp.z) * ci1[1]) * bfhi(gy.z), (bflo(hl.w) + bflo(pp.w) * ci1[2]) * bflo(gy.w), (bfhi(hl.w) + bfhi(pp.w) * ci1[3]) * bfhi(gy.w), 1.0f);
            *(u32x2*)((unsigned char*)BR + row * 3072 + 1536 + c8 * 8) = o; }
    }
}

__device__ __forceinline__ void ln16_store(f32x4 (&v)[4], int lane, const f32x4 (&gg)[4], const f32x4 (&bb)[4], float* of, bf16_t* ob, unsigned char* o8 = nullptr) {
    float s = 0.f;
#pragma unroll
    for (int j = 0; j < 4; ++j) s += (v[j][0] + v[j][1]) + (v[j][2] + v[j][3]);
    const float mean = wave_sum(s) * (1.f / D); float s2 = 0.f;
#pragma unroll
    for (int j = 0; j < 4; ++j) { v[j] = v[j] - mean; s2 += (v[j][0] * v[j][0] + v[j][1] * v[j][1]) + (v[j][2] * v[j][2] + v[j][3] * v[j][3]); }
    const float rstd = 1.f / sqrtf(wave_sum(s2) * (1.f / D) + LN_EPS);
    f32x4 o[4];
#pragma unroll
    for (int j = 0; j < 4; ++j) o[j] = v[j] * rstd * gg[j] + bb[j];
    if (of) {
#pragma unroll
        for (int j = 0; j < 4; ++j) *(f32x4*)(of + 16 * lane + 4 * j) = o[j]; }
    if (ob) { u32x4 w0, w1; w0.x = pk2(o[0][0], o[0][1]); w0.y = pk2(o[0][2], o[0][3]); w0.z = pk2(o[1][0], o[1][1]); w0.w = pk2(o[1][2], o[1][3]); w1.x = pk2(o[2][0], o[2][1]); w1.y = pk2(o[2][2], o[2][3]); w1.z = pk2(o[3][0], o[3][1]); w1.w = pk2(o[3][2], o[3][3]);
        *(u32x4*)(ob + 16 * lane) = w0; *(u32x4*)(ob + 16 * lane + 8) = w1; }
    if (o8) { u32x4 w; w.x = pk4_fp8s(o[0][0], o[0][1], o[0][2], o[0][3], 1.0f); w.y = pk4_fp8s(o[1][0], o[1][1], o[1][2], o[1][3], 1.0f); w.z = pk4_fp8s(o[2][0], o[2][1], o[2][2], o[2][3], 1.0f); w.w = pk4_fp8s(o[3][0], o[3][1], o[3][2], o[3][3], 1.0f); *(u32x4*)(o8 + 16 * lane) = w; }
}
__device__ __forceinline__ void ld16_bf16(const bf16_t* row, int lane, f32x4 (&v)[4]) {
    const u32x4 a = *(const u32x4*)(row + 16 * lane), b = *(const u32x4*)(row + 16 * lane + 8);
    v[0] = (f32x4){bflo(a.x), bfhi(a.x), bflo(a.y), bfhi(a.y)}; v[1] = (f32x4){bflo(a.z), bfhi(a.z), bflo(a.w), bfhi(a.w)}; v[2] = (f32x4){bflo(b.x), bfhi(b.x), bflo(b.y), bfhi(b.y)}; v[3] = (f32x4){bflo(b.z), bfhi(b.z), bflo(b.w), bfhi(b.w)};
}
__device__ __forceinline__ void phase_ln1(const Ctx& c, bool dummy) {
    const float* g = inp(c, I_LN1G, (size_t)c.layer * D); const float* bt = inp(c, I_LN1B, (size_t)c.layer * D);
    bf16_t* xb = (bf16_t*)(c.ws + WS_XB); const bf16_t* PRE = (const bf16_t*)(c.ws + S_PRE); const int lane = c.lane;
    f32x4 gg[4], bb[4];
#pragma unroll
    for (int j = 0; j < 4; ++j) { gg[j] = *(const f32x4*)(g + 16 * lane + 4 * j); bb[j] = *(const f32x4*)(bt + 16 * lane + 4 * j); }
    int row = c.bid * 8 + c.wave; const int step = c.G * 8;
    u32x4 a = *(const u32x4*)(PRE + (size_t)row * D + 16 * lane), b = *(const u32x4*)(PRE + (size_t)row * D + 16 * lane + 8);
    for (; row < T; row += step) {
        const int nrow = row + step < T ? row + step : row;
        const u32x4 na = *(const u32x4*)(PRE + (size_t)nrow * D + 16 * lane), nb = *(const u32x4*)(PRE + (size_t)nrow * D + 16 * lane + 8);
        f32x4 v[4]; v[0] = (f32x4){bflo(a.x), bfhi(a.x), bflo(a.y), bfhi(a.y)}; v[1] = (f32x4){bflo(a.z), bfhi(a.z), bflo(a.w), bfhi(a.w)}; v[2] = (f32x4){bflo(b.x), bfhi(b.x), bflo(b.y), bfhi(b.y)}; v[3] = (f32x4){bflo(b.z), bfhi(b.z), bflo(b.w), bfhi(b.w)};
        float s = 0.f;
#pragma unroll
        for (int j = 0; j < 4; ++j) s += (v[j][0] + v[j][1]) + (v[j][2] + v[j][3]);
        const float mean = wave_sum(s) * (1.f / D); float s2 = 0.f;
#pragma unroll
        for (int j = 0; j < 4; ++j) { v[j] = v[j] - mean; s2 += (v[j][0] * v[j][0] + v[j][1] * v[j][1]) + (v[j][2] * v[j][2] + v[j][3] * v[j][3]); }
        const float rstd = 1.f / sqrtf(wave_sum(s2) * (1.f / D) + LN_EPS);
        f32x4 o[4];
#pragma unroll
        for (int j = 0; j < 4; ++j) o[j] = v[j] * rstd * gg[j] + bb[j];
        bf16_t* ob = dummy ? (bf16_t*)(c.ws + S_Y) + (size_t)row * D : xb + (size_t)row * D;
        u32x4 w0, w1; w0.x = pk2(o[0][0], o[0][1]); w0.y = pk2(o[0][2], o[0][3]); w0.z = pk2(o[1][0], o[1][1]); w0.w = pk2(o[1][2], o[1][3]); w1.x = pk2(o[2][0], o[2][1]); w1.y = pk2(o[2][2], o[2][3]); w1.z = pk2(o[3][0], o[3][1]); w1.w = pk2(o[3][2], o[3][3]);
        *(u32x4*)(ob + 16 * lane) = w0; *(u32x4*)(ob + 16 * lane + 8) = w1;
        if (!dummy) { u32x4 w; w.x = pk4_fp8s(o[0][0], o[0][1], o[0][2], o[0][3], 1.0f); w.y = pk4_fp8s(o[1][0], o[1][1], o[1][2], o[1][3], 1.0f); w.z = pk4_fp8s(o[2][0], o[2][1], o[2][2], o[2][3], 1.0f); w.w = pk4_fp8s(o[3][0], o[3][1], o[3][2], o[3][3], 1.0f);
            *(u32x4*)((unsigned char*)(c.ws + WS_XB8) + (size_t)row * D + 16 * lane) = w; }
        a = na; b = nb;
    }
}

__device__ __forceinline__ void phase_route(const Ctx& c) {
    const int layer = c.layer;
    const int lane = c.lane, wave = c.wave;
    const float* LG = (const float*)(c.ws + S_LG); unsigned* PE = (unsigned*)(c.ws + S_PE); float* GW = (float*)(c.ws + S_GW); unsigned* LIST = (unsigned*)(c.ws + S_LIST);
    LAS int* lcnt = (LAS int*)(c.lds); LAS int* lbase = lcnt + 64; LAS unsigned* ent = (LAS unsigned*)(lcnt + 128);
    const float rb = inp(c, I_RB, (size_t)layer * 64)[lane];
    for (int p = c.bid; p < NPANEL; p += c.G) {
        const int sub = p / PSUB; unsigned* gcnt = (unsigned*)(c.ws + WS_CTL) + CW_CNT + (layer * NSUB + sub) * 64;
        __syncthreads();
        if (c.tid < 64) lcnt[c.tid] = 0;
        __syncthreads();
        float lgn = LG[(size_t)(p * 256 + wave * 32) * 64 + lane];
        for (int ti = 0; ti < 32; ++ti) {
            const int tl = wave * 32 + ti, t = p * 256 + tl;
            const float lg = lgn; if (ti < 31) lgn = LG[(size_t)(t + 1) * 64 + lane]; const float sc = 1.0f / (1.0f + expf(-lg)); const float bs = sc + rb;
            float m1 = bs; int i1 = lane;
#pragma unroll
            for (int o = 1; o < 8; o <<= 1) { const float om = __shfl_xor(m1, o); const int oi = __shfl_xor(i1, o); if (om > m1 || (om == m1 && oi < i1)) { m1 = om; i1 = oi; } }
            float m2 = (lane == i1) ? -INFINITY : bs;
#pragma unroll
            for (int o = 1; o < 8; o <<= 1) m2 = fmaxf(m2, __shfl_xor(m2, o));
            const float gs = m1 + m2; const int g = lane >> 3; int grank = 0;
#pragma unroll
            for (int gg = 0; gg < 8; ++gg) { const float og = __shfl(gs, gg * 8); grank += (og > gs || (og == gs && gg < g)) ? 1 : 0; }
            unsigned key = __builtin_bit_cast(unsigned, bs); key = (key & 0x80000000u) ? ~key : (key | 0x80000000u); key = (key & ~63u) | (unsigned)(63 - lane); if (grank >= 4) key = (unsigned)(63 - lane);
            unsigned thr = 0u;
#pragma unroll 1
            for (int bit = 31; bit >= 0; --bit) { const unsigned cand = thr | (1u << bit); const int cntb = __builtin_popcountll(__ballot(key >= cand)); if (cntb >= 8) thr = cand; }
            const unsigned long long selm = __ballot(key >= thr);
            const int rank = (key >= thr) ? __builtin_popcountll(selm & ((1ull << lane) - 1ull)) : 8;
            const bool sel = rank < 8; const float ssum = wave_sum(sel ? sc : 0.f);
            if (sel) { const int ls = __hip_atomic_fetch_add(lcnt + lane, 1, __ATOMIC_RELAXED, __HIP_MEMORY_SCOPE_WORKGROUP); ent[tl * 8 + rank] = ((unsigned)lane << 16) | (unsigned)ls; GW[(size_t)t * 8 + rank] = sc / ssum * 2.5f; }
        }
        __syncthreads();
        if (c.tid < 64) lbase[c.tid] = (int)atomicAdd(gcnt + c.tid, (unsigned)lcnt[c.tid]);
        __syncthreads();
        for (int i = c.tid; i < 2048; i += 512) { const unsigned en = ent[i]; const int e = en >> 16, slot = lbase[e] + (int)(en & 0xffffu); const unsigned a = (unsigned)(p * 256) * 8u + (unsigned)i;
            __hip_atomic_store(LIST + ((size_t)sub * NEXP + e) * TSUB + slot, a, __ATOMIC_RELAXED, __HIP_MEMORY_SCOPE_AGENT);
            PE[a] = ((unsigned)e << 20) | (unsigned)slot; }
    }
}
__device__ __forceinline__ void moe_tables(const Ctx& c, int layer, int sub, LAS int* cnt, LAS int* tp) {
    const unsigned* gcnt = (const unsigned*)(c.ws + WS_CTL) + CW_CNT + (layer * NSUB + sub) * 64;
    __syncthreads();
    if (c.tid < 64) { const int n = (int)gcnt[c.tid]; cnt[c.tid] = n; int v = (n + 255) >> 8;
#pragma unroll
        for (int o = 1; o < 64; o <<= 1) { const int t = __shfl_up(v, o); if (c.tid >= o) v += t; }
        tp[c.tid + 1] = v; if (c.tid == 0) tp[0] = 0; }
    __syncthreads();
}
__device__ __forceinline__ void phase_combine(const Ctx& c, int sub, const LAS int* tp, bool last_layer, bool dummy) {
    const float* g2 = inp(c, I_LN2G, (size_t)c.layer * D); const float* b2 = inp(c, I_LN2B, (size_t)c.layer * D);
    const unsigned char* Y = (const unsigned char*)(c.ws + S_Y); const unsigned* PE = (const unsigned*)(c.ws + S_PE); const float* GWp = (const float*)(c.ws + S_GW); bf16_t* xb = (bf16_t*)(c.ws + WS_XB);
    const unsigned char* SF = (const unsigned char*)(c.ws + S_SF);
    const int lane = c.lane;
    f32x4 gg[4], bb[4];
#pragma unroll
    for (int j = 0; j < 4; ++j) { gg[j] = *(const f32x4*)(g2 + 16 * lane + 4 * j); bb[j] = *(const f32x4*)(b2 + 16 * lane + 4 * j); }
    for (int t = sub * TSUB + c.bid * 8 + c.wave; t < (sub + 1) * TSUB; t += c.G * 8) {
        f32x4 v[4]; ld16_bf16(xb + (size_t)t * D, lane, v); const u32x4 sfw = *(const u32x4*)(SF + (size_t)t * D + 16 * lane);
        unsigned pe[8]; float gw[8];
#pragma unroll
        for (int k = 0; k < 8; ++k) { pe[k] = 0; gw[k] = 0.f; }
        { const u32x4 p0 = *(const u32x4*)(PE + (size_t)t * 8), p1 = *(const u32x4*)(PE + (size_t)t * 8 + 4); const f32x4 w0 = *(const f32x4*)(GWp + (size_t)t * 8) * (1.0f / Y_SCALE), w1 = *(const f32x4*)(GWp + (size_t)t * 8 + 4) * (1.0f / Y_SCALE);
          pe[0] = p0.x; pe[1] = p0.y; pe[2] = p0.z; pe[3] = p0.w; pe[4] = p1.x; pe[5] = p1.y; pe[6] = p1.z; pe[7] = p1.w; gw[0] = w0[0]; gw[1] = w0[1]; gw[2] = w0[2]; gw[3] = w0[3]; gw[4] = w1[0]; gw[5] = w1[1]; gw[6] = w1[2]; gw[7] = w1[3]; }
        u32x4 y[8];
#pragma unroll
        for (int k = 0; k < 8; ++k) { const int e = pe[k] >> 20, slot = pe[k] & 0xfffffu; const size_t R = (size_t)tp[e] * 256 + slot; y[k] = *(const u32x4*)(Y + R * D + 16 * lane); }
#pragma unroll
        for (int j = 0; j < 4; ++j) { const unsigned w = j == 0 ? sfw.x : (j == 1 ? sfw.y : (j == 2 ? sfw.z : sfw.w)); const f32x2 lo = __builtin_amdgcn_cvt_pk_f32_fp8((int)w, false), hi = __builtin_amdgcn_cvt_pk_f32_fp8((int)w, true);
            v[j] = v[j] * ALPHA + (f32x4){lo.x, lo.y, hi.x, hi.y} * (1.0f / Y_SCALE); }
#pragma unroll
        for (int k = 0; k < 8; ++k) { const unsigned yw[4] = {y[k].x, y[k].y, y[k].z, y[k].w};
#pragma unroll
            for (int j = 0; j < 4; ++j) { const f32x2 lo = __builtin_amdgcn_cvt_pk_f32_fp8((int)yw[j], false), hi = __builtin_amdgcn_cvt_pk_f32_fp8((int)yw[j], true); v[j] = v[j] + (f32x4){lo.x, lo.y, hi.x, hi.y} * gw[k]; } }
        if (dummy) ln16_store(v, lane, gg, bb, nullptr, (bf16_t*)(c.ws + S_H7 + 876 * MiB) );
        else ln16_store(v, lane, gg, bb, last_layer ? c.out + (size_t)t * D : (float*)nullptr, last_layer ? (bf16_t*)nullptr : xb + (size_t)t * D, last_layer ? (unsigned char*)nullptr : (unsigned char*)(c.ws + WS_XB8) + (size_t)t * D);
    }
}

constexpr int NPH = 21;
__global__ void __launch_bounds__(512, 2) mk_fwd(Args args) {
    extern __shared__ __attribute__((aligned(16))) unsigned char lds_raw[];
    Ctx c0; c0.lds = (lds_t*)lds_raw; c0.tid = threadIdx.x; c0.lane = c0.tid & 63; c0.wave = __builtin_amdgcn_readfirstlane(c0.tid >> 6); c0.G = gridDim.x; c0.bid = blockIdx.x;
    c0.ws = args.ws; c0.out = args.out; c0.layer = 0;
    volatile LAS unsigned* MISC = (volatile LAS unsigned*)(c0.lds + LDS_MISC);
    LAS int* mcnt = (LAS int*)(c0.lds + LDS_MISC + 256); LAS int* mtp = mcnt + 64;
    if (c0.tid < 16) MISC[c0.tid] = 0u;
    if (c0.tid == 0) { LAS unsigned long long* pt = (LAS unsigned long long*)(c0.lds + LDS_PTAB);
#pragma unroll
        for (int i = 0; i < 27; ++i) pt[i] = (unsigned long long)args.in[i]; }
    __syncthreads();
#ifdef X7
    __builtin_amdgcn_fence(__ATOMIC_ACQUIRE, ""); asm volatile("s_waitcnt vmcnt(0)" ::: "memory"); __syncthreads();
#endif
#if MK_ONE_LAUNCH
    XcdBarrier bar = xcd_barrier_post((unsigned*)(c0.ws + WS_CTL) + CW_BAR, MISC + 8);
#define SEAM() xcd_barrier(bar)
#define LSEAM() do { asm volatile("s_waitcnt vmcnt(0)" ::: "memory"); __syncthreads(); if (c0.wave == 0) { __builtin_amdgcn_fence(__ATOMIC_ACQUIRE, "agent"); asm volatile("s_waitcnt vmcnt(0)" ::: "memory"); } __syncthreads(); } while (0)
#else
#define SEAM() do {} while (0)
#define LSEAM() do {} while (0)
#error one launch only
#endif
    const int lo = args.ph_lo, hi = args.ph_hi;
#define IN(k) (lo <= (k) && (k) < hi)
#ifndef PHSEL
#define PHSEL 0xffffffffu
#endif
#define PHS(k) ((PHSEL >> (k)) & 1u)
#ifndef REP_PH
#define REP_PH -1
#define REP_N 0
#endif
#define RP(k) for (int rep_ = 0; rep_ < ((REP_PH == (k)) ? 1 + REP_N : 1); ++rep_)
    for (int l = 0; l < DEPTH; ++l) {
        const int pb = l * NPH;
        c0.layer = l;

        if (PHS(0) && IN(pb + 0)) RP(0) { const Ctx c = fresh(c0); phase_cvt(c); SEAM(); }
        if (PHS(1) && IN(pb + 1)) RP(1) {
            const Ctx c = fresh(c0);
            PanelOrder S{(const char*)(c.ws + WS_XB8), (const char*)(c.ws + W_IN), 14, c.G, c.bid, (size_t)256 * D, (size_t)256 * D};
            EpiIn E{(bf16_t*)(c.ws + S_H7), (const unsigned*)(c.ws + WS_COS), c.lds + LDS_EPI};
            gemm_phase<EpiIn, PanelOrder, false, true>(c.lds, c.tid, D, D, S, E); SEAM(); }
        if (PHS(2) && IN(pb + 2)) RP(2) { { const Ctx c = fresh(c0); phase_mix1(c); LSEAM(); }
            { const Ctx c = fresh(c0);
              OwnOrder S{(const char*)(c.ws + S_BR), (const char*)(c.ws + W_SM), 2, c.G, c.bid, (size_t)256 * 1536 * 2, (size_t)256 * 2, (size_t)65536 * 2, 0};
              EpiPool E{(bf16_t*)(c.ws + S_BR), inp(c, I_POOLS, (size_t)c.layer * 512)};
              gemm_phase<EpiPool, OwnOrder, false>(c.lds, c.tid, 256, 1536 * 2, S, E); }
            { const Ctx c = fresh(c0);
              OwnOrder S{(const char*)(c.ws + S_BR) + 1024 * 2, (const char*)(c.ws + W_SM) + (size_t)2 * 65536 * 2, 4, c.G, c.bid, (size_t)256 * 1536 * 2, (size_t)256 * 2, (size_t)65536 * 2, 1};
              EpiRG E{(const bf16_t*)(c.ws + S_BR), (bf16_t*)(c.ws + S_LA), (bf16_t*)(c.ws + S_BB), inp(c, I_BA, (size_t)c.layer * 512), inp(c, I_BX, (size_t)c.layer * 512), (const float*)(c.ws + W_SM + 768 * 1024)};
              gemm_phase<EpiRG, OwnOrder, false>(c.lds, c.tid, 256, 1536 * 2, S, E); }
            LSEAM(); }
        if (PHS(3) && IN(pb + 3)) RP(3) { const Ctx c = fresh(c0); phase_rgscan(c); SEAM(); }
        if (PHS(4) && IN(pb + 4)) RP(4) { const Ctx c = fresh(c0); phase_scan(c); SEAM(); }
        if (PHS(5) && IN(pb + 5)) RP(5) { const Ctx c = fresh(c0); phase_mix2(c); SEAM(); }
        if (PHS(6) && IN(pb + 6)) RP(6) {
            const Ctx c = fresh(c0);
            PanelOrder S{(const char*)(c.ws + WS_XB8), (const char*)(c.ws + W_IN) + (size_t)HW * D, 12, c.G, c.bid, (size_t)256 * D, (size_t)256 * D};
            EpiGates E{(unsigned char*)(c.ws + S_H7), inp(c, I_GATEB, (size_t)c.layer * 3 * D)};
            gemm_phase<EpiGates, PanelOrder, false, true>(c.lds, c.tid, D, D, S, E); SEAM(); }
#if 1
        if (PHS(7) && IN(pb + 7)) RP(7) {
            const Ctx c = fresh(c0);
            MergeOrder S{(const char*)(c.ws + S_BR), (const char*)(c.ws + W_BR), c.G, c.bid, -1};
            EpiMerge E{(bf16_t*)(c.ws + S_MG), (const unsigned char*)(c.ws + S_H7), (unsigned char*)(c.ws + S_KV + 64 * MiB)};
            gemm_phase<EpiMerge, MergeOrder, false, true>(c.lds, c.tid, 512, 3072, S, E, MX_WG); SEAM(); }
#else
        for (int i = 0; i < 3; ++i) if (PHS(7) && IN(pb + 7 + i)) {
            const Ctx c = fresh(c0);
            MergeOrder S{(const char*)(c.ws + S_BR), (const char*)(c.ws + W_BR), c.G, c.bid, i};
            EpiMerge E{(bf16_t*)(c.ws + S_MG), (const unsigned char*)(c.ws + S_H7), (unsigned char*)(c.ws + S_KV + 64 * MiB)};
            gemm_phase<EpiMerge, MergeOrder, false, true>(c.lds, c.tid, 512, 3072, S, E, MX_WG); if (i == 2) SEAM(); }
#endif
        if (PHS(10) && IN(pb + 10)) RP(10) {
            const Ctx c = fresh(c0);
            PanelOrder S{(const char*)(c.ws + S_KV + 64 * MiB), (const char*)(c.ws + W_OUT), 4, c.G, c.bid, (size_t)256 * D, (size_t)256 * D};
            EpiResB E{rep_ > 0 ? (bf16_t*)(c.ws + S_Y) : (bf16_t*)(c.ws + S_PRE), (const bf16_t*)(c.ws + WS_XB), ALPHA};
            gemm_phase<EpiResB, PanelOrder, false, true>(c.lds, c.tid, D, D, S, E); SEAM(); }
        if (PHS(11) && IN(pb + 11)) RP(11) { const Ctx c = fresh(c0); phase_ln1(c, rep_ > 0); SEAM(); }
        if (PHS(12) && IN(pb + 12)) RP(12) {
            const Ctx c = fresh(c0);
            PanelOrder S{(const char*)(c.ws + WS_XB), (const char*)(c.ws + W_SHUP), 3, c.G, c.bid, (size_t)256 * D * 2, (size_t)256 * D * 2};
            EpiGLU E{(unsigned char*)(c.ws + S_HS), (float*)(c.ws + S_LG), false};
            gemm_phase<EpiGLU, PanelOrder, false>(c.lds, c.tid, D, D * 2, S, E); SEAM(); }
        if (PHS(14) && IN(pb + 13)) RP(14) {
            const Ctx c = fresh(c0);
            PanelOrder S{(const char*)(c.ws + S_HS), (const char*)(c.ws + W_SHDN), 4, c.G, c.bid, (size_t)256 * DEXP, (size_t)256 * DEXP};
            EpiExpDown E{(unsigned char*)(c.ws + S_SF)};
            gemm_phase<EpiExpDown, PanelOrder, false, true>(c.lds, c.tid, DEXP, DEXP, S, E); }
        if (PHS(13) && IN(pb + 14)) RP(13) { const Ctx c = fresh(c0); phase_route(c); SEAM(); }
        for (int s = 0; s < NSUB; ++s) {
            if (PHS(15) && IN(pb + 15 + 3 * s)) RP(15) { const Ctx c = fresh(c0); moe_tables(c, c.layer, s, mcnt, mtp);
                const unsigned* list = (const unsigned*)(c.ws + S_LIST) + (size_t)s * NEXP * TSUB;
                MoeOrder S{(const char*)(c.ws + WS_XB8), (const char*)(c.ws + W_E13), 2, c.G, c.bid, (size_t)512 * D, (size_t)256 * D, 0, mtp, mcnt, list, true, c.lane};
                EpiGLU E{(unsigned char*)(c.ws + S_HE), nullptr, true};
                gemm_phase<EpiGLU, MoeOrder, true, true>(c.lds, c.tid, D, D, S, E); SEAM(); }
            if (PHS(16) && IN(pb + 16 + 3 * s)) RP(16) { const Ctx c = fresh(c0); moe_tables(c, c.layer, s, mcnt, mtp);
                const unsigned* list = (const unsigned*)(c.ws + S_LIST) + (size_t)s * NEXP * TSUB;
                MoeOrder S{(const char*)(c.ws + S_HE), (const char*)(c.ws + W_E2), 4, c.G, c.bid, (size_t)D * DEXP, (size_t)256 * DEXP, (size_t)256 * DEXP, mtp, mcnt, list, false, c.lane};
                EpiExpDown E{(unsigned char*)(c.ws + S_Y)};
                gemm_phase<EpiExpDown, MoeOrder, false, true>(c.lds, c.tid, DEXP, DEXP, S, E); SEAM(); }
            if (PHS(17) && IN(pb + 17 + 3 * s)) RP(17) { const Ctx c = fresh(c0); moe_tables(c, c.layer, s, mcnt, mtp); phase_combine(c, s, mtp, c.layer == DEPTH - 1, rep_ > 0); }
        }
    }
#undef IN
#ifdef X7
    asm volatile("s_waitcnt vmcnt(0)" ::: "memory"); __syncthreads(); __builtin_amdgcn_fence(__ATOMIC_RELEASE, "agent"); asm volatile("s_waitcnt vmcnt(0)" ::: "memory");
#endif
}

extern "C" void kernel_launch(void* const* d_in, const int* in_sizes, int n_in, void* d_out, int out_size, void* d_ws, size_t ws_size, hipStream_t stream) {
    static int grid = 0;
    if (grid == 0) {
        if (n_in != 27 || ws_size < WS_END) { fprintf(stderr, "kernel_launch: n_in %d ws %zu (need %zu)\n", n_in, ws_size, (size_t)WS_END); grid = -1; return; }
        if (hipFuncSetAttribute((const void*)mk_fwd, hipFuncAttributeMaxDynamicSharedMemorySize, LDS_BYTES) != hipSuccess) { fprintf(stderr, "kernel_launch: hipFuncSetAttribute failed\n"); grid = -1; return; }
        int dev = 0, cus = 0, per_cu = 0;
        hipGetDevice(&dev); hipDeviceGetAttribute(&cus, hipDeviceAttributeMultiprocessorCount, dev);
        hipOccupancyMaxActiveBlocksPerMultiprocessor(&per_cu, (const void*)mk_fwd, 512, LDS_BYTES);
        (void)hipGetLastError();
        grid = cus > 0 ? cus : 256; if (grid > 256) grid = 256;
        fprintf(stderr, "kernel_launch: grid %d (occupancy query %d per CU)\n", grid, per_cu);
    }
    if (grid < 0) return;
    hipMemsetAsync((char*)d_ws + WS_CTL, 0, 1 * MiB, stream);
    Args a{};
    for (int i = 0; i < 27; ++i) a.in[i] = d_in[i];
    a.out = (float*)d_out; a.ws = (unsigned char*)d_ws;
#if MK_ONE_LAUNCH
#ifndef MAXPH
#define MAXPH (DEPTH * NPH)
#endif
    a.ph_lo = 0; a.ph_hi = MAXPH;
    hipLaunchKernelGGL(mk_fwd, dim3(grid), dim3(512), LDS_BYTES, stream, a);
#else
#ifndef MAXPH
#define MAXPH (DEPTH * NPH)
#endif
    for (int ph = 0; ph < MAXPH; ++ph) { a.ph_lo = ph; a.ph_hi = ph + 1; hipLaunchKernelGGL(mk_fwd, dim3(grid), dim3(512), LDS_BYTES, stream, a); }
#endif
}
```
